# Optimizing an MI355X kernel written in HIP

```python
import math
import jax, jax.numpy as jnp
from jax import lax
import numpy as np

D_MODEL = 1024
BATCH = 8
SEQ = 2048
DEPTH = 4
DEC_BATCH = 128
DEC_SEQ = 1
PAST_LEN = 16384
PAGE_SIZE = 128

N_META = 16
N_MIXERS = 2
N_SSD_LAYERS = (DEPTH + 1) // 2
N_LRU_LAYERS = DEPTH // 2
CONV_WIDTH = 4
EPS = 1e-6
SSD_EXPAND = 2
D_INNER = SSD_EXPAND * D_MODEL
SSD_HEAD_DIM = 64
SSD_HEADS = D_INNER // SSD_HEAD_DIM
SSD_GROUPS = 8
SSD_HPG = SSD_HEADS // SSD_GROUPS
SSD_STATE = 128
SSD_CHUNK = 128
SSD_CONV_DIM = D_INNER + 2 * SSD_GROUPS * SSD_STATE
SSD_IN_DIM = D_INNER + SSD_CONV_DIM + SSD_HEADS
D_RNN = D_MODEL
LRU_BLOCKS = 8
LRU_BLOCK_W = D_RNN // LRU_BLOCKS
LRU_C = 8.0
D_FF = 4 * D_MODEL

kernel_name = "hybrid_ssd_rglru_decode_step"


def rms_norm(x, g):
    xf = x.astype(jnp.float32)
    y = xf * lax.rsqrt(jnp.mean(xf * xf, axis=-1, keepdims=True) + EPS)
    return (y * g.astype(jnp.float32)).astype(x.dtype)


def causal_conv(x, prev, w, b):
    L = x.shape[1]
    xp = jnp.concatenate([prev.astype(x.dtype), x], axis=1)
    out = b + sum(xp[:, k:k + L] * w[k] for k in range(CONV_WIDTH))
    return out, xp[:, -(CONV_WIDTH - 1):]


def segsum_exp(cs):
    Q = cs.shape[-1]
    diff = cs[..., :, None] - cs[..., None, :]
    mask = jnp.tril(jnp.ones((Q, Q), dtype=bool))
    return jnp.where(mask, jnp.exp(jnp.where(mask, diff, 0.0)), 0.0)


def ssd_chunked(xdt, a, Bm, Cm, h0, chunk):
    b, l = xdt.shape[:2]
    nc = l // chunk
    f32 = jnp.float32
    x = xdt.astype(f32).reshape(b, nc, chunk, SSD_GROUPS, SSD_HPG, SSD_HEAD_DIM)
    Bc = Bm.astype(f32).reshape(b, nc, chunk, SSD_GROUPS, SSD_STATE)
    Cc = Cm.astype(f32).reshape(b, nc, chunk, SSD_GROUPS, SSD_STATE)
    ac = a.astype(f32).reshape(b, nc, chunk, SSD_GROUPS, SSD_HPG)
    cs = jnp.cumsum(ac, axis=2)
    Lmat = segsum_exp(jnp.moveaxis(cs, 2, -1))
    cb = jnp.einsum("bclgn,bcsgn->bcgls", Cc, Bc)
    scores = cb[:, :, :, None] * Lmat
    y_diag = jnp.einsum("bcgrls,bcsgrp->bclgrp", scores, x)
    decay_to_end = jnp.exp(cs[:, :, -1:] - cs)
    chunk_states = jnp.einsum("bcsgn,bcsgrp->bcgrpn", Bc, x * decay_to_end[..., None])
    chunk_decay = jnp.exp(cs[:, :, -1])

    def step(h, inp):
        dec, st = inp
        return h * dec[..., None, None] + st, h

    h_init = h0.astype(f32).reshape(b, SSD_GROUPS, SSD_HPG, SSD_HEAD_DIM, SSD_STATE)
    h_final, h_prev = lax.scan(step, h_init, (jnp.moveaxis(chunk_decay, 1, 0), jnp.moveaxis(chunk_states, 1, 0)))
    h_prev = jnp.moveaxis(h_prev, 0, 1)
    y_off = jnp.einsum("bclgn,bcgrpn->bclgrp", Cc, h_prev) * jnp.exp(cs)[..., None]
    y = (y_diag + y_off).reshape(b, l, SSD_HEADS, SSD_HEAD_DIM)
    return y, h_final.reshape(b, SSD_HEADS, SSD_HEAD_DIM, SSD_STATE).astype(h0.dtype)


def ssd_mixer(u, conv_prev, h0, w_in, conv_w, conv_b, dt_bias, a_log, d_skip, norm_g, w_out, n_lead, chunk):
    b, l, _ = u.shape
    proj = u @ w_in
    z = proj[..., :D_INNER]
    xbc = proj[..., D_INNER:D_INNER + SSD_CONV_DIM]
    dt = proj[..., D_INNER + SSD_CONV_DIM:]
    xbc, conv_new = causal_conv(xbc, conv_prev, conv_w, conv_b)
    xbc = jax.nn.silu(xbc)
    xs = xbc[..., :D_INNER].reshape(b, l, SSD_HEADS, SSD_HEAD_DIM)
    Bm = xbc[..., D_INNER:D_INNER + SSD_GROUPS * SSD_STATE].reshape(b, l, SSD_GROUPS, SSD_STATE)
    Cm = xbc[..., D_INNER + SSD_GROUPS * SSD_STATE:].reshape(b, l, SSD_GROUPS, SSD_STATE)
    dt = jax.nn.softplus(dt.astype(jnp.float32) + dt_bias.astype(jnp.float32))
    a = dt * (-jnp.exp(a_log.astype(jnp.float32)))
    xdt = xs.astype(jnp.float32) * dt[..., None]
    if n_lead > 0:
        y1, h = ssd_chunked(xdt[:, :n_lead], a[:, :n_lead], Bm[:, :n_lead], Cm[:, :n_lead], h0, n_lead)
        y2, h = ssd_chunked(xdt[:, n_lead:], a[:, n_lead:], Bm[:, n_lead:], Cm[:, n_lead:], h, chunk)
        y = jnp.concatenate([y1, y2], axis=1)
    else:
        y, h = ssd_chunked(xdt, a, Bm, Cm, h0, chunk)
    y = y + xs.astype(jnp.float32) * d_skip.astype(jnp.float32)[:, None]
    y = y.reshape(b, l, D_INNER) * jax.nn.silu(z.astype(jnp.float32))
    yg = y.reshape(b, l, SSD_GROUPS, D_INNER // SSD_GROUPS)
    yg = yg * lax.rsqrt(jnp.mean(yg * yg, axis=-1, keepdims=True) + EPS)
    y = yg.reshape(b, l, D_INNER) * norm_g.astype(jnp.float32)
    return y.astype(u.dtype) @ w_out, conv_new, h


def rglru_mixer(u, conv_prev, h0, w_in, b_in, conv_w, conv_b, w_a, b_a, w_x, b_x, lam, w_out, b_out):
    b, l, _ = u.shape
    proj = u @ w_in + b_in
    gate = jax.nn.gelu(proj[..., :D_RNN], approximate=True)
    xr, conv_new = causal_conv(proj[..., D_RNN:], conv_prev, conv_w, conv_b)
    xb = xr.reshape(b, l, LRU_BLOCKS, LRU_BLOCK_W)
    r = jax.nn.sigmoid((jnp.einsum("blkc,kcd->blkd", xb, w_a).reshape(b, l, D_RNN) + b_a).astype(jnp.float32))
    i = jax.nn.sigmoid((jnp.einsum("blkc,kcd->blkd", xb, w_x).reshape(b, l, D_RNN) + b_x).astype(jnp.float32))
    log_a = -LRU_C * r * jax.nn.softplus(-lam.astype(jnp.float32))
    a = jnp.exp(log_a)
    mult = jnp.sqrt(-jnp.expm1(2.0 * log_a))
    bterm = mult * i * xr.astype(jnp.float32)
    bterm = bterm.at[:, 0].add(a[:, 0] * h0.astype(jnp.float32))

    def combine(c1, c2):
        a1, b1 = c1
        a2, b2 = c2
        return a1 * a2, a2 * b1 + b2

    _, h = lax.associative_scan(combine, (a, bterm), axis=1)
    y = (h * gate.astype(jnp.float32)).astype(u.dtype)
    return y @ w_out + b_out, conv_new, h[:, -1].astype(h0.dtype)


def sq_relu_mlp(x, w1, w2):
    h = jax.nn.relu(x @ w1)
    return (h * h) @ w2


def trunk(x, ssd_conv, ssd_h, lru_conv, lru_h, n_lead, chunk, p):
    n_ssd_conv, n_ssd_h, n_lru_conv, n_lru_h = [], [], [], []
    for i in range(DEPTH):
        h = rms_norm(x, p["norm_mix_pre"][i])
        j = i // N_MIXERS
        if i % N_MIXERS == 0:
            m, c_new, s_new = ssd_mixer(h, ssd_conv[j], ssd_h[j], p["ssd_w_in"][j], p["ssd_conv_w"][j],
                                        p["ssd_conv_b"][j], p["ssd_dt_bias"][j], p["ssd_a_log"][j],
                                        p["ssd_d"][j], p["ssd_norm"][j], p["ssd_w_out"][j], n_lead, chunk)
            n_ssd_conv.append(c_new)
            n_ssd_h.append(s_new)
        else:
            m, c_new, s_new = rglru_mixer(h, lru_conv[j], lru_h[j], p["lru_w_in"][j], p["lru_b_in"][j],
                                          p["lru_conv_w"][j], p["lru_conv_b"][j], p["lru_w_a"][j],
                                          p["lru_b_a"][j], p["lru_w_x"][j], p["lru_b_x"][j],
                                          p["lru_lambda"][j], p["lru_w_out"][j], p["lru_b_out"][j])
            n_lru_conv.append(c_new)
            n_lru_h.append(s_new)
        x = x + rms_norm(m, p["norm_mix_post"][i])
        h = rms_norm(x, p["norm_ffn_pre"][i])
        x = x + rms_norm(sq_relu_mlp(h, p["ffn_w1"][i], p["ffn_w2"][i]), p["norm_ffn_post"][i])
    return x, jnp.stack(n_ssd_conv), jnp.stack(n_ssd_h), jnp.stack(n_lru_conv), jnp.stack(n_lru_h)


def setup_inputs(seed: int = 0) -> dict:
    key = jax.random.key(seed)
    ks = jax.random.split(key, 40)
    nrm = jax.random.normal
    NA, NB = N_SSD_LAYERS, N_LRU_LAYERS
    dt0 = jnp.exp(jax.random.uniform(ks[10], (NA, SSD_HEADS), minval=math.log(1e-3), maxval=math.log(1e-1)))
    a_pow = jax.random.uniform(ks[20], (NB, D_RNN), minval=0.9, maxval=0.999)
    s = a_pow ** (1.0 / LRU_C)
    return {
        "x_prompt": nrm(ks[0], (BATCH, SEQ, D_MODEL), jnp.float32),
        "x_sample": nrm(ks[1], (DEC_BATCH, DEC_SEQ, D_MODEL), jnp.float32),
        "state_ssd_conv": nrm(ks[2], (NA, DEC_BATCH, CONV_WIDTH - 1, SSD_CONV_DIM), jnp.float32),
        "state_ssd_h": 0.1 * nrm(ks[3], (NA, DEC_BATCH, SSD_HEADS, SSD_HEAD_DIM, SSD_STATE), jnp.float32),
        "state_lru_conv": nrm(ks[4], (NB, DEC_BATCH, CONV_WIDTH - 1, D_RNN), jnp.float32),
        "state_lru_h": 0.5 * nrm(ks[5], (NB, DEC_BATCH, D_RNN), jnp.float32),
        "meta_tokens": nrm(ks[6], (N_META, D_MODEL), jnp.float32),
        "norm_mix_pre": 1.0 + 0.05 * nrm(ks[30], (DEPTH, D_MODEL), jnp.float32),
        "norm_mix_post": 1.0 + 0.05 * nrm(ks[31], (DEPTH, D_MODEL), jnp.float32),
        "norm_ffn_pre": 1.0 + 0.05 * nrm(ks[32], (DEPTH, D_MODEL), jnp.float32),
        "norm_ffn_post": 1.0 + 0.05 * nrm(ks[33], (DEPTH, D_MODEL), jnp.float32),
        "ssd_w_in": nrm(ks[7], (NA, D_MODEL, SSD_IN_DIM), jnp.float32) * D_MODEL ** -0.5,
        "ssd_conv_w": nrm(ks[8], (NA, CONV_WIDTH, SSD_CONV_DIM), jnp.float32) * CONV_WIDTH ** -0.5,
        "ssd_conv_b": 0.02 * nrm(ks[9], (NA, SSD_CONV_DIM), jnp.float32),
        "ssd_dt_bias": dt0 + jnp.log(-jnp.expm1(-dt0)),
        "ssd_a_log": jnp.log(jax.random.uniform(ks[11], (NA, SSD_HEADS), minval=1.0, maxval=16.0)),
        "ssd_d": 1.0 + 0.1 * nrm(ks[12], (NA, SSD_HEADS), jnp.float32),
        "ssd_norm": 1.0 + 0.05 * nrm(ks[13], (NA, D_INNER), jnp.float32),
        "ssd_w_out": nrm(ks[14], (NA, D_INNER, D_MODEL), jnp.float32) * D_INNER ** -0.5,
        "lru_w_in": nrm(ks[15], (NB, D_MODEL, 2 * D_RNN), jnp.float32) * D_MODEL ** -0.5,
        "lru_b_in": 0.02 * nrm(ks[16], (NB, 2 * D_RNN), jnp.float32),
        "lru_conv_w": nrm(ks[17], (NB, CONV_WIDTH, D_RNN), jnp.float32) * CONV_WIDTH ** -0.5,
        "lru_conv_b": 0.02 * nrm(ks[18], (NB, D_RNN), jnp.float32),
        "lru_w_a": nrm(ks[19], (NB, LRU_BLOCKS, LRU_BLOCK_W, LRU_BLOCK_W), jnp.float32) * LRU_BLOCK_W ** -0.5,
        "lru_b_a": 0.02 * nrm(ks[21], (NB, D_RNN), jnp.float32),
        "lru_w_x": nrm(ks[22], (NB, LRU_BLOCKS, LRU_BLOCK_W, LRU_BLOCK_W), jnp.float32) * LRU_BLOCK_W ** -0.5,
        "lru_b_x": 0.02 * nrm(ks[23], (NB, D_RNN), jnp.float32),
        "lru_lambda": jnp.log(s / (1.0 - s)),
        "lru_w_out": nrm(ks[24], (NB, D_RNN, D_MODEL), jnp.float32) * D_RNN ** -0.5,
        "lru_b_out": 0.02 * nrm(ks[25], (NB, D_MODEL), jnp.float32),
        "ffn_w1": nrm(ks[26], (DEPTH, D_MODEL, D_FF), jnp.float32) * D_MODEL ** -0.5,
        "ffn_w2": nrm(ks[27], (DEPTH, D_FF, D_MODEL), jnp.float32) * D_FF ** -0.5,
    }


def reference(x_prompt, x_sample, state_ssd_conv, state_ssd_h, state_lru_conv, state_lru_h, meta_tokens,
              norm_mix_pre, norm_mix_post, norm_ffn_pre, norm_ffn_post,
              ssd_w_in, ssd_conv_w, ssd_conv_b, ssd_dt_bias, ssd_a_log, ssd_d, ssd_norm, ssd_w_out,
              lru_w_in, lru_b_in, lru_conv_w, lru_conv_b, lru_w_a, lru_b_a, lru_w_x, lru_b_x, lru_lambda,
              lru_w_out, lru_b_out, ffn_w1, ffn_w2):
    p = dict(norm_mix_pre=norm_mix_pre, norm_mix_post=norm_mix_post, norm_ffn_pre=norm_ffn_pre,
             norm_ffn_post=norm_ffn_post, ssd_w_in=ssd_w_in, ssd_conv_w=ssd_conv_w, ssd_conv_b=ssd_conv_b,
             ssd_dt_bias=ssd_dt_bias, ssd_a_log=ssd_a_log, ssd_d=ssd_d, ssd_norm=ssd_norm, ssd_w_out=ssd_w_out,
             lru_w_in=lru_w_in, lru_b_in=lru_b_in, lru_conv_w=lru_conv_w, lru_conv_b=lru_conv_b,
             lru_w_a=lru_w_a, lru_b_a=lru_b_a, lru_w_x=lru_w_x, lru_b_x=lru_b_x, lru_lambda=lru_lambda,
             lru_w_out=lru_w_out, lru_b_out=lru_b_out, ffn_w1=ffn_w1, ffn_w2=ffn_w2)
    dt = x_prompt.dtype
    meta = jnp.broadcast_to(meta_tokens.astype(dt)[None], (BATCH, N_META, D_MODEL))
    xp = jnp.concatenate([meta, x_prompt], axis=1)
    z_ssd_conv = jnp.zeros((N_SSD_LAYERS, BATCH, CONV_WIDTH - 1, SSD_CONV_DIM), dt)
    z_ssd_h = jnp.zeros((N_SSD_LAYERS, BATCH, SSD_HEADS, SSD_HEAD_DIM, SSD_STATE), dt)
    z_lru_conv = jnp.zeros((N_LRU_LAYERS, BATCH, CONV_WIDTH - 1, D_RNN), dt)
    z_lru_h = jnp.zeros((N_LRU_LAYERS, BATCH, D_RNN), dt)
    yp, p_ssd_conv, p_ssd_h, p_lru_conv, p_lru_h = trunk(xp, z_ssd_conv, z_ssd_h, z_lru_conv, z_lru_h,
                                                         N_META, SSD_CHUNK, p)
    y_prompt = yp[:, N_META:]
    y_sample, s_ssd_conv, s_ssd_h, s_lru_conv, s_lru_h = trunk(x_sample, state_ssd_conv, state_ssd_h,
                                                               state_lru_conv, state_lru_h, 0, DEC_SEQ, p)
    return (y_prompt, y_sample, p_ssd_conv, p_ssd_h, p_lru_conv, p_lru_h,
            s_ssd_conv, s_ssd_h, s_lru_conv, s_lru_h)
```

```cpp
#include <hip/hip_runtime.h>
#include <hip/hip_cooperative_groups.h>
#include <cstdio>
#include <cstdint>
namespace cg = cooperative_groups;

constexpr int DM = 1024, NB = 8, SEQ = 2048, NMETA = 16, LP = SEQ + NMETA  , NS = 128;
constexpr int TP = NB * LP  , T = TP + NS  ;
constexpr int DI = 2048, HD = 64, NH = 32, NG = 8, NST = 128, CONVD = 4096, INDIM = 6176, DFF = 4096, DR = 1024;
constexpr int ZXW = 6144;
constexpr int NPAD_SSD = 6400;
constexpr int NSEQ = NB + NS;
constexpr float EPS = 1e-6f;

constexpr size_t O_YP = 0, O_YS = O_YP + (size_t)NB * SEQ * DM, O_PSC = O_YS + (size_t)NS * DM, O_PSH = O_PSC + (size_t)2 * NB * 3 * CONVD,
                 O_PLC = O_PSH + (size_t)2 * NB * NH * HD * NST, O_PLH = O_PLC + (size_t)2 * NB * 3 * DR, O_SSC = O_PLH + (size_t)2 * NB * DR,
                 O_SSH = O_SSC + (size_t)2 * NS * 3 * CONVD, O_SLC = O_SSH + (size_t)2 * NS * NH * HD * NST, O_SLH = O_SLC + (size_t)2 * NS * 3 * DR,
                 O_END = O_SLH + (size_t)2 * NS * DR;

enum { I_XP = 0, I_XS, I_SSC, I_SSH, I_SLC, I_SLH, I_META, I_NMPRE, I_NMPOST, I_NFPRE, I_NFPOST, I_SWIN, I_SCW, I_SCB, I_SDTB, I_SALOG, I_SD, I_SNORM, I_SWOUT,
       I_LWIN, I_LBIN, I_LCW, I_LCB, I_LWA, I_LBA, I_LWX, I_LBX, I_LLAM, I_LWOUT, I_LBOUT, I_W1, I_W2, N_IN };

#ifndef SUBREP
#define SUBREP 0
#endif
typedef unsigned short bf16;

constexpr size_t MiB = 1u << 20;
constexpr size_t WS_CTL = 0, CTL_ZERO_BYTES = 32768;
constexpr size_t WS_LCF = 512 * 1024;
constexpr size_t WE_SIN = 0, WE_SOUT = WE_SIN + (size_t)NPAD_SSD * DM, WE_SEND = WE_SOUT + (size_t)DM * DI;
constexpr size_t WE_LIN = 0, WE_LAX = WE_LIN + (size_t)2048 * DM, WE_LOUT = WE_LAX + (size_t)8 * 256 * 128, WE_LEND = WE_LOUT + (size_t)DM * DR;
constexpr size_t WE_F1 = 0, WE_F2 = WE_F1 + (size_t)DFF * DM, WE_FEND = WE_F2 + (size_t)DM * DFF;
constexpr size_t WE_SSD0 = 0, WE_LRU0 = WE_SSD0 + 2 * WE_SEND, WE_FFN0 = WE_LRU0 + 2 * WE_LEND, WE_TOTAL = WE_FFN0 + 4 * WE_FEND;
constexpr size_t WS_W = 1 * MiB;
constexpr size_t WS_X = 121 * MiB;
constexpr size_t WS_XB = WS_X + 65 * MiB;
constexpr size_t WS_RS = WS_XB + 33 * MiB;
constexpr size_t WS_M = WS_RS + 1 * MiB;
constexpr size_t WS_ZX = WS_M + 65 * MiB;
constexpr size_t WS_DT = WS_ZX + 195 * MiB;
constexpr size_t WS_YN = WS_DT + 3 * MiB;
constexpr size_t WS_SCR = WS_YN + 65 * MiB;
constexpr size_t WS_END = WS_SCR + 400 * MiB;
static_assert(WE_TOTAL * 2 <= 120 * MiB, "weight region");
static_assert(WS_END <= 1024 * MiB, "d_ws map");

#define GAS __attribute__((address_space(1)))
#define LAS __attribute__((address_space(3)))
typedef unsigned v4u __attribute__((ext_vector_type(4)));
typedef unsigned v2u __attribute__((ext_vector_type(2)));
typedef float v4f __attribute__((ext_vector_type(4)));
typedef float v2f __attribute__((ext_vector_type(2)));
#define LDS_WAIT() asm volatile("s_waitcnt lgkmcnt(0)" ::: "memory")
#define VM_WAIT() asm volatile("s_waitcnt vmcnt(0)" ::: "memory")

__device__ __forceinline__ float silu_f(float x) { return x * __builtin_amdgcn_rcpf(1.f + __expf(-x)); }
__device__ __forceinline__ float sigmoid_f(float x) { return __builtin_amdgcn_rcpf(1.f + __expf(-x)); }
__device__ __forceinline__ float neg_expm1_f(float x) { const float p = x * (1.f + x * (0.5f + x * (0.16666667f + x * (0.041666668f + x * (0.0083333338f + x * 0.0013888889f)))));
    return x > -0.35f ? -p : 1.f - __expf(x); }
__device__ __forceinline__ float softplus_f(float x) { return fmaxf(x, 0.f) + log1pf(__expf(-fabsf(x))); }
__device__ __forceinline__ float one_minus_exp2x(float x, float e) { const float t = 2.f * x;
    const float p = t * (1.f + t * (0.5f + t * (0.16666667f + t * (0.041666668f + t * (0.0083333338f + t * 0.0013888889f)))));
    return t > -0.35f ? -p : 1.f - e * e; }
__device__ __forceinline__ void lru_gate2(v2f ga, v2f gx, float bav, float bxv, float cfac, v2f xr, v2f& av, v2f& bt, v2f& la) {
    const v2f ta = ga + bav, tx = gx + bxv;
    v2f ea, ex; ea.x = __expf(-ta.x); ea.y = __expf(-ta.y); ex.x = __expf(-tx.x); ex.y = __expf(-tx.y);
    ea = ea + 1.0f; ex = ex + 1.0f;
    v2f rg, ig; rg.x = __builtin_amdgcn_rcpf(ea.x); rg.y = __builtin_amdgcn_rcpf(ea.y); ig.x = __builtin_amdgcn_rcpf(ex.x); ig.y = __builtin_amdgcn_rcpf(ex.y);
    la = rg * (-cfac);
    av.x = __expf(la.x); av.y = __expf(la.y);
    const v2f t = la * 2.0f;
    const v2f p = t * (1.0f + t * (0.5f + t * (0.16666667f + t * (0.041666668f + t * (0.0083333338f + t * 0.0013888889f)))));
    const v2f q = 1.0f - av * av;
    v2f om; om.x = t.x > -0.35f ? -p.x : q.x; om.y = t.y > -0.35f ? -p.y : q.y;
    v2f mu; mu.x = __builtin_amdgcn_sqrtf(om.x); mu.y = __builtin_amdgcn_sqrtf(om.y);
    bt = mu * ig * xr;
}
__device__ __forceinline__ float gelu_tanh_f(float x) { const float u = 0.7978845608028654f * (x + 0.044715f * x * x * x); return x * __builtin_amdgcn_rcpf(1.f + __expf(-2.f * u)); }
__device__ __forceinline__ float dpp_add(float v, float w) { return v + w; }
#define WS_DPP(v, ctrl, rmask) ((v) + __builtin_bit_cast(float, __builtin_amdgcn_update_dpp(0, __builtin_bit_cast(int, (v)), (ctrl), (rmask), 0xf, true)))
__device__ __forceinline__ float wave_sum(float v) {
    v = WS_DPP(v, 0xB1, 0xf);
    v = WS_DPP(v, 0x4E, 0xf);
    v = WS_DPP(v, 0x141, 0xf);
    v = WS_DPP(v, 0x140, 0xf);
    v = WS_DPP(v, 0x142, 0xa);
    v = WS_DPP(v, 0x143, 0xc);
    return __builtin_bit_cast(float, __builtin_amdgcn_readlane(__builtin_bit_cast(int, v), 63));
}
__device__ __forceinline__ float xor32_f(float x, int lane) { const unsigned u = __builtin_bit_cast(unsigned, x); const auto r = __builtin_amdgcn_permlane32_swap(u, u, false, false);
    return __builtin_bit_cast(float, lane < 32 ? r[1] : r[0]); }
__device__ __forceinline__ float xor16_f(float x, int lane) { const unsigned u = __builtin_bit_cast(unsigned, x); const auto r = __builtin_amdgcn_permlane16_swap(u, u, false, false);
    return __builtin_bit_cast(float, (lane & 16) ? r[0] : r[1]); }
typedef __bf16 bf16x2_hw __attribute__((ext_vector_type(2)));
__device__ __forceinline__ unsigned pk2(float lo, float hi) { const v2f v = {lo, hi}; return __builtin_bit_cast(unsigned, __builtin_convertvector(v, bf16x2_hw)); }
__device__ __forceinline__ unsigned f2bf(float f) { return pk2(f, 0.f) & 0xffffu; }
__device__ __forceinline__ float bf2f(bf16 b) { return __builtin_bit_cast(float, (unsigned)b << 16); }
__device__ __forceinline__ float bflo(unsigned w) { return __builtin_bit_cast(float, w << 16); }
__device__ __forceinline__ float bfhi(unsigned w) { return __builtin_bit_cast(float, w & 0xffff0000u); }
__device__ __forceinline__ int seq_row0(int q) { return q < NB ? q * LP : TP + (q - NB); }
__device__ __forceinline__ int seq_len(int q) { return q < NB ? LP : 1; }

namespace pg8 {
#define PG8_LAS __attribute__((address_space(3)))
typedef unsigned short bf16_t;
typedef short bf16x8 __attribute__((ext_vector_type(8)));
typedef float f32x4 __attribute__((ext_vector_type(4)));
typedef unsigned u32x4 __attribute__((ext_vector_type(4)));
constexpr int BM = 256, BK = 64, HALF = 128, HTB = HALF * BK * 2  , STAGE_BYTES = 8 * HTB, NXCD = 8, WGM = 4;

__host__ __device__ __forceinline__ int lds_byte(int r, int c) { const int st = (r >> 4) * 2 + (c >> 5), rr = r & 15, cc = c & 31, ob = rr * 64 + cc * 2; return st * 1024 + (ob ^ (((ob >> 9) & 1) << 5)); }
__host__ __device__ __forceinline__ void stage_rc(int b, int& R, int& C) { const int st = b / 1024, sb = b % 1024, swz = sb ^ (((sb >> 9) & 1) << 5); R = (st >> 1) * 16 + swz / 64; C = (st & 1) * 32 + (swz % 64) / 2; }
__host__ __device__ __forceinline__ int perm32(int rho) { const int n = rho >> 4, i = rho & 15; return 8 * (i >> 2) + 4 * n + (i & 3); }

struct Unit { int pm, pn; };
struct Gemm { const bf16_t* A; const bf16_t* Bt; int M, N, K; };

struct StaticOrder {
    int nM, nN, nwg, G, c;
    __host__ __device__ void init(int M, int N, int G_, int c_) { nM = M / BM; nN = N / BM; nwg = nM * nN; G = G_; c = c_; }
    __host__ __device__ bool next(int i, Unit& u) const {
        const long L = (long)i * G + c; if (L >= nwg) return false;
        int wgid = (int)L; { const int q = nwg / NXCD, r = nwg % NXCD, xcd = wgid % NXCD, off = wgid / NXCD; wgid = (xcd < r ? xcd * (q + 1) : r * (q + 1) + (xcd - r) * q) + off; }
        const int nig = WGM * nN, gid = wgid / nig, fm = gid * WGM, gsz = (nM - fm) < WGM ? (nM - fm) : WGM;
        u.pm = fm + ((wgid % nig) % gsz); u.pn = (wgid % nig) / gsz; return true;
    }
    __device__ __forceinline__ void a_ready(const Unit&) const {}
    __device__ __forceinline__ void done(const Unit&) const {}
};
__device__ __forceinline__ unsigned cvt_pk_bf16(float lo, float hi) { return ::pk2(lo, hi); }

template <class Epi, class Sched, bool ALIGN_EPI = false, bool SP2 = false>
__device__ __forceinline__ void gemm_phase(PG8_LAS unsigned char* lds, const Gemm g, const Sched& S, const Epi& E) {
    int tid_ = threadIdx.x; asm volatile("" : "+v"(tid_));
    const int tid = tid_, wid = __builtin_amdgcn_readfirstlane(tid >> 6), lane = tid & 63, wr = wid >> 2, wc = wid & 3, fr = lane & 15, fq = lane >> 4;
    const int K = g.K, nt = K / BK;
    unsigned voffA[2], voffB[2];
#pragma unroll
    for (int i = 0; i < 2; ++i) { int R, C; stage_rc(tid * 16 + i * 8192, R, C); const int Rb = Epi::PERM ? ((R & ~31) + perm32(R & 31)) : R;
        voffA[i] = (unsigned)(R * K + C) * 2u; voffB[i] = (unsigned)(Rb * K + C) * 2u; }
    const size_t kstep = (size_t)(BK * 2);
    const size_t hstep = (size_t)HALF * K * 2;
    const size_t tstep = 2 * hstep;
    const unsigned ldsw = (unsigned)wid * 1024u;
    const int aoff = lds_byte(wr * 64 + fr, fq * 8), boff = lds_byte(wc * 32 + fr, fq * 8);
#define PG8_SA(b, h) (((b) * 2 + (h)) * HTB)
#define PG8_SB(b, h) ((4 + (b) * 2 + (h)) * HTB)
#define PG8_STAGE(bufoff, gbase, voff) do { _Pragma("unroll") for (int _i = 0; _i < 2; ++_i) \
        __builtin_amdgcn_global_load_lds((const unsigned*)((const char*)(gbase) + (voff)[_i]), (PG8_LAS unsigned*)(lds + (bufoff) + ldsw + _i * 8192), 16, 0, 0); } while (0)
#define PG8_LDA(dst, b, h) do { _Pragma("unroll") for (int m = 0; m < 4; ++m) _Pragma("unroll") for (int k = 0; k < 2; ++k) dst[m][k] = *(const PG8_LAS bf16x8*)(lds + PG8_SA(b, h) + aoff + m * 2048 + k * 1024); } while (0)
#define PG8_LDB(dst, b, h) do { _Pragma("unroll") for (int n = 0; n < 2; ++n) _Pragma("unroll") for (int k = 0; k < 2; ++k) dst[n][k] = *(const PG8_LAS bf16x8*)(lds + PG8_SB(b, h) + boff + n * 2048 + k * 1024); } while (0)
#define PG8_MMA(ai, bj, At, Bt) do { __builtin_amdgcn_s_setprio(1); _Pragma("unroll") for (int m = 0; m < 4; ++m) _Pragma("unroll") for (int n = 0; n < 2; ++n) _Pragma("unroll") for (int k = 0; k < 2; ++k) \
        acc[ai][bj][m][n] = __builtin_amdgcn_mfma_f32_16x16x32_bf16(Bt[n][k], At[m][k], acc[ai][bj][m][n], 0, 0, 0); __builtin_amdgcn_s_setprio(0); } while (0)
#define PG8_WAIT_V(n) asm volatile("s_waitcnt vmcnt(" #n ")" ::: "memory")
#define PG8_WAIT_L(n) asm volatile("s_waitcnt lgkmcnt(" #n ")" ::: "memory")
#define PG8_BAR __builtin_amdgcn_s_barrier()
#define PG8_SCHED __builtin_amdgcn_sched_barrier(0)
    Unit cur, nxt; int ui = 0;
    if (!S.next(0, cur)) return;
    f32x4 acc[2][2][4][2];
#pragma unroll
    for (int a = 0; a < 2; ++a)
#pragma unroll
        for (int b = 0; b < 2; ++b)
#pragma unroll
            for (int m = 0; m < 4; ++m)
#pragma unroll
                for (int n = 0; n < 2; ++n) acc[a][b][m][n] = (f32x4){0.f, 0.f, 0.f, 0.f};
    bf16x8 At[4][2], B0[2][2], B1[2][2];
    const char* cA = (const char*)g.A + (size_t)cur.pm * tstep; const char* cB = (const char*)g.Bt + (size_t)cur.pn * tstep;
    S.a_ready(cur);
    if constexpr (SP2) {
        PG8_STAGE(PG8_SB(0, 0), cB, voffB); PG8_STAGE(PG8_SB(0, 1), cB + hstep, voffB); PG8_STAGE(PG8_SA(0, 0), cA, voffA); PG8_STAGE(PG8_SA(0, 1), cA + hstep, voffA);
        if (wr == 1) PG8_BAR;
        PG8_WAIT_V(2); PG8_BAR;
        PG8_STAGE(PG8_SB(1, 0), cB + kstep, voffB); PG8_STAGE(PG8_SA(1, 0), cA + kstep, voffA); PG8_STAGE(PG8_SB(1, 1), cB + hstep + kstep, voffB);
        PG8_WAIT_V(6); PG8_BAR;
    } else {
        PG8_STAGE(PG8_SB(0, 0), cB, voffB); PG8_STAGE(PG8_SA(0, 0), cA, voffA); PG8_STAGE(PG8_SB(0, 1), cB + hstep, voffB); PG8_STAGE(PG8_SA(0, 1), cA + hstep, voffA);
        if (wr == 1) PG8_BAR;
        PG8_WAIT_V(4); PG8_BAR;
        PG8_STAGE(PG8_SB(1, 0), cB + kstep, voffB); PG8_STAGE(PG8_SA(1, 0), cA + kstep, voffA); PG8_STAGE(PG8_SB(1, 1), cB + hstep + kstep, voffB);
        PG8_WAIT_V(6); PG8_BAR;
    }
    for (;;) {
        const bool has_next = S.next(ui + 1, nxt);
        const char* nA = has_next ? (const char*)g.A + (size_t)nxt.pm * tstep : cA; const char* nB = has_next ? (const char*)g.Bt + (size_t)nxt.pn * tstep : cB;
        for (int t = 0; t < nt; t += 2) {
            const bool last = (t == nt - 2);
            const char* a1 = cA + (size_t)(t + 1) * kstep;
            const char* a2 = last ? nA : cA + (size_t)(t + 2) * kstep; const char* b2 = last ? nB : cB + (size_t)(t + 2) * kstep;
            const char* a3 = a2 + kstep; const char* b3 = b2 + kstep;
            if (last && has_next) S.a_ready(nxt);
            if constexpr (SP2) {
            PG8_LDB(B0, 0, 0); PG8_LDB(B1, 0, 1); PG8_SCHED; PG8_LDA(At, 0, 0); PG8_STAGE(PG8_SA(1, 1), a1 + hstep, voffA);
            PG8_WAIT_V(8); PG8_WAIT_L(0); PG8_BAR; PG8_MMA(0, 0, At, B0); PG8_MMA(0, 1, At, B1); PG8_BAR; PG8_SCHED;
            PG8_LDA(At, 0, 1); PG8_STAGE(PG8_SB(0, 0), b2, voffB); PG8_STAGE(PG8_SB(0, 1), b2 + hstep, voffB); PG8_STAGE(PG8_SA(0, 0), a2, voffA);
            PG8_WAIT_V(8); PG8_WAIT_L(0); PG8_BAR; PG8_MMA(1, 0, At, B0); PG8_MMA(1, 1, At, B1); PG8_BAR; PG8_SCHED;
            PG8_LDB(B0, 1, 0); PG8_LDB(B1, 1, 1); PG8_SCHED; PG8_LDA(At, 1, 0); PG8_STAGE(PG8_SA(0, 1), a2 + hstep, voffA);
            PG8_WAIT_V(8); PG8_WAIT_L(0); PG8_BAR; PG8_MMA(0, 0, At, B0); PG8_MMA(0, 1, At, B1); PG8_BAR; PG8_SCHED;
            PG8_LDA(At, 1, 1); PG8_STAGE(PG8_SB(1, 0), b3, voffB); PG8_STAGE(PG8_SB(1, 1), b3 + hstep, voffB); PG8_STAGE(PG8_SA(1, 0), a3, voffA);
            PG8_WAIT_V(8); PG8_WAIT_L(0); PG8_BAR; PG8_MMA(1, 0, At, B0); PG8_MMA(1, 1, At, B1); PG8_BAR; PG8_SCHED;
            } else {
            PG8_LDB(B0, 0, 0); PG8_SCHED; PG8_LDA(At, 0, 0); PG8_STAGE(PG8_SA(1, 1), a1 + hstep, voffA);
            PG8_WAIT_L(8); PG8_BAR; PG8_WAIT_L(0); PG8_MMA(0, 0, At, B0); PG8_BAR; PG8_SCHED;
            PG8_LDB(B1, 0, 1); PG8_STAGE(PG8_SB(0, 0), b2, voffB);
            PG8_BAR; PG8_WAIT_L(0); PG8_MMA(0, 1, At, B1); PG8_BAR;
            PG8_LDA(At, 0, 1); PG8_STAGE(PG8_SA(0, 0), a2, voffA);
            PG8_BAR; PG8_WAIT_L(0); PG8_MMA(1, 0, At, B0); PG8_BAR; PG8_SCHED;
            PG8_STAGE(PG8_SB(0, 1), b2 + hstep, voffB);
            PG8_WAIT_V(6); PG8_BAR; PG8_MMA(1, 1, At, B1); PG8_BAR;
            PG8_LDB(B0, 1, 0); PG8_SCHED; PG8_LDA(At, 1, 0); PG8_STAGE(PG8_SA(0, 1), a2 + hstep, voffA);
            PG8_WAIT_L(8); PG8_BAR; PG8_WAIT_L(0); PG8_MMA(0, 0, At, B0); PG8_BAR; PG8_SCHED;
            PG8_LDB(B1, 1, 1); PG8_STAGE(PG8_SB(1, 0), b3, voffB);
            PG8_BAR; PG8_WAIT_L(0); PG8_MMA(0, 1, At, B1); PG8_BAR;
            PG8_LDA(At, 1, 1); PG8_STAGE(PG8_SA(1, 0), a3, voffA);
            PG8_BAR; PG8_WAIT_L(0); PG8_MMA(1, 0, At, B0); PG8_BAR; PG8_SCHED;
            PG8_STAGE(PG8_SB(1, 1), b3 + hstep, voffB);
            PG8_WAIT_V(6); PG8_BAR; PG8_MMA(1, 1, At, B1); PG8_BAR;
            }
        }
        if constexpr (ALIGN_EPI) { if (wr == 0) PG8_BAR; }
        if constexpr (!Epi::AFTER_DRAIN) { E(acc, cur, wr, wc, fr, fq); if (SUBREP & 2048) asm volatile("s_waitcnt vmcnt(0)" ::: "memory"); if (SUBREP & 1024) { asm volatile("" ::: "memory"); E(acc, cur, wr, wc, fr, fq); } S.done(cur); }
        if (!has_next) break;
#pragma unroll
        for (int a = 0; a < 2; ++a)
#pragma unroll
            for (int b = 0; b < 2; ++b)
#pragma unroll
                for (int m = 0; m < 4; ++m)
#pragma unroll
                    for (int n = 0; n < 2; ++n) acc[a][b][m][n] = (f32x4){0.f, 0.f, 0.f, 0.f};
        cur = nxt; cA = nA; cB = nB; ++ui;
        if constexpr (ALIGN_EPI) { if (wr == 1) PG8_BAR; }
    }
    PG8_WAIT_V(0);
    if constexpr (!ALIGN_EPI) { if (wr == 0) PG8_BAR; }
    PG8_BAR;
    if constexpr (Epi::AFTER_DRAIN) { E.fused(acc, cur, wr, wc, fr, fq, lds, wid, lane); S.done(cur); }
#undef PG8_SA
#undef PG8_SB
#undef PG8_STAGE
#undef PG8_LDA
#undef PG8_LDB
#undef PG8_MMA
#undef PG8_WAIT_V
#undef PG8_WAIT_L
#undef PG8_BAR
#undef PG8_SCHED
}
}

namespace pg8 {
#define EPI_STORE16(p, v) (*(u32x4*)(p) = (v))
struct EpiSsdIn {
    static constexpr bool PERM = true, AFTER_DRAIN = false;
    bf16_t* ZX; float* DT; const float* rs;
    __device__ __forceinline__ void elem(int r, int c, float v) const { if (c < ZXW) ZX[(size_t)r * ZXW + c] = (bf16_t)f2bf(v); else DT[(size_t)r * 32 + (c - ZXW)] = v; }
    __device__ __forceinline__ void operator()(const f32x4 (&acc)[2][2][4][2], const Unit& u, int wr, int wc, int fr, int fq) const {
        const int row0 = u.pm * BM + wr * 64 + fr;
        if (u.pn < 24) {
            const int col0 = u.pn * BM + wc * 32 + 8 * fq;
#pragma unroll
            for (int ai = 0; ai < 2; ++ai)
#pragma unroll
                for (int m = 0; m < 4; ++m) { const int r = row0 + ai * HALF + m * 16; bf16_t* rowp = ZX + (size_t)r * ZXW + col0;
#pragma unroll
                    for (int bj = 0; bj < 2; ++bj) { const f32x4 v0 = acc[ai][bj][m][0], v1 = acc[ai][bj][m][1];
                        u32x4 w; w.x = cvt_pk_bf16(v0[0], v0[1]); w.y = cvt_pk_bf16(v0[2], v0[3]); w.z = cvt_pk_bf16(v1[0], v1[1]); w.w = cvt_pk_bf16(v1[2], v1[3]);
                        EPI_STORE16(rowp + bj * HALF, w); } }
        } else if (wc == 0) {
#pragma unroll
            for (int ai = 0; ai < 2; ++ai)
#pragma unroll
                for (int m = 0; m < 4; ++m) { const int r = row0 + ai * HALF + m * 16; float* p = DT + (size_t)r * 32 + 8 * fq;
                    *(f32x4*)p = acc[ai][0][m][0]; *(f32x4*)(p + 4) = acc[ai][0][m][1]; }
        }
    }
};
struct EpiLruIn {
    static constexpr bool PERM = true, AFTER_DRAIN = false;
    bf16_t* G; bf16_t* XRAW; const float* rs; const float* bias;
    __device__ __forceinline__ void elem(int r, int c, float v) const { v = v + bias[c]; if (c < DR) G[(size_t)r * DR + c] = (bf16_t)f2bf(gelu_tanh_f(v)); else XRAW[(size_t)r * DR + (c - DR)] = (bf16_t)f2bf(v); }
    __device__ __forceinline__ void operator()(const f32x4 (&acc)[2][2][4][2], const Unit& u, int wr, int wc, int fr, int fq) const {
        const int row0 = u.pm * BM + wr * 64 + fr, bcol0 = u.pn * BM + wc * 32 + 8 * fq; const bool gate = u.pn < 4;
        bf16_t* base = gate ? G : XRAW; const int col0 = (gate ? bcol0 : bcol0 - DR);
        f32x4 bv[2][2];
#pragma unroll
        for (int bj = 0; bj < 2; ++bj)
#pragma unroll
            for (int n = 0; n < 2; ++n) bv[bj][n] = *(const f32x4*)(bias + bcol0 + bj * HALF + 4 * n);
#pragma unroll
        for (int ai = 0; ai < 2; ++ai)
#pragma unroll
            for (int m = 0; m < 4; ++m) { const int r = row0 + ai * HALF + m * 16; bf16_t* rowp = base + (size_t)r * DR + col0;
#pragma unroll
                for (int bj = 0; bj < 2; ++bj) { f32x4 v0 = acc[ai][bj][m][0] + bv[bj][0], v1 = acc[ai][bj][m][1] + bv[bj][1];
                    if (gate) {
#pragma unroll
                        for (int j = 0; j < 4; ++j) { v0[j] = gelu_tanh_f(v0[j]); v1[j] = gelu_tanh_f(v1[j]); } }
                    u32x4 w; w.x = cvt_pk_bf16(v0[0], v0[1]); w.y = cvt_pk_bf16(v0[2], v0[3]); w.z = cvt_pk_bf16(v1[0], v1[1]); w.w = cvt_pk_bf16(v1[2], v1[3]);
                    EPI_STORE16(rowp + bj * HALF, w); } }
    }
};
struct EpiFfn1 {
    static constexpr bool PERM = true, AFTER_DRAIN = false;
    bf16_t* H1; const float* rs;
    __device__ __forceinline__ void elem(int r, int c, float v) const { v = fmaxf(v, 0.f); H1[(size_t)r * DFF + c] = (bf16_t)f2bf(v * v); }
    __device__ __forceinline__ void operator()(const f32x4 (&acc)[2][2][4][2], const Unit& u, int wr, int wc, int fr, int fq) const {
        const int row0 = u.pm * BM + wr * 64 + fr, col0 = u.pn * BM + wc * 32 + 8 * fq;
#pragma unroll
        for (int ai = 0; ai < 2; ++ai)
#pragma unroll
            for (int m = 0; m < 4; ++m) { const int r = row0 + ai * HALF + m * 16; bf16_t* rowp = H1 + (size_t)r * DFF + col0;
#pragma unroll
                for (int bj = 0; bj < 2; ++bj) { f32x4 v0 = acc[ai][bj][m][0], v1 = acc[ai][bj][m][1];
#pragma unroll
                    for (int j = 0; j < 4; ++j) { v0[j] = fmaxf(v0[j], 0.f); v0[j] *= v0[j]; v1[j] = fmaxf(v1[j], 0.f); v1[j] *= v1[j]; }
                    u32x4 w; w.x = cvt_pk_bf16(v0[0], v0[1]); w.y = cvt_pk_bf16(v0[2], v0[3]); w.z = cvt_pk_bf16(v1[0], v1[1]); w.w = cvt_pk_bf16(v1[2], v1[3]);
                    EPI_STORE16(rowp + bj * HALF, w); } }
    }
};
struct EpiM {
    static constexpr bool PERM = true, AFTER_DRAIN = false;
    bf16_t* C; const float* bias;
    __device__ __forceinline__ void elem(int r, int c, float v) const { C[(size_t)r * DM + c] = (bf16_t)f2bf(v + (bias ? bias[c] : 0.f)); }
    __device__ __forceinline__ void operator()(const f32x4 (&acc)[2][2][4][2], const Unit& u, int wr, int wc, int fr, int fq) const {
        const int row0 = u.pm * BM + wr * 64 + fr, col0 = u.pn * BM + wc * 32 + 8 * fq;
        f32x4 bv[2][2];
#pragma unroll
        for (int bj = 0; bj < 2; ++bj)
#pragma unroll
            for (int n = 0; n < 2; ++n) bv[bj][n] = bias ? *(const f32x4*)(bias + col0 + bj * HALF + 4 * n) : (f32x4){0.f, 0.f, 0.f, 0.f};
#pragma unroll
        for (int ai = 0; ai < 2; ++ai)
#pragma unroll
            for (int m = 0; m < 4; ++m) { bf16_t* rowp = C + (size_t)(row0 + ai * HALF + m * 16) * DM + col0;
#pragma unroll
                for (int bj = 0; bj < 2; ++bj) { const f32x4 v0 = acc[ai][bj][m][0] + bv[bj][0], v1 = acc[ai][bj][m][1] + bv[bj][1];
                    u32x4 w; w.x = cvt_pk_bf16(v0[0], v0[1]); w.y = cvt_pk_bf16(v0[2], v0[3]); w.z = cvt_pk_bf16(v1[0], v1[1]); w.w = cvt_pk_bf16(v1[2], v1[3]);
                    EPI_STORE16(rowp + bj * HALF, w); } }
    }
};
}

constexpr int NWAVES = 8, NTHR = 512;
constexpr int RING_BYTES = 131072, LDS_BYTES = 153600;
constexpr int LDS_MISC_OFF = 152576;
constexpr int CW_BAR = 4096;
#ifndef TOUCH_W
#define TOUCH_W 0
#endif
#ifndef REP_MASK
#define REP_MASK 0
#endif
constexpr int PL = 9, NPH = 1 + 4 * PL;

struct Args { const float* in[N_IN]; float* out; unsigned char* ws; int ph_lo, ph_hi; };
__device__ __forceinline__ const float* arg_in(int k) {
    const auto ka = __builtin_amdgcn_kernarg_segment_ptr();
    unsigned long long p;
    asm volatile("s_load_dwordx2 %0, %1, %2\n\ts_waitcnt lgkmcnt(0)" : "=s"(p) : "s"(ka), "s"(k * 8) : "memory");
    return (const float*)p;
}

constexpr int TP_PITCH = 68, TP_WAVE_BYTES = 64 * TP_PITCH * 4;
__device__ __forceinline__ void p0_transpose_item(const float* W, int ldw, int N, int nblk, bf16* WT, int ldt, int row_off, const float* scale, LAS float* scr, int item, int lane) {
    const int kb = item / nblk, nb = item % nblk, k0 = 64 * kb, n0 = 64 * nb, c4 = 4 * (lane & 15), rq = lane >> 4;
    v4f v[16];
#pragma unroll
    for (int i = 0; i < 16; ++i) v[i] = (n0 + c4 < N) ? *(const GAS v4f*)(W + (size_t)(k0 + 4 * i + rq) * ldw + n0 + c4) : (v4f){0.f, 0.f, 0.f, 0.f};
#pragma unroll
    for (int i = 0; i < 16; ++i) { const float sc = scale ? scale[k0 + 4 * i + rq] : 1.f; *(LAS v4f*)(scr + (4 * i + rq) * TP_PITCH + c4) = v[i] * sc; }
    LDS_WAIT(); asm volatile("" ::: "memory");
    const int c = lane & 7;
#pragma unroll
    for (int jj = 0; jj < 8; ++jj) { const int n = (lane >> 3) + 8 * jj; const LAS float* sp = scr + (8 * c) * TP_PITCH + n;
        v4u o; o.x = pk2(sp[0 * TP_PITCH], sp[1 * TP_PITCH]); o.y = pk2(sp[2 * TP_PITCH], sp[3 * TP_PITCH]); o.z = pk2(sp[4 * TP_PITCH], sp[5 * TP_PITCH]); o.w = pk2(sp[6 * TP_PITCH], sp[7 * TP_PITCH]);
        if (n0 + n < N) *(GAS v4u*)(WT + (size_t)(row_off + n0 + n) * ldt + k0 + 8 * c) = o; }
    LDS_WAIT(); asm volatile("" ::: "memory");
}
constexpr int IT_SIN = (DM / 64) * ((INDIM + 63) / 64), IT_SOUT = (DI / 64) * (DM / 64), IT_LIN = (DM / 64) * (2048 / 64), IT_LAX = 8 * 2 * 4, IT_LOUT = (DR / 64) * (DM / 64),
              IT_F1 = (DM / 64) * (DFF / 64), IT_F2 = (DFF / 64) * (DM / 64), IT_PAIR = IT_SIN + IT_SOUT + IT_LIN + IT_LAX + IT_LOUT + 2 * (IT_F1 + IT_F2);

__device__ __forceinline__ void p0_prologue(const Args& a, LAS unsigned char* lds, int gw, int NGW, int wave, int lane) {
    bf16* WB = (bf16*)(a.ws + WS_W);
    LAS float* scr = (LAS float*)(lds + wave * TP_WAVE_BYTES);
    for (int it = gw; it < 2 * IT_PAIR; it += NGW) {
        const int j = it / IT_PAIR; int r = it % IT_PAIR;
        bf16* ws_ssd = WB + WE_SSD0 + (size_t)j * WE_SEND; bf16* ws_lru = WB + WE_LRU0 + (size_t)j * WE_LEND;
        if (r < IT_SIN) { p0_transpose_item(arg_in(I_SWIN) + (size_t)j * DM * INDIM, INDIM, INDIM, (INDIM + 63) / 64, ws_ssd + WE_SIN, DM, 0, arg_in(I_NMPRE) + (size_t)(2 * j) * DM, scr, r, lane); continue; } r -= IT_SIN;
        if (r < IT_SOUT) { p0_transpose_item(arg_in(I_SWOUT) + (size_t)j * DI * DM, DM, DM, DM / 64, ws_ssd + WE_SOUT, DI, 0, arg_in(I_SNORM) + (size_t)j * DI, scr, r, lane); continue; } r -= IT_SOUT;
        if (r < IT_LIN) { p0_transpose_item(arg_in(I_LWIN) + (size_t)j * DM * 2048, 2048, 2048, 2048 / 64, ws_lru + WE_LIN, DM, 0, arg_in(I_NMPRE) + (size_t)(2 * j + 1) * DM, scr, r, lane); continue; } r -= IT_LIN;
        if (r < IT_LAX) { const int blk = r >> 3, mat = (r >> 2) & 1, sub = r & 3;
            p0_transpose_item(arg_in(mat ? I_LWX : I_LWA) + ((size_t)j * 8 + blk) * 128 * 128, 128, 128, 2, ws_lru + WE_LAX + (size_t)blk * 256 * 128, 128, mat * 128, nullptr, scr, sub, lane); continue; } r -= IT_LAX;
        if (r < IT_LOUT) { p0_transpose_item(arg_in(I_LWOUT) + (size_t)j * DR * DM, DM, DM, DM / 64, ws_lru + WE_LOUT, DR, 0, nullptr, scr, r, lane); continue; } r -= IT_LOUT;
        const int f = r / (IT_F1 + IT_F2), i = 2 * j + f; r -= f * (IT_F1 + IT_F2);
        bf16* ws_ffn = WB + WE_FFN0 + (size_t)i * WE_FEND;
        if (r < IT_F1) { p0_transpose_item(arg_in(I_W1) + (size_t)i * DM * DFF, DFF, DFF, DFF / 64, ws_ffn + WE_F1, DM, 0, arg_in(I_NFPRE) + (size_t)i * DM, scr, r, lane); continue; } r -= IT_F1;
        p0_transpose_item(arg_in(I_W2) + (size_t)i * DFF * DM, DM, DM, DM / 64, ws_ffn + WE_F2, DFF, 0, nullptr, scr, r, lane);
    }
    for (int idx = gw * 64 + lane; idx < 2 * (NPAD_SSD - INDIM) * DM / 8; idx += NGW * 64) { const int j = idx / ((NPAD_SSD - INDIM) * DM / 8), o = idx % ((NPAD_SSD - INDIM) * DM / 8);
        ((GAS v4u*)(WB + WE_SSD0 + (size_t)j * WE_SEND + WE_SIN + (size_t)INDIM * DM))[o] = (v4u){0u, 0u, 0u, 0u}; }
    for (int idx = gw * 64 + lane; idx < 2 * DR; idx += NGW * 64) ((float*)(a.ws + WS_LCF))[idx] = 8.0f * softplus_f(-arg_in(I_LLAM)[idx]);
    float* X = (float*)(a.ws + WS_X); bf16* XB = (bf16*)(a.ws + WS_XB); float* RS = (float*)(a.ws + WS_RS);
    for (int r = gw; r < T; r += NGW) {
        const float* src;
        if (r < TP) { const int b = r / LP, t = r % LP; src = t < NMETA ? arg_in(I_META) + (size_t)t * DM : arg_in(I_XP) + ((size_t)b * SEQ + (t - NMETA)) * DM; }
        else src = arg_in(I_XS) + (size_t)(r - TP) * DM;
        v4f v[4]; float s = 0.f;
#pragma unroll
        for (int j = 0; j < 4; ++j) { v[j] = ((const GAS v4f*)src)[lane + 64 * j]; s += (v[j].x * v[j].x + v[j].y * v[j].y) + (v[j].z * v[j].z + v[j].w * v[j].w); }
        const float msx = wave_sum(s) * (1.f / DM) + EPS, rsx = rsqrtf(msx);
        if (lane == 0) RS[r] = sqrtf(msx);
#pragma unroll
        for (int j = 0; j < 4; ++j) {
            ((GAS v2u*)(XB + (size_t)r * DM))[lane + 64 * j] = (v2u){pk2(v[j].x * rsx, v[j].y * rsx), pk2(v[j].z * rsx, v[j].w * rsx)}; }
    }
}
__device__ __forceinline__ void resid_phase(const Args& a, const float* g, bool last, int gw, int NGW, int lane) {
    bf16* XB = (bf16*)(a.ws + WS_XB); float* RS = (float*)(a.ws + WS_RS); const bf16* Mb = (const bf16*)(a.ws + WS_M);
    v4f gg[4];
#pragma unroll
    for (int j = 0; j < 4; ++j) gg[j] = ((const GAS v4f*)g)[lane + 64 * j];
    v2u mwn[4], xwn[4]; float invn = 0.f;
    if (gw < T) { invn = RS[gw];
#pragma unroll
        for (int j = 0; j < 4; ++j) { mwn[j] = ((const GAS v2u*)(Mb + (size_t)gw * DM))[lane + 64 * j]; xwn[j] = ((const GAS v2u*)(XB + (size_t)gw * DM))[lane + 64 * j]; } }
    for (int r = gw; r < T; r += NGW) {
        v4f m[4], x[4]; float s = 0.f; const float inv = invn;
#pragma unroll
        for (int j = 0; j < 4; ++j) { m[j] = (v4f){bflo(mwn[j].x), bfhi(mwn[j].x), bflo(mwn[j].y), bfhi(mwn[j].y)};
            x[j] = (v4f){bflo(xwn[j].x), bfhi(xwn[j].x), bflo(xwn[j].y), bfhi(xwn[j].y)} * inv;
            s += (m[j].x * m[j].x + m[j].y * m[j].y) + (m[j].z * m[j].z + m[j].w * m[j].w); }
        if (r + NGW < T) { invn = RS[r + NGW];
#pragma unroll
            for (int j = 0; j < 4; ++j) { mwn[j] = ((const GAS v2u*)(Mb + (size_t)(r + NGW) * DM))[lane + 64 * j]; xwn[j] = ((const GAS v2u*)(XB + (size_t)(r + NGW) * DM))[lane + 64 * j]; } }
        const float rm = rsqrtf(wave_sum(s) * (1.f / DM) + EPS); float s2 = 0.f;
#pragma unroll
        for (int j = 0; j < 4; ++j) { x[j] = x[j] + m[j] * rm * gg[j]; s2 += (x[j].x * x[j].x + x[j].y * x[j].y) + (x[j].z * x[j].z + x[j].w * x[j].w); }
        s2 = wave_sum(s2);
        if (!last) {
            const float msx = s2 * (1.f / DM) + EPS, rsx = rsqrtf(msx);
            if (lane == 0) RS[r] = sqrtf(msx);
#pragma unroll
            for (int j = 0; j < 4; ++j) ((GAS v2u*)(XB + (size_t)r * DM))[lane + 64 * j] = (v2u){pk2(x[j].x * rsx, x[j].y * rsx), pk2(x[j].z * rsx, x[j].w * rsx)};
        } else {
            float* dst = nullptr;
            if (r < TP) { const int b = r / LP, t = r % LP; if (t >= NMETA) dst = a.out + O_YP + ((size_t)b * SEQ + (t - NMETA)) * DM; }
            else dst = a.out + O_YS + (size_t)(r - TP) * DM;
            if (dst) {
#pragma unroll
                for (int j = 0; j < 4; ++j) ((GAS v4f*)dst)[lane + 64 * j] = x[j]; }
        }
    }
}


#ifndef SUBREP
#define SUBREP 0
#endif
typedef short bf16x8 __attribute__((ext_vector_type(8)));
typedef short bf16x4 __attribute__((ext_vector_type(4)));
constexpr int NCH = 17, N_CITEMS = NB * NCH * NG;
constexpr int YSP = 264;
constexpr int XS = 136;
constexpr size_t SC_CST = 0;
constexpr size_t SC_HPREV = SC_CST + (size_t)NB * NCH * NH * HD * NST * 2;
constexpr size_t SC_DEC = SC_HPREV + (size_t)NB * NCH * NH * HD * NST * 2;
constexpr size_t SC_END = SC_DEC + 65536;
static_assert(SC_END <= 400 * MiB, "ssd scratch");

struct SsdItem { int b, c, g, Q, row0; };
__device__ __forceinline__ SsdItem ssd_item(int item) { SsdItem it; it.g = item % NG;
    if (item < NB * 16 * NG) { it.c = 1 + (item / NG) % 16; it.b = item / (NG * 16); } else { it.c = 0; it.b = (item - NB * 16 * NG) / NG; }
    it.Q = it.c == 0 ? NMETA : 128; it.row0 = it.b * LP + (it.c == 0 ? 0 : NMETA + 128 * (it.c - 1)); return it; }

struct DtRaw { float r0, r1; };
__device__ __forceinline__ DtRaw ssd_dt_load(const float* DT, int row0, int Q, int h, int lane) { DtRaw d; d.r0 = 0.f; d.r1 = 0.f;
    if (lane < Q) d.r0 = DT[(size_t)(row0 + lane) * 32 + h];
    if (lane + 64 < Q) d.r1 = DT[(size_t)(row0 + lane + 64) * 32 + h];
    return d; }
__device__ __forceinline__ float ssd_dt_finish(const DtRaw dr, int Q, float dtb, float Aneg, LAS float* dtl, LAS float* csl, int lane) {
    float d0 = 0.f, d1 = 0.f;
    if (lane < Q) d0 = softplus_f(dr.r0 + dtb);
    if (lane + 64 < Q) d1 = softplus_f(dr.r1 + dtb);
    float a0 = d0 * Aneg, a1 = d1 * Aneg;
#pragma unroll
    for (int o = 1; o < 64; o <<= 1) { const float t0 = __shfl_up(a0, o), t1 = __shfl_up(a1, o); if (lane >= o) { a0 += t0; a1 += t1; } }
    const float tot0 = __shfl(a0, 63); a1 += tot0;
    const float tot = __shfl(a1, 63);
    dtl[lane] = d0; dtl[lane + 64] = d1; csl[lane] = a0; csl[lane + 64] = a1;
    return tot;
}
__device__ __forceinline__ float ssd_dt_cs(const float* DT, int row0, int Q, int h, float dtb, float Aneg, LAS float* dtl, LAS float* csl, int lane) {
    return ssd_dt_finish(ssd_dt_load(DT, row0, Q, h, lane), Q, dtb, Aneg, dtl, csl, lane); }


__device__ __forceinline__ float bf_elem(const v4u& w, int k) { const unsigned x = k < 2 ? w.x : k < 4 ? w.y : k < 6 ? w.z : w.w; return (k & 1) ? bfhi(x) : bflo(x); }
struct NoMid { __device__ __forceinline__ void operator()() const {} };
template <bool ROWMAJOR, class Mid>
__device__ __forceinline__ void ssd_conv_lane(const bf16* src  , bool hasprev, const float* cw, const float* cb, int cc, LAS bf16* dst, float* cso  , int Q, const Mid& mid) {
    v4u raw[19];
#pragma unroll
    for (int i = 0; i < 3; ++i) { const v4u t = *(const GAS v4u*)(src + (ptrdiff_t)(hasprev ? i - 3 : 0) * ZXW); raw[i] = hasprev ? t : (v4u){0u, 0u, 0u, 0u}; }
#pragma unroll
    for (int i = 0; i < 16; ++i) raw[3 + i] = *(const GAS v4u*)(src + (size_t)i * ZXW);
    v4f wv[4][2], bv[2];
#pragma unroll
    for (int t = 0; t < 4; ++t) { wv[t][0] = *(const GAS v4f*)(cw + (size_t)t * CONVD + cc); wv[t][1] = *(const GAS v4f*)(cw + (size_t)t * CONVD + cc + 4); }
    bv[0] = *(const GAS v4f*)(cb + cc); bv[1] = *(const GAS v4f*)(cb + cc + 4);
    mid();
    if (cso) {
#pragma unroll
        for (int i = 0; i < 3; ++i) { float* o = cso + (size_t)i * CONVD + cc; const v4u w = raw[16 + i];
            *(GAS v4f*)o = (v4f){bflo(w.x), bfhi(w.x), bflo(w.y), bfhi(w.y)}; *(GAS v4f*)(o + 4) = (v4f){bflo(w.z), bfhi(w.z), bflo(w.w), bfhi(w.w)}; } }
#pragma unroll
    for (int kp = 0; kp < 4; ++kp) { const int k = 2 * kp;
        const v2f w0 = (v2f){wv[0][k >> 2][k & 3], wv[0][k >> 2][(k & 3) + 1]}, w1 = (v2f){wv[1][k >> 2][k & 3], wv[1][k >> 2][(k & 3) + 1]},
                  w2 = (v2f){wv[2][k >> 2][k & 3], wv[2][k >> 2][(k & 3) + 1]}, w3 = (v2f){wv[3][k >> 2][k & 3], wv[3][k >> 2][(k & 3) + 1]}, bb = (v2f){bv[k >> 2][k & 3], bv[k >> 2][(k & 3) + 1]};
#define RAW2(i) ((v2f){bf_elem(raw[i], k), bf_elem(raw[i], k + 1)})
        v2f x0 = RAW2(0), x1 = RAW2(1), x2 = RAW2(2);
        unsigned pa[4], pb[4]; v2f pv = (v2f){0.f, 0.f}; LAS bf16* d0 = dst + k * XS; LAS bf16* d1 = d0 + XS;
#pragma unroll
        for (int i = 0; i < 16; ++i) { const v2f x3 = RAW2(3 + i);
            const v2f t = bb + w0 * x0 + w1 * x1 + w2 * x2 + w3 * x3;
            v2f e; e.x = __expf(-t.x); e.y = __expf(-t.y); e = e + 1.0f;
            v2f rr; rr.x = __builtin_amdgcn_rcpf(e.x); rr.y = __builtin_amdgcn_rcpf(e.y);
            const v2f v = t * rr;
            if (!ROWMAJOR) { if (i & 1) { pa[(i >> 1) & 3] = pg8::cvt_pk_bf16(pv.x, v.x); pb[(i >> 1) & 3] = pg8::cvt_pk_bf16(pv.y, v.y);
                    if ((i & 7) == 7) { *(LAS v4u*)(d0 + (i - 7)) = (v4u){pa[0], pa[1], pa[2], pa[3]}; *(LAS v4u*)(d1 + (i - 7)) = (v4u){pb[0], pb[1], pb[2], pb[3]}; } } else pv = v; }
            else *(LAS unsigned*)(dst + i * XS + k) = pg8::cvt_pk_bf16(v.x, v.y);
            x0 = x1; x1 = x2; x2 = x3; }
#undef RAW2
        if (!ROWMAJOR && Q < 32) { *(LAS v4u*)(d0 + 16) = (v4u){0u, 0u, 0u, 0u}; *(LAS v4u*)(d0 + 24) = (v4u){0u, 0u, 0u, 0u}; *(LAS v4u*)(d1 + 16) = (v4u){0u, 0u, 0u, 0u}; *(LAS v4u*)(d1 + 24) = (v4u){0u, 0u, 0u, 0u}; }
        __builtin_amdgcn_sched_barrier(0); }
}
template <bool SA, class Mid>
__device__ __forceinline__ void ssd_conv_tile(const bf16* ZX, int row0, int g, int Q, bool hasprev, const float* cw, const float* cb, LAS bf16* XT, LAS bf16* Bd, LAS bf16* Cs,
                                              float* cso_base, int lane, int wave, const Mid& mid) {
    const int cg = lane & 31, rh = lane >> 5, wq = wave & 3, s0 = 32 * wq + 16 * rh; const bool isx = wave < 4;
    const bool active = s0 < Q && !(!isx && SA && cg >= 16);
    const int cc = isx ? 256 * g + 8 * cg : (cg < 16 ? DI + 128 * g + 8 * cg : DI + NG * NST + 128 * g + 8 * (cg - 16));
    const bf16* src = ZX + (size_t)(row0 + s0) * ZXW + DI + cc;
    float* cso = (cso_base && s0 + 16 == Q) ? cso_base : nullptr;
    if (isx) { if (active) ssd_conv_lane<false>(src, hasprev || s0 > 0, cw, cb, cc, XT + (8 * cg) * XS + s0, cso, Q, mid); }
    else if (SA) { if (active) ssd_conv_lane<false>(src, hasprev || s0 > 0, cw, cb, cc, Bd + (8 * cg) * XS + s0, cso, Q, NoMid()); }
    else { if (active) ssd_conv_lane<true>(src, hasprev || s0 > 0, cw, cb, cc, (cg < 16 ? Bd + 8 * cg : Cs + 8 * (cg - 16)) + s0 * XS, cso, Q, NoMid()); }
}

__device__ __forceinline__ void ssd_phase_a(unsigned char* ws, float* out, LAS unsigned char* lds, int j, int tid, int lane, int wave) {
    const bf16* ZX = (const bf16*)(ws + WS_ZX); const float* DT = (const float*)(ws + WS_DT); bf16* YN = (bf16*)(ws + WS_YN);
    bf16* CST = (bf16*)(ws + WS_SCR + SC_CST); float* DEC = (float*)(ws + WS_SCR + SC_DEC);
    const float* cw = arg_in(I_SCW) + (size_t)j * 4 * CONVD; const float* cb = arg_in(I_SCB) + (size_t)j * CONVD;
    const float* dtbias = arg_in(I_SDTB) + j * NH; const float* alog = arg_in(I_SALOG) + j * NH; const float* dsk = arg_in(I_SD) + j * NH;
    LAS bf16* XWT = (LAS bf16*)lds;
    LAS bf16* BT = XWT + 256 * XS;
    LAS float* DTL = (LAS float*)(BT + 128 * XS);
    LAS float* CSL = DTL + 512;
    LAS float* WL = CSL + 512;
    const int tid0 = tid;
    const int n_all = N_CITEMS + NS * NG, n_ext = (SUBREP & 4) ? n_all + NS * NG : (SUBREP & 32) ? n_all + 1024 : n_all;
    for (int item_ = blockIdx.x; item_ < n_ext; item_ += gridDim.x) {
        const int item = item_ < n_all ? item_ : (SUBREP & 32) ? item_ - n_all : item_ - NS * NG;
        int tid = tid0; asm volatile("" : "+v"(tid));
        const int lane = tid & 63, fr = lane & 15, fq = lane >> 4;
        __syncthreads();
        if (item < N_CITEMS) {
            const SsdItem it = ssd_item(item); const int Q = it.Q;
            ssd_conv_tile<true>(ZX, it.row0, it.g, Q, it.c > 0, cw, cb, XWT, BT, nullptr, nullptr, lane, wave, NoMid());
            if (SUBREP & 1) { asm volatile("" ::: "memory"); ssd_conv_tile<true>(ZX, it.row0, it.g, Q, it.c > 0, cw, cb, XWT, BT, nullptr, nullptr, lane, wave, NoMid()); }
            if (wave >= 4) { const int hh = wave - 4, h = 4 * it.g + hh;
                const float tot = ssd_dt_cs(DT, it.row0, Q, h, dtbias[h], -__expf(alog[h]), DTL + hh * 128, CSL + hh * 128, lane);
                LDS_WAIT();
                WL[hh * 128 + lane] = DTL[hh * 128 + lane] * __expf(tot - CSL[hh * 128 + lane]);
                WL[hh * 128 + lane + 64] = DTL[hh * 128 + lane + 64] * __expf(tot - CSL[hh * 128 + lane + 64]);
                if (lane == 0) DEC[(it.b * NCH + it.c) * NH + h] = __expf(tot); }
            __syncthreads();
            for (int rep_ = 0; rep_ < ((SUBREP & 2) ? 2 : 1); ++rep_) { asm volatile("" ::: "memory");
            pg8::f32x4 acc[2][8];
#pragma unroll
            for (int mi = 0; mi < 2; ++mi)
#pragma unroll
                for (int ni = 0; ni < 8; ++ni) acc[mi][ni] = (pg8::f32x4){0.f, 0.f, 0.f, 0.f};
            const int nkb = Q < 32 ? 1 : Q / 32;
            for (int kb = 0; kb < nkb; ++kb) {
                bf16x8 a[2], bq[8];
#pragma unroll
                for (int mi = 0; mi < 2; ++mi) a[mi] = *(const LAS bf16x8*)(XWT + (32 * wave + 16 * mi + fr) * XS + 32 * kb + 8 * fq);
                { const LAS float* wlp = WL + (wave >> 1) * 128 + 32 * kb + 8 * fq;
                  const v4f wa = *(const LAS v4f*)wlp, wb = *(const LAS v4f*)(wlp + 4);
#pragma unroll
                  for (int mi = 0; mi < 2; ++mi) { const v4u xa = __builtin_bit_cast(v4u, a[mi]);
                      a[mi] = __builtin_bit_cast(bf16x8, (v4u){pg8::cvt_pk_bf16(bflo(xa.x) * wa.x, bfhi(xa.x) * wa.y), pg8::cvt_pk_bf16(bflo(xa.y) * wa.z, bfhi(xa.y) * wa.w),
                                                               pg8::cvt_pk_bf16(bflo(xa.z) * wb.x, bfhi(xa.z) * wb.y), pg8::cvt_pk_bf16(bflo(xa.w) * wb.z, bfhi(xa.w) * wb.w)}); } }
#pragma unroll
                for (int ni = 0; ni < 8; ++ni) bq[ni] = *(const LAS bf16x8*)(BT + (16 * ni + fr) * XS + 32 * kb + 8 * fq);
#pragma unroll
                for (int mi = 0; mi < 2; ++mi)
#pragma unroll
                    for (int ni = 0; ni < 8; ++ni) acc[mi][ni] = __builtin_amdgcn_mfma_f32_16x16x32_bf16(bq[ni], a[mi], acc[mi][ni], 0, 0, 0);
            }
            { LAS bf16* stg = XWT + (32 * wave) * XS;
#pragma unroll
              for (int mi = 0; mi < 2; ++mi)
#pragma unroll
                for (int ni = 0; ni < 8; ++ni) *(LAS v2u*)(stg + (16 * mi + fr) * XS + 16 * ni + 4 * fq) = (v2u){pg8::cvt_pk_bf16(acc[mi][ni][0], acc[mi][ni][1]), pg8::cvt_pk_bf16(acc[mi][ni][2], acc[mi][ni][3])};
              const int hp0 = 32 * wave, h = 4 * it.g + (hp0 >> 6), p0 = hp0 & 63;
              bf16* dstb = CST + ((((size_t)(it.b * NCH + it.c) * NH + h) * HD + p0) * NST);
#pragma unroll
              for (int i = 0; i < 8; ++i) { const int rr = 4 * i + (lane >> 4), c16 = lane & 15;
                  *(GAS v4u*)(dstb + rr * NST + 8 * c16) = *(const LAS v4u*)(stg + rr * XS + 8 * c16); } }
            }
        } else {
            const int si = (item - N_CITEMS) / NG, g = (item - N_CITEMS) % NG, row = TP + si;
            LAS float* xs = (LAS float*)lds; LAS float* Bsm = xs + 256; LAS float* Csm = Bsm + 128; LAS float* dtv = Csm + 128; LAS float* dAv = dtv + 4; LAS float* yv = dAv + 4;
            { const int cc = tid < 256 ? 256 * g + tid : (tid < 384 ? DI + 128 * g + (tid - 256) : DI + NG * NST + 128 * g + (tid - 384));
              const float* sp = arg_in(I_SSC) + (((size_t)j * NS + si) * 3) * CONVD + cc;
              const float s0 = sp[0], s1 = sp[CONVD], s2 = sp[2 * CONVD], x3 = bf2f(ZX[(size_t)row * ZXW + DI + cc]);
              const float v = silu_f(cb[cc] + cw[cc] * s0 + cw[CONVD + cc] * s1 + cw[2 * CONVD + cc] * s2 + cw[3 * CONVD + cc] * x3);
              xs[tid] = v;
              float* op = out + O_SSC + (((size_t)j * NS + si) * 3) * CONVD + cc; op[0] = s1; op[CONVD] = s2; op[2 * CONVD] = x3; }
            if (tid < 4) { const int h = 4 * g + tid; const float d = softplus_f(DT[(size_t)row * 32 + h] + dtbias[h]); dtv[tid] = d; dAv[tid] = __expf(-d * __expf(alog[h])); }
            __syncthreads();
            v2u zz_ = (v2u){0u, 0u}; if (wave == 0) zz_ = *(const GAS v2u*)(ZX + (size_t)row * ZXW + 256 * g + 4 * lane);
            { const int r = wave >> 1, h = 4 * g + r; const float d = dtv[r], dA = dAv[r], Dh = dsk[h];
              const v2f Bv = *(const LAS v2f*)(Bsm + 2 * lane), Cv = *(const LAS v2f*)(Csm + 2 * lane);
              const float* h0 = arg_in(I_SSH) + ((((size_t)j * NS + si) * NH + h) * HD + 32 * (wave & 1)) * NST; float* ho = out + O_SSH + ((((size_t)j * NS + si) * NH + h) * HD + 32 * (wave & 1)) * NST;
              LAS float* PR = (LAS float*)(lds + 8192) + wave * (32 * 65);
              v2f hv[32];
#pragma unroll
              for (int pp = 0; pp < 32; ++pp) hv[pp] = *(const GAS v2f*)(h0 + (size_t)pp * NST + 2 * lane);
#pragma unroll
              for (int pp = 0; pp < 32; ++pp) { const float xdt = xs[64 * r + 32 * (wave & 1) + pp] * d;
                  hv[pp].x = fmaf(hv[pp].x, dA, xdt * Bv.x); hv[pp].y = fmaf(hv[pp].y, dA, xdt * Bv.y);
                  *(GAS v2f*)(ho + (size_t)pp * NST + 2 * lane) = hv[pp];
                  PR[pp * 65 + lane] = Cv.x * hv[pp].x + Cv.y * hv[pp].y; }
              LDS_WAIT();
              if (lane < 32) { float y = 0.f;
#pragma unroll 16
                  for (int k = 0; k < 64; ++k) y += PR[lane * 65 + k];
                  const int p = 32 * (wave & 1) + lane; yv[64 * r + p] = y + Dh * xs[64 * r + p]; } }
            __syncthreads();
            if (wave == 0) { const int c0 = 256 * g + 4 * lane; const v2u zz = zz_;
                const v4f y = *(const LAS v4f*)(yv + 4 * lane);
                const float v0 = y.x * silu_f(bflo(zz.x)), v1 = y.y * silu_f(bfhi(zz.x)), v2 = y.z * silu_f(bflo(zz.y)), v3 = y.w * silu_f(bfhi(zz.y));
                const float rs = rsqrtf(wave_sum(v0 * v0 + v1 * v1 + v2 * v2 + v3 * v3) * (1.f / 256.f) + EPS);
                *(GAS v2u*)(YN + (size_t)row * DI + c0) = (v2u){pk2(v0 * rs, v1 * rs), pk2(v2 * rs, v3 * rs)}; }
        }
    }
}

__device__ __forceinline__ void ssd_phase_b(unsigned char* ws, float* out, int j, int tid) {
    const bf16* CST = (const bf16*)(ws + WS_SCR + SC_CST); const float* DEC = (const float*)(ws + WS_SCR + SC_DEC); bf16* HPREV = (bf16*)(ws + WS_SCR + SC_HPREV);
    constexpr int PER_B = NH * HD * NST / 8;
    for (int idx = blockIdx.x * NTHR + tid; idx < NB * PER_B; idx += gridDim.x * NTHR) {
        const int b = idx / PER_B, e = (idx % PER_B) * 8, h = e / (HD * NST);
        v4f H0 = (v4f){0.f, 0.f, 0.f, 0.f}, H1 = H0;
#pragma unroll 4
        for (int c = 0; c < NCH; ++c) {
            const size_t off = (size_t)(b * NCH + c) * (NH * HD * NST) + e;
            if (c > 0) *(GAS v4u*)(HPREV + off) = (v4u){pk2(H0.x, H0.y), pk2(H0.z, H0.w), pk2(H1.x, H1.y), pk2(H1.z, H1.w)};
            const float dec = DEC[(b * NCH + c) * NH + h];
            const v4u sw = *(const GAS v4u*)(CST + off); const v4f s0 = (v4f){bflo(sw.x), bfhi(sw.x), bflo(sw.y), bfhi(sw.y)}, s1 = (v4f){bflo(sw.z), bfhi(sw.z), bflo(sw.w), bfhi(sw.w)};
            H0 = H0 * dec + s0; H1 = H1 * dec + s1;
        }
        float* op = out + O_PSH + ((size_t)j * NB + b) * (NH * HD * NST) + e;
        *(GAS v4f*)op = H0; *(GAS v4f*)(op + 4) = H1;
    }
}

__device__ __forceinline__ void ssd_phase_c(unsigned char* ws, float* out, LAS unsigned char* lds, int j, int tid0, int, int wave) {
    const bf16* ZX = (const bf16*)(ws + WS_ZX); const float* DT = (const float*)(ws + WS_DT); bf16* YN = (bf16*)(ws + WS_YN);
    const bf16* HPREV = (const bf16*)(ws + WS_SCR + SC_HPREV);
    const float* cw = arg_in(I_SCW) + (size_t)j * 4 * CONVD; const float* cb = arg_in(I_SCB) + (size_t)j * CONVD;
    const float* dtbias = arg_in(I_SDTB) + j * NH; const float* alog = arg_in(I_SALOG) + j * NH; const float* dsk = arg_in(I_SD) + j * NH;
    LAS bf16* XT = (LAS bf16*)lds;
    LAS bf16* Bs = XT + 256 * XS;
    LAS bf16* Cs = Bs + 128 * XS;
    LAS float* DTL = (LAS float*)(Cs + 128 * XS);
    LAS float* CSL = DTL + 512;
    for (int item = blockIdx.x; item < N_CITEMS; item += gridDim.x) {
        const SsdItem it = ssd_item(item); const int Q = it.Q;
        int tid = tid0; asm volatile("" : "+v"(tid));
        const int lane = tid & 63, fr = lane & 15, fq = lane >> 4;
        __syncthreads();
        const bool fuse = Q == 128; DtRaw dr; dr.r0 = 0.f; dr.r1 = 0.f;
        const float dtb_ = dtbias[4 * it.g + (wave & 3)], an_ = -__expf(alog[4 * it.g + (wave & 3)]);
        if (wave < 4) { const int h = 4 * it.g + wave; if (fuse) dr = ssd_dt_load(DT, it.row0, Q, h, lane); else (void)ssd_dt_cs(DT, it.row0, Q, h, dtb_, an_, DTL + wave * 128, CSL + wave * 128, lane); }
        { float* cso = (it.c == NCH - 1) ? out + O_PSC + (((size_t)j * NB + it.b) * 3) * CONVD : nullptr;
          auto mid = [&]() { if (fuse) (void)ssd_dt_finish(dr, Q, dtb_, an_, DTL + wave * 128, CSL + wave * 128, lane); };
          ssd_conv_tile<false>(ZX, it.row0, it.g, Q, it.c > 0, cw, cb, XT, Bs, Cs, cso, lane, wave, mid); }
        __syncthreads();
        const int l0 = 16 * wave, nlt = Q / 16;
        pg8::f32x4 ST[8];
        if (l0 < Q) {
            bf16x8 cf[4];
#pragma unroll
            for (int kb = 0; kb < 4; ++kb) cf[kb] = *(const LAS bf16x8*)(Cs + (l0 + fr) * XS + 32 * kb + 8 * fq);
#pragma unroll
            for (int t = 0; t < 8; ++t) { ST[t] = (pg8::f32x4){0.f, 0.f, 0.f, 0.f};
                if (t <= wave) {
#pragma unroll
                    for (int kb = 0; kb < 4; ++kb) { const bf16x8 bfrag = *(const LAS bf16x8*)(Bs + (16 * t + fr) * XS + 32 * kb + 8 * fq);
                        ST[t] = __builtin_amdgcn_mfma_f32_16x16x32_bf16(bfrag, cf[kb], ST[t], 0, 0, 0); } } }
        }
        __syncthreads();
        LAS bf16* CBL = Bs;
        if (l0 < Q) {
#pragma unroll
            for (int t = 0; t < 8; ++t) if (t <= wave) *(LAS v2u*)(CBL + (l0 + fr) * XS + 16 * t + 4 * fq) = (v2u){pk2(ST[t][0], ST[t][1]), pk2(ST[t][2], ST[t][3])};
        }
        const int r = wave >> 1, ph = wave & 1, h = 4 * it.g + r, hp0 = 64 * r + 32 * ph;
        const bool hasprev = it.c > 0;
        bf16x8 hf[2][4];
        if (hasprev) { const bf16* hpb = HPREV + ((((size_t)(it.b * NCH + it.c) * NH + h) * HD) + 32 * ph + fr) * NST + 8 * fq;
#pragma unroll
            for (int pt = 0; pt < 2; ++pt)
#pragma unroll
                for (int kb = 0; kb < 4; ++kb) hf[pt][kb] = *(const GAS bf16x8*)(hpb + (size_t)(16 * pt) * NST + 32 * kb); }
        __syncthreads();
        const LAS float* csr = CSL + r * 128; const LAS float* dtr = DTL + r * 128; const float Dh = dsk[h];
        float csl[8];
#pragma unroll
        for (int u = 0; u < 8; ++u) csl[u] = csr[(16 * u + fr) & 127];
        pg8::f32x4 ay[2][8];
#pragma unroll
        for (int u = 0; u < 8; ++u) { ay[0][u] = (pg8::f32x4){0.f, 0.f, 0.f, 0.f}; ay[1][u] = ay[0][u]; }
        const int zl = lane >> 2, zck = lane & 3;
        const bf16* zb = ZX + (size_t)(it.row0 + zl) * ZXW + 256 * it.g + hp0 + 8 * zck;
        LAS unsigned char* stg = (LAS unsigned char*)(XT + hp0 * XS);
        const int stg_lin = zl * 64 + 16 * (zck ^ ((zl >> 2) & 3));
        const int stg_acc = fr * 64 + 8 * (fq & 1);
        const int stg_x = (fr >> 2) & 3, stg_c = fq >> 1;
#pragma unroll
        for (int kb = 0; kb < 4; ++kb) if (32 * kb < Q) {
            bf16x8 xf[2];
#pragma unroll
            for (int pt = 0; pt < 2; ++pt) xf[pt] = *(const LAS bf16x8*)(XT + (hp0 + 16 * pt + fr) * XS + 32 * kb + 8 * fq);
            const v4f c0 = *(const LAS v4f*)(csr + 32 * kb + 8 * fq), c1 = *(const LAS v4f*)(csr + 32 * kb + 8 * fq + 4);
            const v4f d0 = *(const LAS v4f*)(dtr + 32 * kb + 8 * fq), d1 = *(const LAS v4f*)(dtr + 32 * kb + 8 * fq + 4);
            const float csv[8] = {c0.x, c0.y, c0.z, c0.w, c1.x, c1.y, c1.z, c1.w}, dtv[8] = {d0.x, d0.y, d0.z, d0.w, d1.x, d1.y, d1.z, d1.w};
#pragma unroll
            for (int u = 2 * kb; u < 8; ++u) if (u < nlt) {
                const v4u raw = *(const LAS v4u*)(CBL + (16 * u + fr) * XS + 32 * kb + 8 * fq);
                const float cbv[8] = {bflo(raw.x), bfhi(raw.x), bflo(raw.y), bfhi(raw.y), bflo(raw.z), bfhi(raw.z), bflo(raw.w), bfhi(raw.w)};
                const int lrow = 16 * u + fr; float e[8];
#pragma unroll
                for (int jj = 0; jj < 8; ++jj) { const int sidx = 32 * kb + 8 * fq + jj; e[jj] = (sidx <= lrow && sidx < Q) ? cbv[jj] * __expf(csl[u] - csv[jj]) * dtv[jj] : 0.f;
                    if (sidx == lrow) e[jj] += Dh; }
                const bf16x8 sf = __builtin_bit_cast(bf16x8, (v4u){pk2(e[0], e[1]), pk2(e[2], e[3]), pk2(e[4], e[5]), pk2(e[6], e[7])});
#pragma unroll
                for (int pt = 0; pt < 2; ++pt) ay[pt][u] = __builtin_amdgcn_mfma_f32_16x16x32_bf16(xf[pt], sf, ay[pt][u], 0, 0, 0);
            }
            __builtin_amdgcn_sched_barrier(0);
        }
        if (hasprev) {
#pragma unroll
            for (int u = 0; u < 8; ++u) { const float ecs = __expf(csl[u]); pg8::f32x4 ao0 = (pg8::f32x4){0.f, 0.f, 0.f, 0.f}, ao1 = ao0;
#pragma unroll
                for (int kb = 0; kb < 4; ++kb) { const bf16x8 cfr = *(const LAS bf16x8*)(Cs + (16 * u + fr) * XS + 32 * kb + 8 * fq);
                    ao0 = __builtin_amdgcn_mfma_f32_16x16x32_bf16(hf[0][kb], cfr, ao0, 0, 0, 0); ao1 = __builtin_amdgcn_mfma_f32_16x16x32_bf16(hf[1][kb], cfr, ao1, 0, 0, 0); }
                ay[0][u] = ay[0][u] + ao0 * ecs; ay[1][u] = ay[1][u] + ao1 * ecs; } }
        __builtin_amdgcn_sched_barrier(0);
        v2u zz[2][8];
        { v4u zr[8];
#pragma unroll
          for (int i = 0; i < 8; ++i) zr[i] = *(const GAS v4u*)(zb + (size_t)(16 * (i < nlt ? i : 0)) * ZXW);
#pragma unroll
          for (int i = 0; i < 8; ++i) *(LAS v4u*)(stg + 1024 * i + stg_lin) = zr[i]; }
#pragma unroll
        for (int u = 0; u < 8; ++u)
#pragma unroll
            for (int pt = 0; pt < 2; ++pt) zz[pt][u] = *(const LAS v2u*)(stg + 1024 * u + stg_acc + 16 * ((2 * pt + stg_c) ^ stg_x));
        float ssq[8];
#pragma unroll
        for (int u = 0; u < 8; ++u) { ssq[u] = 0.f; if (u < nlt) {
#pragma unroll
            for (int pt = 0; pt < 2; ++pt) { const v2u zw = zz[pt][u]; const float zf[4] = {bflo(zw.x), bfhi(zw.x), bflo(zw.y), bfhi(zw.y)};
#pragma unroll
                for (int q = 0; q < 4; ++q) { const float y = ay[pt][u][q] * silu_f(zf[q]); ay[pt][u][q] = y; ssq[u] += y * y; } }
            ssq[u] += xor16_f(ssq[u], lane); ssq[u] += xor32_f(ssq[u], lane); } }
        LAS float* SSQ = CSL + 512;
        if (fq == 0) {
#pragma unroll
            for (int u = 0; u < 8; ++u) if (u < nlt) SSQ[wave * 128 + 16 * u + fr] = ssq[u]; }
        __syncthreads();
        {
#pragma unroll
            for (int u = 0; u < 8; ++u) if (u < nlt) { float tsum = SSQ[(2 * fq) * 128 + 16 * u + fr] + SSQ[(2 * fq + 1) * 128 + 16 * u + fr];
                tsum += xor16_f(tsum, lane); tsum += xor32_f(tsum, lane);
                const float rs = rsqrtf(tsum * (1.f / 256.f) + EPS);
#pragma unroll
                for (int pt = 0; pt < 2; ++pt) *(LAS v2u*)(stg + 1024 * u + stg_acc + 16 * ((2 * pt + stg_c) ^ stg_x)) = (v2u){pk2(ay[pt][u][0] * rs, ay[pt][u][1] * rs), pk2(ay[pt][u][2] * rs, ay[pt][u][3] * rs)}; }
            bf16* yb = YN + (size_t)(it.row0 + zl) * DI + 256 * it.g + hp0 + 8 * zck;
#pragma unroll
            for (int i = 0; i < 8; ++i) if (i < nlt) *(GAS v4u*)(yb + (size_t)(16 * i) * DI) = *(const LAS v4u*)(stg + 1024 * i + stg_lin); }
    }
}

constexpr size_t SC_LSUM = 0;
constexpr size_t SC_LSUB = SC_LSUM + (size_t)NB * NCH * DR * 2 * 4;
constexpr size_t SC_LAB = SC_LSUB + (size_t)NB * NCH * 8 * DR * 2 * 4;
template <bool FINAL>
__device__ __forceinline__ void lru_phase(unsigned char* ws, float* out, LAS unsigned char* lds, int j, int tid0, int, int wave) {
    const bf16* G = (const bf16*)(ws + WS_ZX); const bf16* XRAW = G + (size_t)T * DR; bf16* YL = (bf16*)(ws + WS_YN);
    const bf16* WAX = (const bf16*)(ws + WS_W) + WE_LRU0 + (size_t)j * WE_LEND + WE_LAX;
    float* LSUM = (float*)(ws + WS_SCR + SC_LSUM); float* LSUB = (float*)(ws + WS_SCR + SC_LSUB); unsigned* LAB = (unsigned*)(ws + WS_SCR + SC_LAB); const float* LCF = (const float*)(ws + WS_LCF) + (size_t)j * DR;
    const float* cw = arg_in(I_LCW) + (size_t)j * 4 * DR; const float* cb = arg_in(I_LCB) + (size_t)j * DR;
    const float* ba = arg_in(I_LBA) + (size_t)j * DR; const float* bx = arg_in(I_LBX) + (size_t)j * DR;
    LAS bf16* WL = (LAS bf16*)lds;
    LAS bf16* XR = WL + 256 * XS;
    LAS bf16* GL = XR + 128 * XS;
    LAS float* WSUM = (LAS float*)(GL + 128 * XS);
    LAS float* CHC = WSUM + 8 * 128 * 2;
    const int nitems = FINAL ? N_CITEMS + 8 : N_CITEMS;
    int kb_staged = -1;
    bool srep_ = false;
    for (int item = blockIdx.x; item < nitems; item += gridDim.x) {
        int tid = tid0; asm volatile("" : "+v"(tid));
        const int lane = tid & 63, fr = lane & 15, fq = lane >> 4;
        const bool samp = item >= N_CITEMS;
        int b = 0, c = -1, kb, Q = 128, row0 = TP;
        if (!samp) { const SsdItem it = ssd_item(item); kb = it.g; c = it.c; b = it.b; Q = it.Q; row0 = it.row0; }
        else kb = item - N_CITEMS;
        if (FINAL && !samp) {
            const int c4 = tid & 31, rg = tid >> 5, nrg = Q / 8, r0 = 8 * rg, dg4 = kb * 128 + 4 * c4;
            LAS float* QS = (LAS float*)lds;
            LAS float* HINL = QS + 16 * 128 * 2;
            __syncthreads();
            v4u ab[8]; v2u gq[8];
            v2f cs_[NCH - 1];
            if (tid < 128) { const int dg = kb * 128 + tid;
#pragma unroll
                for (int cp = 0; cp < NCH - 1; ++cp) { const v2f t = *(const GAS v2f*)(LSUM + ((size_t)(b * NCH + (cp < c ? cp : 0)) * DR + dg) * 2); const float mk = cp < c ? 1.f : 0.f;
                    cs_[cp].x = 1.f + mk * (t.x - 1.f); cs_[cp].y = mk * t.y; } }
            { const int rr = rg < nrg ? r0 : 0;
              const unsigned* labp = LAB + (size_t)(row0 + rr) * DR + dg4; const bf16* gp = G + (size_t)(row0 + rr) * DR + dg4;
#pragma unroll
              for (int i = 0; i < 8; ++i) { ab[i] = *(const GAS v4u*)(labp + (size_t)i * DR); gq[i] = *(const GAS v2u*)(gp + (size_t)i * DR); } }
            if (tid < 128) { float h = 0.f;
#pragma unroll
                for (int cp = 0; cp < NCH - 1; ++cp) h = cs_[cp].x * h + cs_[cp].y;
                HINL[tid] = h; }
            float av[8][4]; v4f A4 = (v4f){1.f, 1.f, 1.f, 1.f}, H4 = (v4f){0.f, 0.f, 0.f, 0.f};
#pragma unroll
            for (int i = 0; i < 8; ++i) { const v4u w = ab[i];
                av[i][0] = __expf(bflo(w.x)); av[i][1] = __expf(bflo(w.y)); av[i][2] = __expf(bflo(w.z)); av[i][3] = __expf(bflo(w.w));
                const v4f a4 = (v4f){av[i][0], av[i][1], av[i][2], av[i][3]}, b4 = (v4f){bfhi(w.x), bfhi(w.y), bfhi(w.z), bfhi(w.w)};
                H4 = a4 * H4 + b4; A4 = A4 * a4; }
            if (rg < nrg) { *(LAS v4f*)(QS + (rg * 128 + 4 * c4) * 2) = (v4f){A4.x, H4.x, A4.y, H4.y}; *(LAS v4f*)(QS + (rg * 128 + 4 * c4) * 2 + 4) = (v4f){A4.z, H4.z, A4.w, H4.w}; }
            __syncthreads();
            if (rg < nrg) {
                v4f h4 = *(const LAS v4f*)(HINL + 4 * c4);
                for (int qq = 0; qq < rg; ++qq) { const v4f s0 = *(const LAS v4f*)(QS + (qq * 128 + 4 * c4) * 2), s1 = *(const LAS v4f*)(QS + (qq * 128 + 4 * c4) * 2 + 4);
                    h4 = (v4f){s0.x * h4.x + s0.y, s0.z * h4.y + s0.w, s1.x * h4.z + s1.y, s1.z * h4.w + s1.w}; }
                bf16* yp = YL + (size_t)(row0 + r0) * DR + dg4;
#pragma unroll
                for (int i = 0; i < 8; ++i) { const v4u w = ab[i]; const v4f a4 = (v4f){av[i][0], av[i][1], av[i][2], av[i][3]}, b4 = (v4f){bfhi(w.x), bfhi(w.y), bfhi(w.z), bfhi(w.w)};
                    h4 = a4 * h4 + b4;
                    const v4f g4 = (v4f){bflo(gq[i].x), bfhi(gq[i].x), bflo(gq[i].y), bfhi(gq[i].y)}, y4 = h4 * g4;
                    *(GAS v2u*)(yp + (size_t)i * DR) = (v2u){pk2(y4.x, y4.y), pk2(y4.z, y4.w)}; }
                if (c == NCH - 1 && rg == nrg - 1) *(GAS v4f*)(out + O_PLH + ((size_t)j * NB + b) * DR + dg4) = h4;
            }
            continue;
        }
        __syncthreads();
        if (kb != kb_staged) { const GAS v4u* src = (const GAS v4u*)(WAX + (size_t)kb * 256 * 128); v4u wv[8];
#pragma unroll
          for (int i = 0; i < 8; ++i) wv[i] = src[tid + NTHR * i];
#pragma unroll
          for (int i = 0; i < 8; ++i) { const int e = tid + NTHR * i; *(LAS v4u*)(WL + (e >> 4) * XS + 8 * (e & 15)) = wv[i]; }
          if (tid < 128) { CHC[tid] = LCF[kb * 128 + tid]; CHC[128 + tid] = ba[kb * 128 + tid]; CHC[256 + tid] = bx[kb * 128 + tid]; }
          kb_staged = kb; }
        v2f cs_[NCH - 1], ws_[7];
        const bool do_hin = FINAL && !samp && tid < 128;
        if (do_hin) {
#pragma unroll
            for (int cp = 0; cp < NCH - 1; ++cp) cs_[cp] = cp < c ? *(const GAS v2f*)(LSUM + ((size_t)(b * NCH + cp) * DR + kb * 128 + tid) * 2) : (v2f){1.f, 0.f};
#pragma unroll
            for (int ww = 0; ww < 7; ++ww) ws_[ww] = *(const GAS v2f*)(LSUB + (((size_t)(b * NCH + c) * 8 + ww) * DR + kb * 128 + tid) * 2); }
        v4u gv[4];
        if (FINAL) {
#pragma unroll
            for (int i = 0; i < 4; ++i) { const int e = tid + NTHR * i; if (e < Q * 16) gv[i] = *(const GAS v4u*)(G + (size_t)(row0 + (e >> 4)) * DR + kb * 128 + 8 * (e & 15)); } }
        for (int rp_ = 0; rp_ < ((!FINAL && (SUBREP & 64)) ? 2 : 1); ++rp_) { asm volatile("" ::: "memory");
        if (!samp) {
            const int c8 = tid & 15, rg = tid >> 4, s0 = 4 * rg, cc = kb * 128 + 8 * c8;
            if (s0 < Q) {
                const bf16* src = XRAW + (size_t)(row0 + s0) * DR + cc; const int tfirst = row0 - b * LP + s0;
                v4u raw[7];
#pragma unroll
                for (int i = 0; i < 3; ++i) { const bool ok = tfirst >= 3 - i; const v4u t = *(const GAS v4u*)(src + (ptrdiff_t)(ok ? i - 3 : 0) * DR); raw[i] = ok ? t : (v4u){0u, 0u, 0u, 0u}; }
#pragma unroll
                for (int i = 0; i < 4; ++i) raw[3 + i] = *(const GAS v4u*)(src + (size_t)i * DR);
                v4f wv[4][2], bv[2];
#pragma unroll
                for (int t = 0; t < 4; ++t) { wv[t][0] = *(const GAS v4f*)(cw + (size_t)t * DR + cc); wv[t][1] = *(const GAS v4f*)(cw + (size_t)t * DR + cc + 4); }
                bv[0] = *(const GAS v4f*)(cb + cc); bv[1] = *(const GAS v4f*)(cb + cc + 4);
                if (!FINAL && c == NCH - 1 && s0 + 4 == Q) { float* cso = out + O_PLC + (((size_t)j * NB + b) * 3) * DR + cc;
#pragma unroll
                    for (int i = 0; i < 3; ++i) { const v4u w = raw[4 + i]; float* o = cso + (size_t)i * DR;
                        *(GAS v4f*)o = (v4f){bflo(w.x), bfhi(w.x), bflo(w.y), bfhi(w.y)}; *(GAS v4f*)(o + 4) = (v4f){bflo(w.z), bfhi(w.z), bflo(w.w), bfhi(w.w)}; } }
                unsigned ow[4][4];
#pragma unroll
                for (int kp = 0; kp < 4; ++kp) { const int k = 2 * kp;
                    const v2f w0 = (v2f){wv[0][k >> 2][k & 3], wv[0][k >> 2][(k & 3) + 1]}, w1 = (v2f){wv[1][k >> 2][k & 3], wv[1][k >> 2][(k & 3) + 1]},
                              w2 = (v2f){wv[2][k >> 2][k & 3], wv[2][k >> 2][(k & 3) + 1]}, w3 = (v2f){wv[3][k >> 2][k & 3], wv[3][k >> 2][(k & 3) + 1]}, bb = (v2f){bv[k >> 2][k & 3], bv[k >> 2][(k & 3) + 1]};
#define RAW2(i) ((v2f){bf_elem(raw[i], k), bf_elem(raw[i], k + 1)})
                    v2f x0 = RAW2(0), x1 = RAW2(1), x2 = RAW2(2);
#pragma unroll
                    for (int i = 0; i < 4; ++i) { const v2f x3 = RAW2(3 + i); const v2f t = bb + w0 * x0 + w1 * x1 + w2 * x2 + w3 * x3; ow[i][kp] = pk2(t.x, t.y); x0 = x1; x1 = x2; x2 = x3; }
#undef RAW2
                }
#pragma unroll
                for (int i = 0; i < 4; ++i) *(LAS v4u*)(XR + (s0 + i) * XS + 8 * c8) = (v4u){ow[i][0], ow[i][1], ow[i][2], ow[i][3]};
            }
        } else {
            const int ch = tid & 127, sub = tid >> 7, cc = kb * 128 + ch, nr = Q / 4, s0 = sub * nr;
            const float w0 = cw[cc], w1 = cw[DR + cc], w2 = cw[2 * DR + cc], w3 = cw[3 * DR + cc], bias = cb[cc];
            {
                const float* spb = arg_in(I_SLC) + ((size_t)j * NS * 3) * DR + cc; float* opb = out + O_SLC + ((size_t)j * NS * 3) * DR + cc;
#pragma unroll 8
                for (int s = s0; s < s0 + nr; ++s) { const float* sp = spb + (size_t)s * 3 * DR;
                    const float q0 = sp[0], q1 = sp[DR], q2 = sp[2 * DR], x3 = bf2f(XRAW[(size_t)(TP + s) * DR + cc]);
                    XR[s * XS + ch] = (bf16)f2bf(bias + w0 * q0 + w1 * q1 + w2 * q2 + w3 * x3);
                    float* op = opb + (size_t)s * 3 * DR; op[0] = q1; op[DR] = q2; op[2 * DR] = x3; }
            }
        }
        }
        if (FINAL) {
#pragma unroll
            for (int i = 0; i < 4; ++i) { const int e = tid + NTHR * i; if (e < Q * 16) *(LAS v4u*)(GL + (e >> 4) * XS + 8 * (e & 15)) = gv[i]; } }
        if (do_hin) { float h = 0.f;
#pragma unroll
            for (int cp = 0; cp < NCH - 1; ++cp) h = cs_[cp].x * h + cs_[cp].y;
            WSUM[tid] = h;
#pragma unroll
            for (int ww = 0; ww < 7; ++ww) { h = ws_[ww].x * h + ws_[ww].y; WSUM[(ww + 1) * 128 + tid] = h; } }
        __syncthreads();
        const bool act = 16 * wave < Q; const int l0 = 16 * wave;
        if (act) {
            pg8::f32x4 acc[16];
            for (int rm_ = 0; rm_ < ((SUBREP & 128) ? 2 : 1); ++rm_) { asm volatile("" ::: "memory");
#pragma unroll
            for (int nt = 0; nt < 16; ++nt) acc[nt] = (pg8::f32x4){0.f, 0.f, 0.f, 0.f};
#pragma unroll
            for (int kk = 0; kk < 4; ++kk) { const bf16x8 af = *(const LAS bf16x8*)(XR + (l0 + fr) * XS + 32 * kk + 8 * fq);
#pragma unroll
                for (int nt = 0; nt < 16; ++nt) { const bf16x8 wf = *(const LAS bf16x8*)(WL + (16 * nt + fr) * XS + 32 * kk + 8 * fq);
                    acc[nt] = __builtin_amdgcn_mfma_f32_16x16x32_bf16(af, wf, acc[nt], 0, 0, 0); }
                __builtin_amdgcn_sched_barrier(0); }
            }
            if (samp) {
                if (FINAL) { const float* h0p = arg_in(I_SLH) + (size_t)j * NS * DR; float* hop = out + O_SLH + (size_t)j * NS * DR;
#pragma unroll 1
                    for (int nt = 0; nt < 8; ++nt) { const int d = 16 * nt + fr, dg = kb * 128 + d; const float cfac = CHC[d], bav = CHC[128 + d], bxv = CHC[256 + d];
                        const pg8::f32x4 ga = nt == 0 ? acc[0] : nt == 1 ? acc[1] : nt == 2 ? acc[2] : nt == 3 ? acc[3] : nt == 4 ? acc[4] : nt == 5 ? acc[5] : nt == 6 ? acc[6] : acc[7];
                        const pg8::f32x4 gx = nt == 0 ? acc[8] : nt == 1 ? acc[9] : nt == 2 ? acc[10] : nt == 3 ? acc[11] : nt == 4 ? acc[12] : nt == 5 ? acc[13] : nt == 6 ? acc[14] : acc[15];
#pragma unroll
                        for (int q = 0; q < 4; ++q) { const int l = l0 + 4 * fq + q;
                            const float rg = sigmoid_f(ga[q] + bav), ig = sigmoid_f(gx[q] + bxv), la = -cfac * rg, av = __expf(la), mult = __builtin_amdgcn_sqrtf(one_minus_exp2x(la, av));
                            const float bt = mult * ig * bf2f(XR[l * XS + d]);
                            const float h = av * h0p[(size_t)l * DR + dg] + bt; hop[(size_t)l * DR + dg] = h;
                            GL[l * XS + d] = (bf16)f2bf(h * bf2f(GL[l * XS + d])); } } }
            } else {
                for (int rg_ = 0; rg_ < ((!FINAL && (SUBREP & 256)) ? 2 : 1); ++rg_) { asm volatile("" ::: "memory");
#pragma unroll
                for (int nt = 0; nt < 8; ++nt) { const int d = 16 * nt + fr, dg = kb * 128 + d; const float cfac = CHC[d], bav = CHC[128 + d], bxv = CHC[256 + d];
                    float aq[4], bq[4], A = 1.f, H = 0.f;
#pragma unroll
                    for (int q = 0; q < 4; q += 2) { const int l = l0 + 4 * fq + q; v2f av2, bt2, la2;
                        lru_gate2((v2f){acc[nt][q], acc[nt][q + 1]}, (v2f){acc[nt + 8][q], acc[nt + 8][q + 1]}, bav, bxv, cfac, (v2f){bf2f(XR[l * XS + d]), bf2f(XR[(l + 1) * XS + d])}, av2, bt2, la2);
                        aq[q] = av2.x; aq[q + 1] = av2.y; bq[q] = bt2.x; bq[q + 1] = bt2.y;
                        H = av2.x * H + bt2.x; H = av2.y * H + bt2.y; A *= av2.x * av2.y;
                        if (!FINAL) { LAB[(size_t)(row0 + l) * DR + dg] = pk2(la2.x, bt2.x); LAB[(size_t)(row0 + l + 1) * DR + dg] = pk2(la2.y, bt2.y); } }
                    const float Ap = xor16_f(A, lane), Hp = xor16_f(H, lane);
                    const bool odd = (fq & 1) != 0;
                    const float AT = A * Ap, HT = odd ? A * Hp + H : Ap * H + Hp;
                    const float A01 = xor32_f(AT, lane), H01 = xor32_f(HT, lane);
                    const float Aex = fq == 0 ? 1.f : fq == 1 ? Ap : fq == 2 ? A01 : Ap * A01, Hex = fq == 0 ? 0.f : fq == 1 ? Hp : fq == 2 ? H01 : Ap * H01 + Hp;
                    if (!FINAL) { if (fq == 3) { const v2f tot = (v2f){A01 * AT, AT * H01 + HT};
                            *(LAS v2f*)(WSUM + (wave * 128 + d) * 2) = tot; } }
                    else { float h = Aex * WSUM[wave * 128 + d] + Hex;
#pragma unroll
                        for (int q = 0; q < 4; ++q) { const int l = l0 + 4 * fq + q; h = aq[q] * h + bq[q];
                            GL[l * XS + d] = (bf16)f2bf(h * bf2f(GL[l * XS + d]));
                            if (c == NCH - 1 && l == Q - 1) out[O_PLH + ((size_t)j * NB + b) * DR + dg] = h; } }
                    __builtin_amdgcn_sched_barrier(0); }
                }
            }
        }
        if (!FINAL) { __syncthreads();
            if (tid < 128) { float A = 1.f, H = 0.f; const int nw = Q / 16;
                for (int ww = 0; ww < nw; ++ww) { const v2f sm = *(const LAS v2f*)(WSUM + (ww * 128 + tid) * 2); H = sm.x * H + sm.y; A *= sm.x; }
                *(GAS v2f*)(LSUM + ((size_t)(b * NCH + c) * DR + kb * 128 + tid) * 2) = (v2f){A, H}; } }
        if (FINAL && act) { LDS_WAIT();
#pragma unroll
            for (int k = 0; k < 4; ++k) { const int ci = lane + 64 * k, rr = l0 + (ci >> 4), c16 = ci & 15;
                *(GAS v4u*)(YL + (size_t)(row0 + rr) * DR + kb * 128 + 8 * c16) = *(const LAS v4u*)(GL + rr * XS + 8 * c16); } }
        if (FINAL && (SUBREP & 16) && samp && !srep_) { srep_ = true; item -= gridDim.x; }
    }
}

__device__ __forceinline__ void lru_sample_item(unsigned char* ws, float* out, LAS unsigned char* lds, int j, int kb, int rgp, int tid, int wave) {
    const bf16* G = (const bf16*)(ws + WS_ZX); const bf16* XRAW = G + (size_t)T * DR; bf16* YL = (bf16*)(ws + WS_YN);
    const bf16* WAX = (const bf16*)(ws + WS_W) + WE_LRU0 + (size_t)j * WE_LEND + WE_LAX + (size_t)kb * 256 * 128;
    const float* LCF = (const float*)(ws + WS_LCF) + (size_t)j * DR;
    const float* cw = arg_in(I_LCW) + (size_t)j * 4 * DR; const float* cb = arg_in(I_LCB) + (size_t)j * DR;
    const float* ba = arg_in(I_LBA) + (size_t)j * DR; const float* bx = arg_in(I_LBX) + (size_t)j * DR;
    LAS bf16* XR = (LAS bf16*)(lds + 32768);
    LAS bf16* GLs = XR + 16 * XS;
    const int lane = tid & 63, fr = lane & 15, fq = lane >> 4, s0 = 16 * rgp, d = 16 * wave + fr, dg = kb * 128 + d;
    float h0v[4];
    { const float* h0p = arg_in(I_SLH) + (size_t)j * NS * DR;
#pragma unroll
      for (int q = 0; q < 4; ++q) h0v[q] = h0p[(size_t)(s0 + 4 * fq + q) * DR + dg]; }
    const float cfac = LCF[dg], bav = ba[dg], bxv = bx[dg];
    bf16x8 wa[4], wx[4];
#pragma unroll
    for (int kk = 0; kk < 4; ++kk) { wa[kk] = *(const GAS bf16x8*)(WAX + (size_t)(16 * wave + fr) * 128 + 32 * kk + 8 * fq); wx[kk] = *(const GAS bf16x8*)(WAX + (size_t)(128 + 16 * wave + fr) * 128 + 32 * kk + 8 * fq); }
    __syncthreads();
    { const int rr = tid >> 5, c4 = tid & 31, cc = kb * 128 + 4 * c4, s = s0 + rr;
      const float* sp = arg_in(I_SLC) + (((size_t)j * NS + s) * 3) * DR + cc; float* op = out + O_SLC + (((size_t)j * NS + s) * 3) * DR + cc;
      const v4f q0 = *(const GAS v4f*)sp, q1 = *(const GAS v4f*)(sp + DR), q2 = *(const GAS v4f*)(sp + 2 * DR);
      const v2u xr = *(const GAS v2u*)(XRAW + (size_t)(TP + s) * DR + cc), gg = *(const GAS v2u*)(G + (size_t)(TP + s) * DR + cc);
      const v4f w0 = *(const GAS v4f*)(cw + cc), w1 = *(const GAS v4f*)(cw + DR + cc), w2 = *(const GAS v4f*)(cw + 2 * DR + cc), w3 = *(const GAS v4f*)(cw + 3 * DR + cc), bb = *(const GAS v4f*)(cb + cc);
      const v4f x3 = (v4f){bflo(xr.x), bfhi(xr.x), bflo(xr.y), bfhi(xr.y)};
      const v4f t = bb + w0 * q0 + w1 * q1 + w2 * q2 + w3 * x3;
      *(GAS v4f*)op = q1; *(GAS v4f*)(op + DR) = q2; *(GAS v4f*)(op + 2 * DR) = x3;
      *(LAS v2u*)(XR + rr * XS + 4 * c4) = (v2u){pk2(t.x, t.y), pk2(t.z, t.w)};
      *(LAS v2u*)(GLs + rr * XS + 4 * c4) = gg; }
    __syncthreads();
    pg8::f32x4 aa = (pg8::f32x4){0.f, 0.f, 0.f, 0.f}, ax = aa;
#pragma unroll
    for (int kk = 0; kk < 4; ++kk) { const bf16x8 af = *(const LAS bf16x8*)(XR + fr * XS + 32 * kk + 8 * fq);
        aa = __builtin_amdgcn_mfma_f32_16x16x32_bf16(af, wa[kk], aa, 0, 0, 0); ax = __builtin_amdgcn_mfma_f32_16x16x32_bf16(af, wx[kk], ax, 0, 0, 0); }
    float* hop = out + O_SLH + (size_t)j * NS * DR;
#pragma unroll
    for (int q = 0; q < 4; ++q) { const int l = 4 * fq + q;
        const float rgt = sigmoid_f(aa[q] + bav), ig = sigmoid_f(ax[q] + bxv), la = -cfac * rgt, av = __expf(la), mult = __builtin_amdgcn_sqrtf(one_minus_exp2x(la, av));
        const float bt = mult * ig * bf2f(XR[l * XS + d]);
        const float h = av * h0v[q] + bt; hop[(size_t)(s0 + l) * DR + dg] = h;
        YL[(size_t)(TP + s0 + l) * DR + dg] = (bf16)f2bf(h * bf2f(GLs[l * XS + d])); }
}

__device__ __forceinline__ void lru_phase_b(unsigned char* ws, float* out, LAS unsigned char* lds, int j, int tid0, int wave) {
    const bf16* G = (const bf16*)(ws + WS_ZX); bf16* YL = (bf16*)(ws + WS_YN);
    const float* LSUM = (const float*)(ws + WS_SCR + SC_LSUM); const unsigned* LAB = (const unsigned*)(ws + WS_SCR + SC_LAB);
    int tid = tid0; asm volatile("" : "+v"(tid));
    const int c4 = tid & 31, rg = tid >> 5;
    LAS float* QS = (LAS float*)lds;
    LAS float* HINL = QS + 16 * 128 * 2;
    v4u abn[8]; v2u gqn[8];
#define LB_ISSUE(item_) { const SsdItem it_ = ssd_item(item_); const int rr_ = rg < it_.Q / 8 ? 8 * rg : 0; \
        const unsigned* labp_ = LAB + (size_t)(it_.row0 + rr_) * DR + it_.g * 128 + 4 * c4; const bf16* gp_ = G + (size_t)(it_.row0 + rr_) * DR + it_.g * 128 + 4 * c4; \
        _Pragma("unroll") for (int i = 0; i < 8; ++i) { abn[i] = *(const GAS v4u*)(labp_ + (size_t)i * DR); gqn[i] = *(const GAS v2u*)(gp_ + (size_t)i * DR); } }
    int item = blockIdx.x;
    if (item < N_CITEMS) LB_ISSUE(item)
    for (; item < N_CITEMS; item += gridDim.x) {
        const SsdItem it = ssd_item(item); const int b = it.b, c = it.c, kb = it.g, Q = it.Q, row0 = it.row0;
        const int nrg = Q / 8, r0 = 8 * rg, dg4 = kb * 128 + 4 * c4;
        v2f cs_[NCH - 1];
        if (tid < 128) { const int dg = kb * 128 + tid;
#pragma unroll
            for (int cp = 0; cp < NCH - 1; ++cp) { const v2f t = *(const GAS v2f*)(LSUM + ((size_t)(b * NCH + (cp < c ? cp : 0)) * DR + dg) * 2); const float mk = cp < c ? 1.f : 0.f;
                cs_[cp].x = 1.f + mk * (t.x - 1.f); cs_[cp].y = mk * t.y; } }
        v4u ab[8]; v2u gq[8];
#pragma unroll
        for (int i = 0; i < 8; ++i) { ab[i] = abn[i]; gq[i] = gqn[i]; }
        if (item + (int)gridDim.x < N_CITEMS) LB_ISSUE(item + (int)gridDim.x)
        __syncthreads();
        if (tid < 128) { float h = 0.f;
#pragma unroll
            for (int cp = 0; cp < NCH - 1; ++cp) h = cs_[cp].x * h + cs_[cp].y;
            HINL[tid] = h; }
        float av[8][4]; v4f A4 = (v4f){1.f, 1.f, 1.f, 1.f}, H4 = (v4f){0.f, 0.f, 0.f, 0.f};
#pragma unroll
        for (int i = 0; i < 8; ++i) { const v4u w = ab[i];
            av[i][0] = __expf(bflo(w.x)); av[i][1] = __expf(bflo(w.y)); av[i][2] = __expf(bflo(w.z)); av[i][3] = __expf(bflo(w.w));
            const v4f a4 = (v4f){av[i][0], av[i][1], av[i][2], av[i][3]}, b4 = (v4f){bfhi(w.x), bfhi(w.y), bfhi(w.z), bfhi(w.w)};
            H4 = a4 * H4 + b4; A4 = A4 * a4; }
        if (rg < nrg) { *(LAS v4f*)(QS + (rg * 128 + 4 * c4) * 2) = (v4f){A4.x, H4.x, A4.y, H4.y}; *(LAS v4f*)(QS + (rg * 128 + 4 * c4) * 2 + 4) = (v4f){A4.z, H4.z, A4.w, H4.w}; }
        __syncthreads();
        if (rg < nrg) {
            v4f h4 = *(const LAS v4f*)(HINL + 4 * c4);
            for (int qq = 0; qq < rg; ++qq) { const v4f s0 = *(const LAS v4f*)(QS + (qq * 128 + 4 * c4) * 2), s1 = *(const LAS v4f*)(QS + (qq * 128 + 4 * c4) * 2 + 4);
                h4 = (v4f){s0.x * h4.x + s0.y, s0.z * h4.y + s0.w, s1.x * h4.z + s1.y, s1.z * h4.w + s1.w}; }
            bf16* yp = YL + (size_t)(row0 + r0) * DR + dg4;
#pragma unroll
            for (int i = 0; i < 8; ++i) { const v4u w = ab[i]; const v4f a4 = (v4f){av[i][0], av[i][1], av[i][2], av[i][3]}, b4 = (v4f){bfhi(w.x), bfhi(w.y), bfhi(w.z), bfhi(w.w)};
                h4 = a4 * h4 + b4;
                const v4f g4 = (v4f){bflo(gq[i].x), bfhi(gq[i].x), bflo(gq[i].y), bfhi(gq[i].y)}, y4 = h4 * g4;
                *(GAS v2u*)(yp + (size_t)i * DR) = (v2u){pk2(y4.x, y4.y), pk2(y4.z, y4.w)}; }
            if (c == NCH - 1 && rg == nrg - 1) *(GAS v4f*)(out + O_PLH + ((size_t)j * NB + b) * DR + dg4) = h4;
        }
    }
#undef LB_ISSUE
    for (; item < N_CITEMS + 64; item += gridDim.x) { const int si = item - N_CITEMS; lru_sample_item(ws, out, lds, j, si & 7, si >> 3, tid, wave); }
}
#define RLX_AGENT __ATOMIC_RELAXED, __HIP_MEMORY_SCOPE_AGENT
#define XB_TMO      128
#define XB_XCNT(j)  (256  + 64 * (j))
#define XB_XSUB(j)  (1280 + 64 * (j))
#define XB_XGEN(j)  (2304 + 64 * (j))
#define XB_TOP      3328
#define XB_TOPGEN   3392
#define XCD_BAR_WORDS 3456
#define XB_SPIN_CAP (1u << 18)

__device__ __forceinline__ unsigned xb_ld(unsigned* p)              { return __hip_atomic_load(p, __ATOMIC_RELAXED, __HIP_MEMORY_SCOPE_AGENT); }
__device__ __forceinline__ unsigned xb_add(unsigned* p, unsigned v) { return __hip_atomic_fetch_add(p, v, __ATOMIC_RELAXED, __HIP_MEMORY_SCOPE_AGENT); }
__device__ __forceinline__ unsigned xb_xcc_id() { return (unsigned)__builtin_amdgcn_s_getreg((3 << 11) | 20) & 0xFu; }
#define XB_SPIN(cond, bar) do { unsigned _sp = 0; while (cond) { __builtin_amdgcn_s_sleep(1); \
    if ((++_sp & 255u) == 0u) { if (xb_ld(&(bar)[XB_TMO])) break; if (_sp > XB_SPIN_CAP) { atomicAdd(&(bar)[XB_TMO], 1u); break; } } } } while (0)

struct XcdBarrier {
    unsigned* bar; unsigned x;
    volatile LAS unsigned* st;
};

__device__ __forceinline__ XcdBarrier xcd_barrier_post(unsigned* bar, volatile LAS unsigned* st) {
    XcdBarrier b; b.bar = bar; b.x = xb_xcc_id(); b.st = st;
    if (threadIdx.x == 0) (void)xb_add(&bar[XB_XCNT(b.x)], 1u);
    return b;
}
__device__ __forceinline__ void xcd_barrier_complete(unsigned* bar, unsigned x, unsigned& nloc, unsigned& nx) {
    const unsigned G = gridDim.x * gridDim.y * gridDim.z;
    unsigned sum, cnt, mine, sp = 0u;
    for (;;) {
        sum = 0u; cnt = 0u; mine = 0u;
#pragma unroll
        for (unsigned j = 0; j < 16; ++j) { const unsigned c = xb_ld(&bar[XB_XCNT(j)]); sum += c; cnt += (c > 0u) ? 1u : 0u; mine = (j == x) ? c : mine; }
        if (sum == G) break;
        __builtin_amdgcn_s_sleep(1);
        if ((++sp & 255u) == 0u) { if (xb_ld(&bar[XB_TMO])) break; if (sp > XB_SPIN_CAP) { atomicAdd(&bar[XB_TMO], 1u); break; } }
    }
    nloc = mine > 0u ? mine : 1u; nx = cnt > 0u ? cnt : 1u;
}

__device__ __forceinline__ void xcd_barrier(const XcdBarrier& b) {
    asm volatile("s_waitcnt vmcnt(0)" ::: "memory");
    __syncthreads();
    if (threadIdx.x == 0) {
        unsigned* bar = b.bar;
        __builtin_amdgcn_s_waitcnt(0);
        unsigned nloc = b.st[0], nx = b.st[1];
        if (nloc == 0u) { xcd_barrier_complete(bar, b.x, nloc, nx); b.st[0] = nloc; b.st[1] = nx; }
        const unsigned old = xb_add(&bar[XB_XSUB(b.x)], 1u);
        const unsigned gen = old / nloc;
        if (old + 1u == (gen + 1u) * nloc) {
            __builtin_amdgcn_fence(__ATOMIC_RELEASE, "agent");
            asm volatile("s_waitcnt vmcnt(0)" ::: "memory");
            const unsigned og = xb_add(&bar[XB_TOP], 1u);
            const unsigned tg = og / nx;
            if (og + 1u == (tg + 1u) * nx) xb_add(&bar[XB_TOPGEN], 1u);
            else XB_SPIN(xb_ld(&bar[XB_TOPGEN]) == tg, bar);
            __builtin_amdgcn_fence(__ATOMIC_ACQUIRE, "agent");
            xb_add(&bar[XB_XGEN(b.x)], 1u);
            asm volatile("s_waitcnt vmcnt(0)" ::: "memory");
        } else {
            XB_SPIN(xb_ld(&bar[XB_XGEN(b.x)]) == gen, bar);
            __builtin_amdgcn_fence(__ATOMIC_ACQUIRE, "agent");
            asm volatile("s_waitcnt vmcnt(0)" ::: "memory");
        }
    }
    __syncthreads();
}

typedef float f32x16 __attribute__((ext_vector_type(16)));
constexpr int SG_SP = 136, SG_WREG = 2 * 32 * SG_SP * 2;
template <int K, int RT, class Epi>
__device__ __forceinline__ void small_gemm(LAS unsigned char* lds, const bf16* A, const bf16* Bt, int rt0, int nrt, int ct0, int nct, const Epi& E) {
    static_assert(RT == 1 && K % 1024 == 0, "small_gemm shape");
    int tid_ = threadIdx.x; asm volatile("" : "+v"(tid_));
    const int tid = tid_, lane = tid & 63, wave = __builtin_amdgcn_readfirstlane(tid >> 6), r = lane & 31, hh = lane >> 5, c16 = lane & 15, rs = lane >> 4;
    constexpr int KW = K / 8, NBAT = KW / 128;
    LAS bf16* As = (LAS bf16*)(lds + wave * SG_WREG); LAS bf16* Bs = As + 32 * SG_SP;
    LAS float* Pw = (LAS float*)(lds + wave * SG_WREG);
    const int ntiles = nrt * nct;
    v4u sa[8], sb[8];
#define SG_ISSUE(tile_, b_) { const bf16* ap_ = A + (size_t)(32 * (rt0 + (tile_) / nct) + rs) * K + wave * KW + 128 * (b_) + 8 * c16; \
        const bf16* bp_ = Bt + (size_t)(32 * (ct0 + (tile_) % nct) + rs) * K + wave * KW + 128 * (b_) + 8 * c16; \
        _Pragma("unroll") for (int i = 0; i < 8; ++i) { sa[i] = *(const GAS v4u*)(ap_ + (size_t)(4 * i) * K); sb[i] = *(const GAS v4u*)(bp_ + (size_t)(4 * i) * K); } }
    int tile = blockIdx.x;
    if (tile < ntiles) SG_ISSUE(tile, 0)
    for (; tile < ntiles; tile += gridDim.x) {
        const int row0 = 32 * (rt0 + tile / nct), col0 = 32 * (ct0 + tile % nct);
        f32x16 acc;
#pragma unroll
        for (int i = 0; i < 16; ++i) acc[i] = 0.f;
        __syncthreads();
#pragma unroll 1
        for (int b = 0; b < NBAT; ++b) {
#pragma unroll
            for (int i = 0; i < 8; ++i) { *(LAS v4u*)(As + (4 * i + rs) * SG_SP + 8 * c16) = sa[i]; *(LAS v4u*)(Bs + (4 * i + rs) * SG_SP + 8 * c16) = sb[i]; }
            bf16x8 af[8], bfr[8];
#pragma unroll
            for (int i = 0; i < 8; ++i) { af[i] = *(const LAS bf16x8*)(As + r * SG_SP + 16 * i + 8 * hh); bfr[i] = *(const LAS bf16x8*)(Bs + r * SG_SP + 16 * i + 8 * hh); }
            if (b + 1 < NBAT) SG_ISSUE(tile, b + 1)
            else if (tile + (int)gridDim.x < ntiles) SG_ISSUE(tile + (int)gridDim.x, 0)
#pragma unroll
            for (int i = 0; i < 8; ++i) acc = __builtin_amdgcn_mfma_f32_32x32x16_bf16(af[i], bfr[i], acc, 0, 0, 0);
        }
#pragma unroll
        for (int i = 0; i < 16; ++i) Pw[((i & 3) + 8 * (i >> 2) + 4 * hh) * 33 + r] = acc[i];
        __syncthreads();
#pragma unroll
        for (int e = 0; e < 2; ++e) { const int idx = tid + 512 * e, rr = idx >> 5, cc = idx & 31; float v = 0.f;
#pragma unroll
            for (int w = 0; w < 8; ++w) v += *(const LAS float*)(lds + w * SG_WREG + (rr * 33 + cc) * 4);
            E.elem(row0 + rr, col0 + cc, v); }
    }
#undef SG_ISSUE
}
constexpr int TM = 16384;
__device__ __forceinline__ void touch_region(const void* p, size_t bytes, int gthread, int nthreads) {
    const GAS v4u* q = (const GAS v4u*)p; const size_t n = bytes / 16;
    for (size_t i = gthread; i < n; i += (size_t)nthreads * 4) { v4u a = q[i], b = (i + nthreads < n) ? q[i + nthreads] : a, c = (i + 2 * (size_t)nthreads < n) ? q[i + 2 * (size_t)nthreads] : a, d = (i + 3 * (size_t)nthreads < n) ? q[i + 3 * (size_t)nthreads] : a;
        asm volatile("" :: "v"(a), "v"(b), "v"(c), "v"(d)); }
}
template <int N, int K, class Epi>
__device__ __forceinline__ void run_gemm(LAS unsigned char* lds, const bf16* A, const bf16* Bt, const Epi& E) {
    pg8::Gemm g{A, Bt, TM, N, K}; pg8::StaticOrder S; S.init(TM, N, (int)gridDim.x, (int)blockIdx.x);
    pg8::gemm_phase<Epi, pg8::StaticOrder, true, true>(lds, g, S, E);
    small_gemm<K, 1>(lds, A, Bt, TM / 32, (T - TM) / 32, 0, N / 32, E);
    if (SUBREP & 512) { asm volatile("" ::: "memory"); small_gemm<K, 1>(lds, A, Bt, TM / 32, (T - TM) / 32, 0, N / 32, E); }
}
__global__ void __launch_bounds__(NTHR, 2) mk_fwd(Args args) {
    extern __shared__ __attribute__((aligned(16))) unsigned char lds_raw[];
    LAS unsigned char* lds = (LAS unsigned char*)lds_raw;
    if (threadIdx.x < 2) ((LAS unsigned*)(lds + LDS_MISC_OFF))[threadIdx.x] = 0u;
    __syncthreads();
    const XcdBarrier bar = xcd_barrier_post((unsigned*)(args.ws + WS_CTL) + CW_BAR, (volatile LAS unsigned*)(lds + LDS_MISC_OFF));
    for (int ph = args.ph_lo, rep = 0; ph < args.ph_hi; ++ph) {
        if (ph > 0 && ((ph - 1) / PL) % 2 == 1 && (ph - 1) % PL == 3) continue;
        if (ph == args.ph_lo + 1 && rep == 0) cg::this_grid().sync();
        else if (ph > args.ph_lo || rep) xcd_barrier(bar);
        int tid = threadIdx.x; asm volatile("" : "+v"(tid));
        unsigned char* ws = args.ws; asm volatile("" : "+s"(ws));
        const int lane = tid & 63, wave = __builtin_amdgcn_readfirstlane(tid >> 6);
        const int G = gridDim.x, gw = blockIdx.x * NWAVES + wave, NGW = G * NWAVES;
        bf16* WB = (bf16*)(ws + WS_W); bf16* XB = (bf16*)(ws + WS_XB); float* RS = (float*)(ws + WS_RS); bf16* Mb = (bf16*)(ws + WS_M);
        bf16* ZX = (bf16*)(ws + WS_ZX); float* DT = (float*)(ws + WS_DT); bf16* YN = (bf16*)(ws + WS_YN);
        if (ph == 0) { p0_prologue(args, lds, gw, NGW, wave, lane); if (((REP_MASK >> 6) & 1) && rep == 0) { rep = 1; --ph; } else rep = 0; continue; }
        const int i = (ph - 1) / PL, k = (ph - 1) % PL, j = i >> 1; const bool ssd = (i & 1) == 0;
        bf16* wl = ssd ? WB + WE_SSD0 + (size_t)j * WE_SEND : WB + WE_LRU0 + (size_t)j * WE_LEND;
        bf16* wf = WB + WE_FFN0 + (size_t)i * WE_FEND;
        if (k == 0) {
            if (ssd) { pg8::EpiSsdIn E{ZX, DT, RS}; run_gemm<ZXW, DM>(lds, XB, wl + WE_SIN, E);
                small_gemm<DM, 1>(lds, XB, wl + WE_SIN, 0, T / 32, ZXW / 32, 1, E); }
            else { pg8::EpiLruIn E{ZX, ZX + (size_t)T * DR, RS, arg_in(I_LBIN) + (size_t)j * 2048}; run_gemm<2048, DM>(lds, XB, wl + WE_LIN, E); }
        } else if (k == 4) {
            if (ssd) { pg8::EpiM E{Mb, nullptr}; run_gemm<DM, DI>(lds, YN, wl + WE_SOUT, E); }
            else { pg8::EpiM E{Mb, arg_in(I_LBOUT) + (size_t)j * DM}; run_gemm<DM, DR>(lds, YN, wl + WE_LOUT, E); }
        } else if (k == 5) { if (TOUCH_W) touch_region(wf, (size_t)WE_FEND * 2, blockIdx.x * NTHR + tid, G * NTHR);
            resid_phase(args, arg_in(I_NMPOST) + (size_t)i * DM, false, gw, NGW, lane);
        } else if (k == 6) { pg8::EpiFfn1 E{ZX, RS}; run_gemm<DFF, DM>(lds, XB, wf + WE_F1, E);
        } else if (k == 7) { pg8::EpiM E{Mb, nullptr}; run_gemm<DM, DFF>(lds, ZX, wf + WE_F2, E);
        } else if (k == 8) { resid_phase(args, arg_in(I_NFPOST) + (size_t)i * DM, i == 3, gw, NGW, lane);
        }
        else if (ssd && k == 1) ssd_phase_a(ws, args.out, lds, j, tid, lane, wave);
        else if (ssd && k == 2) ssd_phase_b(ws, args.out, j, tid);
        else if (ssd && k == 3) ssd_phase_c(ws, args.out, lds, j, tid, lane, wave);
        else if (!ssd && k == 1) lru_phase<false>(ws, args.out, lds, j, tid, lane, wave);
        else if (!ssd && k == 2) lru_phase_b(ws, args.out, lds, j, tid, wave);
        if (REP_MASK) { const int kind = (k == 0 || k == 4 || k == 6 || k == 7) ? 0 : (ssd && k >= 1 && k <= 3) ? k : (!ssd && k >= 1 && k <= 2) ? 3 + k : 9;
            if (((REP_MASK >> kind) & 1) && rep == 0) { rep = 1; --ph; } else rep = 0; }
    }
}

__global__ void k_ssd_conv(const bf16* __restrict__ ZX, const float* __restrict__ st, const float* __restrict__ cw, const float* __restrict__ cb,
                           float* __restrict__ XBC, float* __restrict__ o_p, float* __restrict__ o_s) {
    const int r = blockIdx.x, c = blockIdx.y * 256 + threadIdx.x;
    float x0, x1, x2; const float x3 = bf2f(ZX[(size_t)r * ZXW + DI + c]);
    if (r < TP) { const int t = r % LP;
        x2 = t >= 1 ? bf2f(ZX[(size_t)(r - 1) * ZXW + DI + c]) : 0.f; x1 = t >= 2 ? bf2f(ZX[(size_t)(r - 2) * ZXW + DI + c]) : 0.f; x0 = t >= 3 ? bf2f(ZX[(size_t)(r - 3) * ZXW + DI + c]) : 0.f;
        if (t >= LP - 3) o_p[((size_t)(r / LP) * 3 + (t - (LP - 3))) * CONVD + c] = x3;
    } else { const int s = r - TP; const float* sp = st + (size_t)s * 3 * CONVD + c; x0 = sp[0]; x1 = sp[CONVD]; x2 = sp[2 * CONVD];
        float* op = o_s + (size_t)s * 3 * CONVD + c; op[0] = x1; op[CONVD] = x2; op[2 * CONVD] = x3; }
    const float v = cb[c] + cw[c] * x0 + cw[CONVD + c] * x1 + cw[2 * CONVD + c] * x2 + cw[3 * CONVD + c] * x3;
    XBC[(size_t)r * CONVD + c] = silu_f(v);
}
__global__ void __launch_bounds__(64) k_ssd_scan(const float* __restrict__ DT, const float* __restrict__ XBC, const float* __restrict__ h0,
                                                 const float* __restrict__ dt_bias, const float* __restrict__ a_log, const float* __restrict__ dsk,
                                                 float* __restrict__ Y, float* __restrict__ o_ph, float* __restrict__ o_sh) {
    const int q = blockIdx.x / NH, h = blockIdx.x % NH, p = threadIdx.x, g = h / 4;
    const int row0 = seq_row0(q), L = seq_len(q);
    float hs[NST];
    if (q < NB) {
#pragma unroll
        for (int n = 0; n < NST; ++n) hs[n] = 0.f;
    } else { const float* hp = h0 + (((size_t)(q - NB) * NH + h) * HD + p) * NST;
#pragma unroll
        for (int n = 0; n < NST; n += 4) { const float4 v = *(const float4*)(hp + n); hs[n] = v.x; hs[n + 1] = v.y; hs[n + 2] = v.z; hs[n + 3] = v.w; } }
    const float Aneg = -__expf(a_log[h]), dtb = dt_bias[h], Dh = dsk[h];
    for (int t = 0; t < L; ++t) {
        const size_t row = (size_t)(row0 + t);
        const float dtv = softplus_f(DT[row * 32 + h] + dtb);
        const float dA = __expf(dtv * Aneg);
        const float xv = XBC[row * CONVD + h * HD + p], xdt = xv * dtv;
        const float* Bp = XBC + row * CONVD + DI + g * NST; const float* Cp = Bp + NG * NST;
        float y = 0.f;
#pragma unroll
        for (int n = 0; n < NST; ++n) { hs[n] = fmaf(hs[n], dA, xdt * Bp[n]); y = fmaf(Cp[n], hs[n], y); }
        Y[row * DI + h * HD + p] = y + Dh * xv;
    }
    float* op = (q < NB ? o_ph + (((size_t)q * NH + h) * HD + p) * NST : o_sh + (((size_t)(q - NB) * NH + h) * HD + p) * NST);
#pragma unroll
    for (int n = 0; n < NST; n += 4) *(float4*)(op + n) = make_float4(hs[n], hs[n + 1], hs[n + 2], hs[n + 3]);
}
__global__ void k_ssd_gate_norm(const float* __restrict__ Y, const bf16* __restrict__ ZX, bf16* __restrict__ YN) {
    const int wv = blockIdx.x * 4 + (threadIdx.x >> 6), lane = threadIdx.x & 63, r = wv / NG, g = wv % NG, c = g * 256 + lane * 4;
    const float4 y = *(const float4*)(Y + (size_t)r * DI + c); const v2u zz = *(const v2u*)(ZX + (size_t)r * ZXW + c);
    float4 v = make_float4(y.x * silu_f(bflo(zz.x)), y.y * silu_f(bfhi(zz.x)), y.z * silu_f(bflo(zz.y)), y.w * silu_f(bfhi(zz.y)));
    const float s = wave_sum(v.x * v.x + v.y * v.y + v.z * v.z + v.w * v.w);
    const float rs = rsqrtf(s * (1.f / 256.f) + EPS);
    *(v2u*)(YN + (size_t)r * DI + c) = (v2u){pk2(v.x * rs, v.y * rs), pk2(v.z * rs, v.w * rs)};
}
__global__ void k_lru_conv(const bf16* __restrict__ XRAW, const float* __restrict__ st, const float* __restrict__ cw, const float* __restrict__ cb,
                           float* __restrict__ XR, float* __restrict__ o_p, float* __restrict__ o_s) {
    const int r = blockIdx.x, c = blockIdx.y * 256 + threadIdx.x;
    float x0, x1, x2; const float x3 = bf2f(XRAW[(size_t)r * DR + c]);
    if (r < TP) { const int t = r % LP;
        x2 = t >= 1 ? bf2f(XRAW[(size_t)(r - 1) * DR + c]) : 0.f; x1 = t >= 2 ? bf2f(XRAW[(size_t)(r - 2) * DR + c]) : 0.f; x0 = t >= 3 ? bf2f(XRAW[(size_t)(r - 3) * DR + c]) : 0.f;
        if (t >= LP - 3) o_p[((size_t)(r / LP) * 3 + (t - (LP - 3))) * DR + c] = x3;
    } else { const int s = r - TP; const float* sp = st + (size_t)s * 3 * DR + c; x0 = sp[0]; x1 = sp[DR]; x2 = sp[2 * DR];
        float* op = o_s + (size_t)s * 3 * DR + c; op[0] = x1; op[DR] = x2; op[2 * DR] = x3; }
    XR[(size_t)r * DR + c] = cb[c] + cw[c] * x0 + cw[DR + c] * x1 + cw[2 * DR + c] * x2 + cw[3 * DR + c] * x3;
}
__global__ void k_lru_gates(const float* __restrict__ XR, const float* __restrict__ wa, const float* __restrict__ ba, const float* __restrict__ wx, const float* __restrict__ bx,
                            const float* __restrict__ lam, float* __restrict__ AV, float* __restrict__ BV) {
    const int r = blockIdx.x, d = blockIdx.y * 256 + threadIdx.x, k = d >> 7, dd = d & 127;
    const float* xr = XR + (size_t)r * DR + k * 128; const float* wap = wa + (size_t)k * 128 * 128 + dd; const float* wxp = wx + (size_t)k * 128 * 128 + dd;
    float sa = ba[d], sx = bx[d];
    for (int c = 0; c < 128; ++c) { const float xv = xr[c]; sa = fmaf(xv, wap[c * 128], sa); sx = fmaf(xv, wxp[c * 128], sx); }
    const float rg = sigmoid_f(sa), ig = sigmoid_f(sx);
    const float log_a = -8.0f * rg * softplus_f(-lam[d]);
    const float av = __expf(log_a), mult = sqrtf(-expm1f(2.f * log_a));
    AV[(size_t)r * DR + d] = av; BV[(size_t)r * DR + d] = mult * ig * XR[(size_t)r * DR + d];
}
__global__ void k_lru_scan(const float* __restrict__ AV, const float* __restrict__ BV, const bf16* __restrict__ Gt, const float* __restrict__ h0,
                           bf16* __restrict__ YL, float* __restrict__ o_p, float* __restrict__ o_s) {
    const int q = blockIdx.x, d = blockIdx.y * 256 + threadIdx.x, row0 = seq_row0(q), L = seq_len(q);
    float h = q < NB ? 0.f : h0[(size_t)(q - NB) * DR + d];
    for (int t = 0; t < L; ++t) { const size_t row = (size_t)(row0 + t);
        h = fmaf(AV[row * DR + d], h, BV[row * DR + d]);
        YL[row * DR + d] = (bf16)f2bf(h * bf2f(Gt[row * DR + d])); }
    if (q < NB) o_p[(size_t)q * DR + d] = h; else o_s[(size_t)(q - NB) * DR + d] = h;
}

extern "C" void kernel_launch(void* const* d_in, const int* in_sizes, int n_in, void* d_out, int out_size, void* d_ws, size_t ws_size, hipStream_t stream) {
    static int grid = 0;
    if (grid == 0) {
        if (n_in != N_IN || (size_t)out_size != O_END || ws_size < WS_END) { fprintf(stderr, "kernel_launch: unexpected sizes n_in %d out %d ws %zu (need %zu)\n", n_in, out_size, ws_size, (size_t)WS_END); grid = -1; return; }
        int dev = 0, cus = 0, per_cu = 0;
        if (hipGetDevice(&dev) != hipSuccess || hipDeviceGetAttribute(&cus, hipDeviceAttributeMultiprocessorCount, dev) != hipSuccess) { grid = -1; return; }
        if (hipFuncSetAttribute((const void*)mk_fwd, hipFuncAttributeMaxDynamicSharedMemorySize, LDS_BYTES) != hipSuccess) { fprintf(stderr, "kernel_launch: hipFuncSetAttribute failed\n"); grid = -1; return; }
        if (hipOccupancyMaxActiveBlocksPerMultiprocessor(&per_cu, (const void*)mk_fwd, NTHR, LDS_BYTES) != hipSuccess || per_cu < 1) { fprintf(stderr, "kernel_launch: occupancy query %d\n", per_cu); grid = -1; return; }
        grid = cus;
    }
    if (grid < 0) return;
    const float* const* in = (const float* const*)d_in; float* out = (float*)d_out; unsigned char* ws = (unsigned char*)d_ws;
    (void)hipMemsetAsync(ws + WS_CTL, 0, CTL_ZERO_BYTES, stream);
    Args a{};
    for (int i = 0; i < N_IN; ++i) a.in[i] = in[i];
    a.out = out; a.ws = ws;
    bf16* ZX = (bf16*)(ws + WS_ZX); float* DT = (float*)(ws + WS_DT); bf16* YN = (bf16*)(ws + WS_YN);
    float* SCR = (float*)(ws + WS_SCR);
    constexpr size_t SZ_X = (size_t)T * DM;
    int ph = 0;
    while (ph < NPH) {
        const int i = ph ? (ph - 1) / PL : -1, k = ph ? (ph - 1) % PL : -1, j = i >> 1;
        if (false) {
            if (k == 1) {
            if ((i & 1) == 0) {
                float* XBC = SCR; float* Y = SCR + (size_t)T * CONVD;
                hipLaunchKernelGGL(k_ssd_conv, dim3(T, CONVD / 256), dim3(256), 0, stream, ZX, in[I_SSC] + (size_t)j * NS * 3 * CONVD, in[I_SCW] + (size_t)j * 4 * CONVD, in[I_SCB] + (size_t)j * CONVD,
                                   XBC, out + O_PSC + (size_t)j * NB * 3 * CONVD, out + O_SSC + (size_t)j * NS * 3 * CONVD);
                hipLaunchKernelGGL(k_ssd_scan, dim3(NSEQ * NH), dim3(64), 0, stream, DT, XBC, in[I_SSH] + (size_t)j * NS * NH * HD * NST, in[I_SDTB] + j * NH, in[I_SALOG] + j * NH, in[I_SD] + j * NH,
                                   Y, out + O_PSH + (size_t)j * NB * NH * HD * NST, out + O_SSH + (size_t)j * NS * NH * HD * NST);
                hipLaunchKernelGGL(k_ssd_gate_norm, dim3(T * NG / 4), dim3(256), 0, stream, Y, ZX, YN);
            } else {
                float* XR = SCR; float* AV = SCR + SZ_X; float* BV = SCR + 2 * SZ_X;
                hipLaunchKernelGGL(k_lru_conv, dim3(T, DR / 256), dim3(256), 0, stream, ZX + (size_t)T * DR, in[I_SLC] + (size_t)j * NS * 3 * DR, in[I_LCW] + (size_t)j * 4 * DR, in[I_LCB] + (size_t)j * DR,
                                   XR, out + O_PLC + (size_t)j * NB * 3 * DR, out + O_SLC + (size_t)j * NS * 3 * DR);
                hipLaunchKernelGGL(k_lru_gates, dim3(T, DR / 256), dim3(256), 0, stream, XR, in[I_LWA] + (size_t)j * 8 * 128 * 128, in[I_LBA] + (size_t)j * DR, in[I_LWX] + (size_t)j * 8 * 128 * 128, in[I_LBX] + (size_t)j * DR,
                                   in[I_LLAM] + (size_t)j * DR, AV, BV);
                hipLaunchKernelGGL(k_lru_scan, dim3(NSEQ, DR / 256), dim3(256), 0, stream, AV, BV, ZX, in[I_SLH] + (size_t)j * NS * DR, YN, out + O_PLH + (size_t)j * NB * DR, out + O_SLH + (size_t)j * NS * DR);
            }
            }
            ++ph; continue;
        }
        int hi = ph + 1;
        hi = NPH;
        a.ph_lo = ph; a.ph_hi = hi;
        void* kargs[] = {(void*)&a};
        const hipError_t e = hipLaunchCooperativeKernel((const void*)mk_fwd, dim3(grid), dim3(NTHR), kargs, LDS_BYTES, stream);
        if (e != hipSuccess) fprintf(stderr, "kernel_launch: cooperative launch failed: %s (grid %d)\n", hipGetErrorString(e), grid);
        ph = hi;
    }
}
```

```cpp
#include <hip/hip_runtime.h>
#include <hip/hip_cooperative_groups.h>
#include <cstdio>
#include <cstdint>
namespace cg = cooperative_groups;

constexpr int DM = 1024, NB = 8, SEQ = 2048, NMETA = 16, LP = SEQ + NMETA  , NS = 128;
constexpr int TP = NB * LP  , T = TP + NS  ;
constexpr int DI = 2048, HD = 64, NH = 32, NG = 8, NST = 128, CONVD = 4096, INDIM = 6176, DFF = 4096, DR = 1024;
constexpr int ZXW = 6144;
constexpr int NPAD_SSD = 6400;
constexpr int NSEQ = NB + NS;
constexpr float EPS = 1e-6f;

constexpr size_t O_YP = 0, O_YS = O_YP + (size_t)NB * SEQ * DM, O_PSC = O_YS + (size_t)NS * DM, O_PSH = O_PSC + (size_t)2 * NB * 3 * CONVD,
                 O_PLC = O_PSH + (size_t)2 * NB * NH * HD * NST, O_PLH = O_PLC + (size_t)2 * NB * 3 * DR, O_SSC = O_PLH + (size_t)2 * NB * DR,
                 O_SSH = O_SSC + (size_t)2 * NS * 3 * CONVD, O_SLC = O_SSH + (size_t)2 * NS * NH * HD * NST, O_SLH = O_SLC + (size_t)2 * NS * 3 * DR,
                 O_END = O_SLH + (size_t)2 * NS * DR;

enum { I_XP = 0, I_XS, I_SSC, I_SSH, I_SLC, I_SLH, I_META, I_NMPRE, I_NMPOST, I_NFPRE, I_NFPOST, I_SWIN, I_SCW, I_SCB, I_SDTB, I_SALOG, I_SD, I_SNORM, I_SWOUT,
       I_LWIN, I_LBIN, I_LCW, I_LCB, I_LWA, I_LBA, I_LWX, I_LBX, I_LLAM, I_LWOUT, I_LBOUT, I_W1, I_W2, N_IN };

#ifndef SUBREP
#define SUBREP 0
#endif
typedef unsigned short bf16;

constexpr size_t MiB = 1u << 20;
constexpr size_t WS_CTL = 0, CTL_ZERO_BYTES = 32768;
constexpr size_t WS_LCF = 512 * 1024;
constexpr size_t WE_SIN = 0, WE_SOUT = WE_SIN + (size_t)NPAD_SSD * DM, WE_SEND = WE_SOUT + (size_t)DM * DI;
constexpr size_t WE_LIN = 0, WE_LAX = WE_LIN + (size_t)2048 * DM, WE_LOUT = WE_LAX + (size_t)8 * 256 * 128, WE_LEND = WE_LOUT + (size_t)DM * DR;
constexpr size_t WE_F1 = 0, WE_F2 = WE_F1 + (size_t)DFF * DM, WE_FEND = WE_F2 + (size_t)DM * DFF;
constexpr size_t WE_SSD0 = 0, WE_LRU0 = WE_SSD0 + 2 * WE_SEND, WE_FFN0 = WE_LRU0 + 2 * WE_LEND, WE_TOTAL = WE_FFN0 + 4 * WE_FEND;
constexpr size_t WS_W = 1 * MiB;
constexpr size_t WS_X = 121 * MiB;
constexpr size_t WS_XB = WS_X + 65 * MiB;
constexpr size_t WS_RS = WS_XB + 33 * MiB;
constexpr size_t WS_M = WS_RS + 1 * MiB;
constexpr size_t WS_ZX = WS_M + 65 * MiB;
constexpr size_t WS_DT = WS_ZX + 195 * MiB;
constexpr size_t WS_YN = WS_DT + 3 * MiB;
constexpr size_t WS_SCR = WS_YN + 65 * MiB;
constexpr size_t WS_END = WS_SCR + 400 * MiB;
static_assert(WE_TOTAL * 2 <= 120 * MiB, "weight region");
static_assert(WS_END <= 1024 * MiB, "d_ws map");

#define GAS __attribute__((address_space(1)))
#define LAS __attribute__((address_space(3)))
typedef unsigned v4u __attribute__((ext_vector_type(4)));
typedef unsigned v2u __attribute__((ext_vector_type(2)));
typedef float v4f __attribute__((ext_vector_type(4)));
typedef float v2f __attribute__((ext_vector_type(2)));
#define LDS_WAIT() asm volatile("s_waitcnt lgkmcnt(0)" ::: "memory")
#define VM_WAIT() asm volatile("s_waitcnt vmcnt(0)" ::: "memory")

__device__ __forceinline__ float silu_f(float x) { return x * __builtin_amdgcn_rcpf(1.f + __expf(-x)); }
__device__ __forceinline__ float sigmoid_f(float x) { return __builtin_amdgcn_rcpf(1.f + __expf(-x)); }
__device__ __forceinline__ float neg_expm1_f(float x) { const float p = x * (1.f + x * (0.5f + x * (0.16666667f + x * (0.041666668f + x * (0.0083333338f + x * 0.0013888889f)))));
    return x > -0.35f ? -p : 1.f - __expf(x); }
__device__ __forceinline__ float softplus_f(float x) { return fmaxf(x, 0.f) + log1pf(__expf(-fabsf(x))); }
__device__ __forceinline__ float one_minus_exp2x(float x, float e) { const float t = 2.f * x;
    const float p = t * (1.f + t * (0.5f + t * (0.16666667f + t * (0.041666668f + t * (0.0083333338f + t * 0.0013888889f)))));
    return t > -0.35f ? -p : 1.f - e * e; }
__device__ __forceinline__ void lru_gate2(v2f ga, v2f gx, float bav, float bxv, float cfac, v2f xr, v2f& av, v2f& bt, v2f& la) {
    const v2f ta = ga + bav, tx = gx + bxv;
    v2f ea, ex; ea.x = __expf(-ta.x); ea.y = __expf(-ta.y); ex.x = __expf(-tx.x); ex.y = __expf(-tx.y);
    ea = ea + 1.0f; ex = ex + 1.0f;
    v2f rg, ig; rg.x = __builtin_amdgcn_rcpf(ea.x); rg.y = __builtin_amdgcn_rcpf(ea.y); ig.x = __builtin_amdgcn_rcpf(ex.x); ig.y = __builtin_amdgcn_rcpf(ex.y);
    la = rg * (-cfac);
    av.x = __expf(la.x); av.y = __expf(la.y);
    const v2f t = la * 2.0f;
    const v2f p = t * (1.0f + t * (0.5f + t * (0.16666667f + t * (0.041666668f + t * (0.0083333338f + t * 0.0013888889f)))));
    const v2f q = 1.0f - av * av;
    v2f om; om.x = t.x > -0.35f ? -p.x : q.x; om.y = t.y > -0.35f ? -p.y : q.y;
    v2f mu; mu.x = __builtin_amdgcn_sqrtf(om.x); mu.y = __builtin_amdgcn_sqrtf(om.y);
    bt = mu * ig * xr;
}
__device__ __forceinline__ float gelu_tanh_f(float x) { const float u = 0.7978845608028654f * (x + 0.044715f * x * x * x); return x * __builtin_amdgcn_rcpf(1.f + __expf(-2.f * u)); }
__device__ __forceinline__ float dpp_add(float v, float w) { return v + w; }
#define WS_DPP(v, ctrl, rmask) ((v) + __builtin_bit_cast(float, __builtin_amdgcn_update_dpp(0, __builtin_bit_cast(int, (v)), (ctrl), (rmask), 0xf, true)))
__device__ __forceinline__ float wave_sum(float v) {
    v = WS_DPP(v, 0xB1, 0xf);
    v = WS_DPP(v, 0x4E, 0xf);
    v = WS_DPP(v, 0x141, 0xf);
    v = WS_DPP(v, 0x140, 0xf);
    v = WS_DPP(v, 0x142, 0xa);
    v = WS_DPP(v, 0x143, 0xc);
    return __builtin_bit_cast(float, __builtin_amdgcn_readlane(__builtin_bit_cast(int, v), 63));
}
__device__ __forceinline__ float xor32_f(float x, int lane) { const unsigned u = __builtin_bit_cast(unsigned, x); const auto r = __builtin_amdgcn_permlane32_swap(u, u, false, false);
    return __builtin_bit_cast(float, lane < 32 ? r[1] : r[0]); }
__device__ __forceinline__ float xor16_f(float x, int lane) { const unsigned u = __builtin_bit_cast(unsigned, x); const auto r = __builtin_amdgcn_permlane16_swap(u, u, false, false);
    return __builtin_bit_cast(float, (lane & 16) ? r[0] : r[1]); }
typedef __bf16 bf16x2_hw __attribute__((ext_vector_type(2)));
__device__ __forceinline__ unsigned pk2(float lo, float hi) { const v2f v = {lo, hi}; return __builtin_bit_cast(unsigned, __builtin_convertvector(v, bf16x2_hw)); }
__device__ __forceinline__ unsigned f2bf(float f) { return pk2(f, 0.f) & 0xffffu; }
__device__ __forceinline__ float bf2f(bf16 b) { return __builtin_bit_cast(float, (unsigned)b << 16); }
__device__ __forceinline__ float bflo(unsigned w) { return __builtin_bit_cast(float, w << 16); }
__device__ __forceinline__ float bfhi(unsigned w) { return __builtin_bit_cast(float, w & 0xffff0000u); }
__device__ __forceinline__ int seq_row0(int q) { return q < NB ? q * LP : TP + (q - NB); }
__device__ __forceinline__ int seq_len(int q) { return q < NB ? LP : 1; }

namespace pg8 {
#define PG8_LAS __attribute__((address_space(3)))
typedef unsigned short bf16_t;
typedef short bf16x8 __attribute__((ext_vector_type(8)));
typedef float f32x4 __attribute__((ext_vector_type(4)));
typedef unsigned u32x4 __attribute__((ext_vector_type(4)));
constexpr int BM = 256, BK = 64, HALF = 128, HTB = HALF * BK * 2  , STAGE_BYTES = 8 * HTB, NXCD = 8, WGM = 4;

__host__ __device__ __forceinline__ int lds_byte(int r, int c) { const int st = (r >> 4) * 2 + (c >> 5), rr = r & 15, cc = c & 31, ob = rr * 64 + cc * 2; return st * 1024 + (ob ^ (((ob >> 9) & 1) << 5)); }
__host__ __device__ __forceinline__ void stage_rc(int b, int& R, int& C) { const int st = b / 1024, sb = b % 1024, swz = sb ^ (((sb >> 9) & 1) << 5); R = (st >> 1) * 16 + swz / 64; C = (st & 1) * 32 + (swz % 64) / 2; }
__host__ __device__ __forceinline__ int perm32(int rho) { const int n = rho >> 4, i = rho & 15; return 8 * (i >> 2) + 4 * n + (i & 3); }

struct Unit { int pm, pn; };
struct Gemm { const bf16_t* A; const bf16_t* Bt; int M, N, K; };

struct StaticOrder {
    int nM, nN, nwg, G, c;
    __host__ __device__ void init(int M, int N, int G_, int c_) { nM = M / BM; nN = N / BM; nwg = nM * nN; G = G_; c = c_; }
    __host__ __device__ bool next(int i, Unit& u) const {
        const long L = (long)i * G + c; if (L >= nwg) return false;
        int wgid = (int)L; { const int q = nwg / NXCD, r = nwg % NXCD, xcd = wgid % NXCD, off = wgid / NXCD; wgid = (xcd < r ? xcd * (q + 1) : r * (q + 1) + (xcd - r) * q) + off; }
        const int nig = WGM * nN, gid = wgid / nig, fm = gid * WGM, gsz = (nM - fm) < WGM ? (nM - fm) : WGM;
        u.pm = fm + ((wgid % nig) % gsz); u.pn = (wgid % nig) / gsz; return true;
    }
    __device__ __forceinline__ void a_ready(const Unit&) const {}
    __device__ __forceinline__ void done(const Unit&) const {}
};
__device__ __forceinline__ unsigned cvt_pk_bf16(float lo, float hi) { return ::pk2(lo, hi); }

template <class Epi, class Sched, bool ALIGN_EPI = false, bool SP2 = false>
__device__ __forceinline__ void gemm_phase(PG8_LAS unsigned char* lds, const Gemm g, const Sched& S, const Epi& E) {
    int tid_ = threadIdx.x; asm volatile("" : "+v"(tid_));
    const int tid = tid_, wid = __builtin_amdgcn_readfirstlane(tid >> 6), lane = tid & 63, wr = wid >> 2, wc = wid & 3, fr = lane & 15, fq = lane >> 4;
    const int K = g.K, nt = K / BK;
    unsigned voffA[2], voffB[2];
#pragma unroll
    for (int i = 0; i < 2; ++i) { int R, C; stage_rc(tid * 16 + i * 8192, R, C); const int Rb = Epi::PERM ? ((R & ~31) + perm32(R & 31)) : R;
        voffA[i] = (unsigned)(R * K + C) * 2u; voffB[i] = (unsigned)(Rb * K + C) * 2u; }
    const size_t kstep = (size_t)(BK * 2);
    const size_t hstep = (size_t)HALF * K * 2;
    const size_t tstep = 2 * hstep;
    const unsigned ldsw = (unsigned)wid * 1024u;
    const int aoff = lds_byte(wr * 64 + fr, fq * 8), boff = lds_byte(wc * 32 + fr, fq * 8);
#define PG8_SA(b, h) (((b) * 2 + (h)) * HTB)
#define PG8_SB(b, h) ((4 + (b) * 2 + (h)) * HTB)
#define PG8_STAGE(bufoff, gbase, voff) do { _Pragma("unroll") for (int _i = 0; _i < 2; ++_i) \
        __builtin_amdgcn_global_load_lds((const unsigned*)((const char*)(gbase) + (voff)[_i]), (PG8_LAS unsigned*)(lds + (bufoff) + ldsw + _i * 8192), 16, 0, 0); } while (0)
#define PG8_LDA(dst, b, h) do { _Pragma("unroll") for (int m = 0; m < 4; ++m) _Pragma("unroll") for (int k = 0; k < 2; ++k) dst[m][k] = *(const PG8_LAS bf16x8*)(lds + PG8_SA(b, h) + aoff + m * 2048 + k * 1024); } while (0)
#define PG8_LDB(dst, b, h) do { _Pragma("unroll") for (int n = 0; n < 2; ++n) _Pragma("unroll") for (int k = 0; k < 2; ++k) dst[n][k] = *(const PG8_LAS bf16x8*)(lds + PG8_SB(b, h) + boff + n * 2048 + k * 1024); } while (0)
#define PG8_MMA(ai, bj, At, Bt) do { __builtin_amdgcn_s_setprio(1); _Pragma("unroll") for (int m = 0; m < 4; ++m) _Pragma("unroll") for (int n = 0; n < 2; ++n) _Pragma("unroll") for (int k = 0; k < 2; ++k) \
        acc[ai][bj][m][n] = __builtin_amdgcn_mfma_f32_16x16x32_bf16(Bt[n][k], At[m][k], acc[ai][bj][m][n], 0, 0, 0); __builtin_amdgcn_s_setprio(0); } while (0)
#define PG8_WAIT_V(n) asm volatile("s_waitcnt vmcnt(" #n ")" ::: "memory")
#define PG8_WAIT_L(n) asm volatile("s_waitcnt lgkmcnt(" #n ")" ::: "memory")
#define PG8_BAR __builtin_amdgcn_s_barrier()
#define PG8_SCHED __builtin_amdgcn_sched_barrier(0)
    Unit cur, nxt; int ui = 0;
    if (!S.next(0, cur)) return;
    f32x4 acc[2][2][4][2];
#pragma unroll
    for (int a = 0; a < 2; ++a)
#pragma unroll
        for (int b = 0; b < 2; ++b)
#pragma unroll
            for (int m = 0; m < 4; ++m)
#pragma unroll
                for (int n = 0; n < 2; ++n) acc[a][b][m][n] = (f32x4){0.f, 0.f, 0.f, 0.f};
    bf16x8 At[4][2], B0[2][2], B1[2][2];
    const char* cA = (const char*)g.A + (size_t)cur.pm * tstep; const char* cB = (const char*)g.Bt + (size_t)cur.pn * tstep;
    S.a_ready(cur);
    if constexpr (SP2) {
        PG8_STAGE(PG8_SB(0, 0), cB, voffB); PG8_STAGE(PG8_SB(0, 1), cB + hstep, voffB); PG8_STAGE(PG8_SA(0, 0), cA, voffA); PG8_STAGE(PG8_SA(0, 1), cA + hstep, voffA);
        if (wr == 1) PG8_BAR;
        PG8_WAIT_V(2); PG8_BAR;
        PG8_STAGE(PG8_SB(1, 0), cB + kstep, voffB); PG8_STAGE(PG8_SA(1, 0), cA + kstep, voffA); PG8_STAGE(PG8_SB(1, 1), cB + hstep + kstep, voffB);
        PG8_WAIT_V(6); PG8_BAR;
    } else {
        PG8_STAGE(PG8_SB(0, 0), cB, voffB); PG8_STAGE(PG8_SA(0, 0), cA, voffA); PG8_STAGE(PG8_SB(0, 1), cB + hstep, voffB); PG8_STAGE(PG8_SA(0, 1), cA + hstep, voffA);
        if (wr == 1) PG8_BAR;
        PG8_WAIT_V(4); PG8_BAR;
        PG8_STAGE(PG8_SB(1, 0), cB + kstep, voffB); PG8_STAGE(PG8_SA(1, 0), cA + kstep, voffA); PG8_STAGE(PG8_SB(1, 1), cB + hstep + kstep, voffB);
        PG8_WAIT_V(6); PG8_BAR;
    }
    for (;;) {
        const bool has_next = S.next(ui + 1, nxt);
        const char* nA = has_next ? (const char*)g.A + (size_t)nxt.pm * tstep : cA; const char* nB = has_next ? (const char*)g.Bt + (size_t)nxt.pn * tstep : cB;
        for (int t = 0; t < nt; t += 2) {
            const bool last = (t == nt - 2);
            const char* a1 = cA + (size_t)(t + 1) * kstep;
            const char* a2 = last ? nA : cA + (size_t)(t + 2) * kstep; const char* b2 = last ? nB : cB + (size_t)(t + 2) * kstep;
            const char* a3 = a2 + kstep; const char* b3 = b2 + kstep;
            if (last && has_next) S.a_ready(nxt);
            if constexpr (SP2) {
            PG8_LDB(B0, 0, 0); PG8_LDB(B1, 0, 1); PG8_SCHED; PG8_LDA(At, 0, 0); PG8_STAGE(PG8_SA(1, 1), a1 + hstep, voffA);
            PG8_WAIT_V(8); PG8_WAIT_L(0); PG8_BAR; PG8_MMA(0, 0, At, B0); PG8_MMA(0, 1, At, B1); PG8_BAR; PG8_SCHED;
            PG8_LDA(At, 0, 1); PG8_STAGE(PG8_SB(0, 0), b2, voffB); PG8_STAGE(PG8_SB(0, 1), b2 + hstep, voffB); PG8_STAGE(PG8_SA(0, 0), a2, voffA);
            PG8_WAIT_V(8); PG8_WAIT_L(0); PG8_BAR; PG8_MMA(1, 0, At, B0); PG8_MMA(1, 1, At, B1); PG8_BAR; PG8_SCHED;
            PG8_LDB(B0, 1, 0); PG8_LDB(B1, 1, 1); PG8_SCHED; PG8_LDA(At, 1, 0); PG8_STAGE(PG8_SA(0, 1), a2 + hstep, voffA);
            PG8_WAIT_V(8); PG8_WAIT_L(0); PG8_BAR; PG8_MMA(0, 0, At, B0); PG8_MMA(0, 1, At, B1); PG8_BAR; PG8_SCHED;
            PG8_LDA(At, 1, 1); PG8_STAGE(PG8_SB(1, 0), b3, voffB); PG8_STAGE(PG8_SB(1, 1), b3 + hstep, voffB); PG8_STAGE(PG8_SA(1, 0), a3, voffA);
            PG8_WAIT_V(8); PG8_WAIT_L(0); PG8_BAR; PG8_MMA(1, 0, At, B0); PG8_MMA(1, 1, At, B1); PG8_BAR; PG8_SCHED;
            } else {
            PG8_LDB(B0, 0, 0); PG8_SCHED; PG8_LDA(At, 0, 0); PG8_STAGE(PG8_SA(1, 1), a1 + hstep, voffA);
            PG8_WAIT_L(8); PG8_BAR; PG8_WAIT_L(0); PG8_MMA(0, 0, At, B0); PG8_BAR; PG8_SCHED;
            PG8_LDB(B1, 0, 1); PG8_STAGE(PG8_SB(0, 0), b2, voffB);
            PG8_BAR; PG8_WAIT_L(0); PG8_MMA(0, 1, At, B1); PG8_BAR;
            PG8_LDA(At, 0, 1); PG8_STAGE(PG8_SA(0, 0), a2, voffA);
            PG8_BAR; PG8_WAIT_L(0); PG8_MMA(1, 0, At, B0); PG8_BAR; PG8_SCHED;
            PG8_STAGE(PG8_SB(0, 1), b2 + hstep, voffB);
            PG8_WAIT_V(6); PG8_BAR; PG8_MMA(1, 1, At, B1); PG8_BAR;
            PG8_LDB(B0, 1, 0); PG8_SCHED; PG8_LDA(At, 1, 0); PG8_STAGE(PG8_SA(0, 1), a2 + hstep, voffA);
            PG8_WAIT_L(8); PG8_BAR; PG8_WAIT_L(0); PG8_MMA(0, 0, At, B0); PG8_BAR; PG8_SCHED;
            PG8_LDB(B1, 1, 1); PG8_STAGE(PG8_SB(1, 0), b3, voffB);
            PG8_BAR; PG8_WAIT_L(0); PG8_MMA(0, 1, At, B1); PG8_BAR;
            PG8_LDA(At, 1, 1); PG8_STAGE(PG8_SA(1, 0), a3, voffA);
            PG8_BAR; PG8_WAIT_L(0); PG8_MMA(1, 0, At, B0); PG8_BAR; PG8_SCHED;
            PG8_STAGE(PG8_SB(1, 1), b3 + hstep, voffB);
            PG8_WAIT_V(6); PG8_BAR; PG8_MMA(1, 1, At, B1); PG8_BAR;
            }
        }
        if constexpr (ALIGN_EPI) { if (wr == 0) PG8_BAR; }
        if constexpr (!Epi::AFTER_DRAIN) { E(acc, cur, wr, wc, fr, fq); if (SUBREP & 2048) asm volatile("s_waitcnt vmcnt(0)" ::: "memory"); if (SUBREP & 1024) { asm volatile("" ::: "memory"); E(acc, cur, wr, wc, fr, fq); } S.done(cur); }
        if (!has_next) break;
#pragma unroll
        for (int a = 0; a < 2; ++a)
#pragma unroll
            for (int b = 0; b < 2; ++b)
#pragma unroll
                for (int m = 0; m < 4; ++m)
#pragma unroll
                    for (int n = 0; n < 2; ++n) acc[a][b][m][n] = (f32x4){0.f, 0.f, 0.f, 0.f};
        cur = nxt; cA = nA; cB = nB; ++ui;
        if constexpr (ALIGN_EPI) { if (wr == 1) PG8_BAR; }
    }
    PG8_WAIT_V(0);
    if constexpr (!ALIGN_EPI) { if (wr == 0) PG8_BAR; }
    PG8_BAR;
    if constexpr (Epi::AFTER_DRAIN) { E.fused(acc, cur, wr, wc, fr, fq, lds, wid, lane); S.done(cur); }
#undef PG8_SA
#undef PG8_SB
#undef PG8_STAGE
#undef PG8_LDA
#undef PG8_LDB
#undef PG8_MMA
#undef PG8_WAIT_V
#undef PG8_WAIT_L
#undef PG8_BAR
#undef PG8_SCHED
}
}

namespace pg8 {
#define EPI_STORE16(p, v) (*(u32x4*)(p) = (v))
struct EpiSsdIn {
    static constexpr bool PERM = true, AFTER_DRAIN = false;
    bf16_t* ZX; float* DT; const float* rs;
    __device__ __forceinline__ void elem(int r, int c, float v) const { if (c < ZXW) ZX[(size_t)r * ZXW + c] = (bf16_t)f2bf(v); else DT[(size_t)r * 32 + (c - ZXW)] = v; }
    __device__ __forceinline__ void operator()(const f32x4 (&acc)[2][2][4][2], const Unit& u, int wr, int wc, int fr, int fq) const {
        const int row0 = u.pm * BM + wr * 64 + fr;
        if (u.pn < 24) {
            const int col0 = u.pn * BM + wc * 32 + 8 * fq;
#pragma unroll
            for (int ai = 0; ai < 2; ++ai)
#pragma unroll
                for (int m = 0; m < 4; ++m) { const int r = row0 + ai * HALF + m * 16; bf16_t* rowp = ZX + (size_t)r * ZXW + col0;
#pragma unroll
                    for (int bj = 0; bj < 2; ++bj) { const f32x4 v0 = acc[ai][bj][m][0], v1 = acc[ai][bj][m][1];
                        u32x4 w; w.x = cvt_pk_bf16(v0[0], v0[1]); w.y = cvt_pk_bf16(v0[2], v0[3]); w.z = cvt_pk_bf16(v1[0], v1[1]); w.w = cvt_pk_bf16(v1[2], v1[3]);
                        EPI_STORE16(rowp + bj * HALF, w); } }
        } else if (wc == 0) {
#pragma unroll
            for (int ai = 0; ai < 2; ++ai)
#pragma unroll
                for (int m = 0; m < 4; ++m) { const int r = row0 + ai * HALF + m * 16; float* p = DT + (size_t)r * 32 + 8 * fq;
                    *(f32x4*)p = acc[ai][0][m][0]; *(f32x4*)(p + 4) = acc[ai][0][m][1]; }
        }
    }
};
struct EpiLruIn {
    static constexpr bool PERM = true, AFTER_DRAIN = false;
    bf16_t* G; bf16_t* XRAW; const float* rs; const float* bias;
    __device__ __forceinline__ void elem(int r, int c, float v) const { v = v + bias[c]; if (c < DR) G[(size_t)r * DR + c] = (bf16_t)f2bf(gelu_tanh_f(v)); else XRAW[(size_t)r * DR + (c - DR)] = (bf16_t)f2bf(v); }
    __device__ __forceinline__ void operator()(const f32x4 (&acc)[2][2][4][2], const Unit& u, int wr, int wc, int fr, int fq) const {
        const int row0 = u.pm * BM + wr * 64 + fr, bcol0 = u.pn * BM + wc * 32 + 8 * fq; const bool gate = u.pn < 4;
        bf16_t* base = gate ? G : XRAW; const int col0 = (gate ? bcol0 : bcol0 - DR);
        f32x4 bv[2][2];
#pragma unroll
        for (int bj = 0; bj < 2; ++bj)
#pragma unroll
            for (int n = 0; n < 2; ++n) bv[bj][n] = *(const f32x4*)(bias + bcol0 + bj * HALF + 4 * n);
#pragma unroll
        for (int ai = 0; ai < 2; ++ai)
#pragma unroll
            for (int m = 0; m < 4; ++m) { const int r = row0 + ai * HALF + m * 16; bf16_t* rowp = base + (size_t)r * DR + col0;
#pragma unroll
                for (int bj = 0; bj < 2; ++bj) { f32x4 v0 = acc[ai][bj][m][0] + bv[bj][0], v1 = acc[ai][bj][m][1] + bv[bj][1];
                    if (gate) {
#pragma unroll
                        for (int j = 0; j < 4; ++j) { v0[j] = gelu_tanh_f(v0[j]); v1[j] = gelu_tanh_f(v1[j]); } }
                    u32x4 w; w.x = cvt_pk_bf16(v0[0], v0[1]); w.y = cvt_pk_bf16(v0[2], v0[3]); w.z = cvt_pk_bf16(v1[0], v1[1]); w.w = cvt_pk_bf16(v1[2], v1[3]);
                    EPI_STORE16(rowp + bj * HALF, w); } }
    }
};
struct EpiFfn1 {
    static constexpr bool PERM = true, AFTER_DRAIN = false;
    bf16_t* H1; const float* rs;
    __device__ __forceinline__ void elem(int r, int c, float v) const { v = fmaxf(v, 0.f); H1[(size_t)r * DFF + c] = (bf16_t)f2bf(v * v); }
    __device__ __forceinline__ void operator()(const f32x4 (&acc)[2][2][4][2], const Unit& u, int wr, int wc, int fr, int fq) const {
        const int row0 = u.pm * BM + wr * 64 + fr, col0 = u.pn * BM + wc * 32 + 8 * fq;
#pragma unroll
        for (int ai = 0; ai < 2; ++ai)
#pragma unroll
            for (int m = 0; m < 4; ++m) { const int r = row0 + ai * HALF + m * 16; bf16_t* rowp = H1 + (size_t)r * DFF + col0;
#pragma unroll
                for (int bj = 0; bj < 2; ++bj) { f32x4 v0 = acc[ai][bj][m][0], v1 = acc[ai][bj][m][1];
#pragma unroll
                    for (int j = 0; j < 4; ++j) { v0[j] = fmaxf(v0[j], 0.f); v0[j] *= v0[j]; v1[j] = fmaxf(v1[j], 0.f); v1[j] *= v1[j]; }
                    u32x4 w; w.x = cvt_pk_bf16(v0[0], v0[1]); w.y = cvt_pk_bf16(v0[2], v0[3]); w.z = cvt_pk_bf16(v1[0], v1[1]); w.w = cvt_pk_bf16(v1[2], v1[3]);
                    EPI_STORE16(rowp + bj * HALF, w); } }
    }
};
struct EpiM {
    static constexpr bool PERM = true, AFTER_DRAIN = false;
    bf16_t* C; const float* bias;
    __device__ __forceinline__ void elem(int r, int c, float v) const { C[(size_t)r * DM + c] = (bf16_t)f2bf(v + (bias ? bias[c] : 0.f)); }
    __device__ __forceinline__ void operator()(const f32x4 (&acc)[2][2][4][2], const Unit& u, int wr, int wc, int fr, int fq) const {
        const int row0 = u.pm * BM + wr * 64 + fr, col0 = u.pn * BM + wc * 32 + 8 * fq;
        f32x4 bv[2][2];
#pragma unroll
        for (int bj = 0; bj < 2; ++bj)
#pragma unroll
            for (int n = 0; n < 2; ++n) bv[bj][n] = bias ? *(const f32x4*)(bias + col0 + bj * HALF + 4 * n) : (f32x4){0.f, 0.f, 0.f, 0.f};
#pragma unroll
        for (int ai = 0; ai < 2; ++ai)
#pragma unroll
            for (int m = 0; m < 4; ++m) { bf16_t* rowp = C + (size_t)(row0 + ai * HALF + m * 16) * DM + col0;
#pragma unroll
                for (int bj = 0; bj < 2; ++bj) { const f32x4 v0 = acc[ai][bj][m][0] + bv[bj][0], v1 = acc[ai][bj][m][1] + bv[bj][1];
                    u32x4 w; w.x = cvt_pk_bf16(v0[0], v0[1]); w.y = cvt_pk_bf16(v0[2], v0[3]); w.z = cvt_pk_bf16(v1[0], v1[1]); w.w = cvt_pk_bf16(v1[2], v1[3]);
                    EPI_STORE16(rowp + bj * HALF, w); } }
    }
};
}

constexpr int NWAVES = 8, NTHR = 512;
constexpr int RING_BYTES = 131072, LDS_BYTES = 153600;
constexpr int LDS_MISC_OFF = 152576;
constexpr int CW_BAR = 4096;
#ifndef TOUCH_W
#define TOUCH_W 0
#endif
#ifndef REP_MASK
#define REP_MASK 0
#endif
constexpr int PL = 9, NPH = 1 + 4 * PL;

struct Args { const float* in[N_IN]; float* out; unsigned char* ws; int ph_lo, ph_hi; };
__device__ __forceinline__ const float* arg_in(int k) {
    const auto ka = __builtin_amdgcn_kernarg_segment_ptr();
    unsigned long long p;
    asm volatile("s_load_dwordx2 %0, %1, %2\n\ts_waitcnt lgkmcnt(0)" : "=s"(p) : "s"(ka), "s"(k * 8) : "memory");
    return (const float*)p;
}

constexpr int TP_PITCH = 68, TP_WAVE_BYTES = 64 * TP_PITCH * 4;
__device__ __forceinline__ void p0_transpose_item(const float* W, int ldw, int N, int nblk, bf16* WT, int ldt, int row_off, const float* scale, LAS float* scr, int item, int lane) {
    const int kb = item / nblk, nb = item % nblk, k0 = 64 * kb, n0 = 64 * nb, c4 = 4 * (lane & 15), rq = lane >> 4;
    v4f v[16];
#pragma unroll
    for (int i = 0; i < 16; ++i) v[i] = (n0 + c4 < N) ? *(const GAS v4f*)(W + (size_t)(k0 + 4 * i + rq) * ldw + n0 + c4) : (v4f){0.f, 0.f, 0.f, 0.f};
#pragma unroll
    for (int i = 0; i < 16; ++i) { const float sc = scale ? scale[k0 + 4 * i + rq] : 1.f; *(LAS v4f*)(scr + (4 * i + rq) * TP_PITCH + c4) = v[i] * sc; }
    LDS_WAIT(); asm volatile("" ::: "memory");
    const int c = lane & 7;
#pragma unroll
    for (int jj = 0; jj < 8; ++jj) { const int n = (lane >> 3) + 8 * jj; const LAS float* sp = scr + (8 * c) * TP_PITCH + n;
        v4u o; o.x = pk2(sp[0 * TP_PITCH], sp[1 * TP_PITCH]); o.y = pk2(sp[2 * TP_PITCH], sp[3 * TP_PITCH]); o.z = pk2(sp[4 * TP_PITCH], sp[5 * TP_PITCH]); o.w = pk2(sp[6 * TP_PITCH], sp[7 * TP_PITCH]);
        if (n0 + n < N) *(GAS v4u*)(WT + (size_t)(row_off + n0 + n) * ldt + k0 + 8 * c) = o; }
    LDS_WAIT(); asm volatile("" ::: "memory");
}
constexpr int IT_SIN = (DM / 64) * ((INDIM + 63) / 64), IT_SOUT = (DI / 64) * (DM / 64), IT_LIN = (DM / 64) * (2048 / 64), IT_LAX = 8 * 2 * 4, IT_LOUT = (DR / 64) * (DM / 64),
              IT_F1 = (DM / 64) * (DFF / 64), IT_F2 = (DFF / 64) * (DM / 64), IT_PAIR = IT_SIN + IT_SOUT + IT_LIN + IT_LAX + IT_LOUT + 2 * (IT_F1 + IT_F2);

__device__ __forceinline__ void p0_prologue(const Args& a, LAS unsigned char* lds, int gw, int NGW, int wave, int lane) {
    bf16* WB = (bf16*)(a.ws + WS_W);
    LAS float* scr = (LAS float*)(lds + wave * TP_WAVE_BYTES);
    for (int it = gw; it < 2 * IT_PAIR; it += NGW) {
        const int j = it / IT_PAIR; int r = it % IT_PAIR;
        bf16* ws_ssd = WB + WE_SSD0 + (size_t)j * WE_SEND; bf16* ws_lru = WB + WE_LRU0 + (size_t)j * WE_LEND;
        if (r < IT_SIN) { p0_transpose_item(arg_in(I_SWIN) + (size_t)j * DM * INDIM, INDIM, INDIM, (INDIM + 63) / 64, ws_ssd + WE_SIN, DM, 0, arg_in(I_NMPRE) + (size_t)(2 * j) * DM, scr, r, lane); continue; } r -= IT_SIN;
        if (r < IT_SOUT) { p0_transpose_item(arg_in(I_SWOUT) + (size_t)j * DI * DM, DM, DM, DM / 64, ws_ssd + WE_SOUT, DI, 0, arg_in(I_SNORM) + (size_t)j * DI, scr, r, lane); continue; } r -= IT_SOUT;
        if (r < IT_LIN) { p0_transpose_item(arg_in(I_LWIN) + (size_t)j * DM * 2048, 2048, 2048, 2048 / 64, ws_lru + WE_LIN, DM, 0, arg_in(I_NMPRE) + (size_t)(2 * j + 1) * DM, scr, r, lane); continue; } r -= IT_LIN;
        if (r < IT_LAX) { const int blk = r >> 3, mat = (r >> 2) & 1, sub = r & 3;
            p0_transpose_item(arg_in(mat ? I_LWX : I_LWA) + ((size_t)j * 8 + blk) * 128 * 128, 128, 128, 2, ws_lru + WE_LAX + (size_t)blk * 256 * 128, 128, mat * 128, nullptr, scr, sub, lane); continue; } r -= IT_LAX;
        if (r < IT_LOUT) { p0_transpose_item(arg_in(I_LWOUT) + (size_t)j * DR * DM, DM, DM, DM / 64, ws_lru + WE_LOUT, DR, 0, nullptr, scr, r, lane); continue; } r -= IT_LOUT;
        const int f = r / (IT_F1 + IT_F2), i = 2 * j + f; r -= f * (IT_F1 + IT_F2);
        bf16* ws_ffn = WB + WE_FFN0 + (size_t)i * WE_FEND;
        if (r < IT_F1) { p0_transpose_item(arg_in(I_W1) + (size_t)i * DM * DFF, DFF, DFF, DFF / 64, ws_ffn + WE_F1, DM, 0, arg_in(I_NFPRE) + (size_t)i * DM, scr, r, lane); continue; } r -= IT_F1;
        p0_transpose_item(arg_in(I_W2) + (size_t)i * DFF * DM, DM, DM, DM / 64, ws_ffn + WE_F2, DFF, 0, nullptr, scr, r, lane);
    }
    for (int idx = gw * 64 + lane; idx < 2 * (NPAD_SSD - INDIM) * DM / 8; idx += NGW * 64) { const int j = idx / ((NPAD_SSD - INDIM) * DM / 8), o = idx % ((NPAD_SSD - INDIM) * DM / 8);
        ((GAS v4u*)(WB + WE_SSD0 + (size_t)j * WE_SEND + WE_SIN + (size_t)INDIM * DM))[o] = (v4u){0u, 0u, 0u, 0u}; }
    for (int idx = gw * 64 + lane; idx < 2 * DR; idx += NGW * 64) ((float*)(a.ws + WS_LCF))[idx] = 8.0f * softplus_f(-arg_in(I_LLAM)[idx]);
    float* X = (float*)(a.ws + WS_X); bf16* XB = (bf16*)(a.ws + WS_XB); float* RS = (float*)(a.ws + WS_RS);
    for (int r = gw; r < T; r += NGW) {
        const float* src;
        if (r < TP) { const int b = r / LP, t = r % LP; src = t < NMETA ? arg_in(I_META) + (size_t)t * DM : arg_in(I_XP) + ((size_t)b * SEQ + (t - NMETA)) * DM; }
        else src = arg_in(I_XS) + (size_t)(r - TP) * DM;
        v4f v[4]; float s = 0.f;
#pragma unroll
        for (int j = 0; j < 4; ++j) { v[j] = ((const GAS v4f*)src)[lane + 64 * j]; s += (v[j].x * v[j].x + v[j].y * v[j].y) + (v[j].z * v[j].z + v[j].w * v[j].w); }
        const float msx = wave_sum(s) * (1.f / DM) + EPS, rsx = rsqrtf(msx);
        if (lane == 0) RS[r] = sqrtf(msx);
#pragma unroll
        for (int j = 0; j < 4; ++j) {
            ((GAS v2u*)(XB + (size_t)r * DM))[lane + 64 * j] = (v2u){pk2(v[j].x * rsx, v[j].y * rsx), pk2(v[j].z * rsx, v[j].w * rsx)}; }
    }
}
__device__ __forceinline__ void resid_phase(const Args& a, const float* g, bool last, int gw, int NGW, int lane) {
    bf16* XB = (bf16*)(a.ws + WS_XB); float* RS = (float*)(a.ws + WS_RS); const bf16* Mb = (const bf16*)(a.ws + WS_M);
    v4f gg[4];
#pragma unroll
    for (int j = 0; j < 4; ++j) gg[j] = ((const GAS v4f*)g)[lane + 64 * j];
    v2u mwn[4], xwn[4]; float invn = 0.f;
    if (gw < T) { invn = RS[gw];
#pragma unroll
        for (int j = 0; j < 4; ++j) { mwn[j] = ((const GAS v2u*)(Mb + (size_t)gw * DM))[lane + 64 * j]; xwn[j] = ((const GAS v2u*)(XB + (size_t)gw * DM))[lane + 64 * j]; } }
    for (int r = gw; r < T; r += NGW) {
        v4f m[4], x[4]; float s = 0.f; const float inv = invn;
#pragma unroll
        for (int j = 0; j < 4; ++j) { m[j] = (v4f){bflo(mwn[j].x), bfhi(mwn[j].x), bflo(mwn[j].y), bfhi(mwn[j].y)};
            x[j] = (v4f){bflo(xwn[j].x), bfhi(xwn[j].x), bflo(xwn[j].y), bfhi(xwn[j].y)} * inv;
            s += (m[j].x * m[j].x + m[j].y * m[j].y) + (m[j].z * m[j].z + m[j].w * m[j].w); }
        if (r + NGW < T) { invn = RS[r + NGW];
#pragma unroll
            for (int j = 0; j < 4; ++j) { mwn[j] = ((const GAS v2u*)(Mb + (size_t)(r + NGW) * DM))[lane + 64 * j]; xwn[j] = ((const GAS v2u*)(XB + (size_t)(r + NGW) * DM))[lane + 64 * j]; } }
        const float rm = rsqrtf(wave_sum(s) * (1.f / DM) + EPS); float s2 = 0.f;
#pragma unroll
        for (int j = 0; j < 4; ++j) { x[j] = x[j] + m[j] * rm * gg[j]; s2 += (x[j].x * x[j].x + x[j].y * x[j].y) + (x[j].z * x[j].z + x[j].w * x[j].w); }
        s2 = wave_sum(s2);
        if (!last) {
            const float msx = s2 * (1.f / DM) + EPS, rsx = rsqrtf(msx);
            if (lane == 0) RS[r] = sqrtf(msx);
#pragma unroll
            for (int j = 0; j < 4; ++j) ((GAS v2u*)(XB + (size_t)r * DM))[lane + 64 * j] = (v2u){pk2(x[j].x * rsx, x[j].y * rsx), pk2(x[j].z * rsx, x[j].w * rsx)};
        } else {
            float* dst = nullptr;
            if (r < TP) { const int b = r / LP, t = r % LP; if (t >= NMETA) dst = a.out + O_YP + ((size_t)b * SEQ + (t - NMETA)) * DM; }
            else dst = a.out + O_YS + (size_t)(r - TP) * DM;
            if (dst) {
#pragma unroll
                for (int j = 0; j < 4; ++j) ((GAS v4f*)dst)[lane + 64 * j] = x[j]; }
        }
    }
}


#ifndef SUBREP
#define SUBREP 0
#endif
typedef short bf16x8 __attribute__((ext_vector_type(8)));
typedef short bf16x4 __attribute__((ext_vector_type(4)));
constexpr int NCH = 17, N_CITEMS = NB * NCH * NG;
constexpr int YSP = 264;
constexpr int XS = 136;
constexpr size_t SC_CST = 0;
constexpr size_t SC_HPREV = SC_CST + (size_t)NB * NCH * NH * HD * NST * 2;
constexpr size_t SC_DEC = SC_HPREV + (size_t)NB * NCH * NH * HD * NST * 2;
constexpr size_t SC_END = SC_DEC + 65536;
static_assert(SC_END <= 400 * MiB, "ssd scratch");

struct SsdItem { int b, c, g, Q, row0; };
__device__ __forceinline__ SsdItem ssd_item(int item) { SsdItem it; it.g = item % NG;
    if (item < NB * 16 * NG) { it.c = 1 + (item / NG) % 16; it.b = item / (NG * 16); } else { it.c = 0; it.b = (item - NB * 16 * NG) / NG; }
    it.Q = it.c == 0 ? NMETA : 128; it.row0 = it.b * LP + (it.c == 0 ? 0 : NMETA + 128 * (it.c - 1)); return it; }

__device__ __forceinline__ float ssd_dt_cs(const float* DT, int row0, int Q, int h, float dtb, float Aneg, LAS float* dtl, LAS float* csl, int lane) {
    float d0 = 0.f, d1 = 0.f;
    if (lane < Q) d0 = softplus_f(DT[(size_t)(row0 + lane) * 32 + h] + dtb);
    if (lane + 64 < Q) d1 = softplus_f(DT[(size_t)(row0 + lane + 64) * 32 + h] + dtb);
    float a0 = d0 * Aneg, a1 = d1 * Aneg;
#pragma unroll
    for (int o = 1; o < 64; o <<= 1) { const float t0 = __shfl_up(a0, o), t1 = __shfl_up(a1, o); if (lane >= o) { a0 += t0; a1 += t1; } }
    const float tot0 = __shfl(a0, 63); a1 += tot0;
    const float tot = __shfl(a1, 63);
    dtl[lane] = d0; dtl[lane + 64] = d1; csl[lane] = a0; csl[lane + 64] = a1;
    return tot;
}


__device__ __forceinline__ float bf_elem(const v4u& w, int k) { const unsigned x = k < 2 ? w.x : k < 4 ? w.y : k < 6 ? w.z : w.w; return (k & 1) ? bfhi(x) : bflo(x); }
#define XT_SWZ(row) (((row) >> 4) & 7)
template <bool ROWMAJOR>
__device__ __forceinline__ void ssd_conv_lane(const bf16* src  , bool hasprev, const float* cw, const float* cb, int cc, LAS bf16* dst, int s0, int swz, float* cso  , int Q) {
    v4u raw[19];
#pragma unroll
    for (int i = 0; i < 3; ++i) { const v4u t = *(const GAS v4u*)(src + (ptrdiff_t)(hasprev ? i - 3 : 0) * ZXW); raw[i] = hasprev ? t : (v4u){0u, 0u, 0u, 0u}; }
#pragma unroll
    for (int i = 0; i < 16; ++i) raw[3 + i] = *(const GAS v4u*)(src + (size_t)i * ZXW);
    v4f wv[4][2], bv[2];
#pragma unroll
    for (int t = 0; t < 4; ++t) { wv[t][0] = *(const GAS v4f*)(cw + (size_t)t * CONVD + cc); wv[t][1] = *(const GAS v4f*)(cw + (size_t)t * CONVD + cc + 4); }
    bv[0] = *(const GAS v4f*)(cb + cc); bv[1] = *(const GAS v4f*)(cb + cc + 4);
    if (cso) {
#pragma unroll
        for (int i = 0; i < 3; ++i) { float* o = cso + (size_t)i * CONVD + cc; const v4u w = raw[16 + i];
            *(GAS v4f*)o = (v4f){bflo(w.x), bfhi(w.x), bflo(w.y), bfhi(w.y)}; *(GAS v4f*)(o + 4) = (v4f){bflo(w.z), bfhi(w.z), bflo(w.w), bfhi(w.w)}; } }
#define RAW2(i) ((v2f){bf_elem(raw[i], k), bf_elem(raw[i], k + 1)})
#define CW2(t) ((v2f){wv[t][k >> 2][k & 3], wv[t][k >> 2][(k & 3) + 1]})
    if (!ROWMAJOR) {
        const int c0 = s0 >> 3;
#pragma unroll
        for (int kp = 0; kp < 4; ++kp) { const int k = 2 * kp;
            const v2f w0 = CW2(0), w1 = CW2(1), w2 = CW2(2), w3 = CW2(3), bb = (v2f){bv[k >> 2][k & 3], bv[k >> 2][(k & 3) + 1]};
            v2f x0 = RAW2(0), x1 = RAW2(1), x2 = RAW2(2);
            unsigned pa[4], pb[4]; v2f pv = (v2f){0.f, 0.f}; LAS bf16* d0 = dst + k * XS; LAS bf16* d1 = d0 + XS;
#pragma unroll
            for (int i = 0; i < 16; ++i) { const v2f x3 = RAW2(3 + i);
                const v2f t = bb + w0 * x0 + w1 * x1 + w2 * x2 + w3 * x3;
                v2f e; e.x = __expf(-t.x); e.y = __expf(-t.y); e = e + 1.0f;
                v2f rr; rr.x = __builtin_amdgcn_rcpf(e.x); rr.y = __builtin_amdgcn_rcpf(e.y);
                const v2f v = t * rr;
                if (i & 1) { pa[(i >> 1) & 3] = pg8::cvt_pk_bf16(pv.x, v.x); pb[(i >> 1) & 3] = pg8::cvt_pk_bf16(pv.y, v.y);
                    if ((i & 7) == 7) { const int co = 8 * ((c0 + (i >> 3)) ^ swz); *(LAS v4u*)(d0 + co) = (v4u){pa[0], pa[1], pa[2], pa[3]}; *(LAS v4u*)(d1 + co) = (v4u){pb[0], pb[1], pb[2], pb[3]}; } } else pv = v;
                x0 = x1; x1 = x2; x2 = x3; }
            if (Q < 32) { const int z0 = 8 * ((c0 + 2) ^ swz), z1 = 8 * ((c0 + 3) ^ swz);
                *(LAS v4u*)(d0 + z0) = (v4u){0u, 0u, 0u, 0u}; *(LAS v4u*)(d0 + z1) = (v4u){0u, 0u, 0u, 0u}; *(LAS v4u*)(d1 + z0) = (v4u){0u, 0u, 0u, 0u}; *(LAS v4u*)(d1 + z1) = (v4u){0u, 0u, 0u, 0u}; }
            __builtin_amdgcn_sched_barrier(0); }
    } else {
        v2f xa[4], xb[4], xc[4];
#pragma unroll
        for (int kp = 0; kp < 4; ++kp) { const int k = 2 * kp; xa[kp] = RAW2(0); xb[kp] = RAW2(1); xc[kp] = RAW2(2); }
#pragma unroll
        for (int i = 0; i < 16; ++i) { unsigned o[4];
#pragma unroll
            for (int kp = 0; kp < 4; ++kp) { const int k = 2 * kp; const v2f x3 = RAW2(3 + i);
                const v2f t = (v2f){bv[k >> 2][k & 3], bv[k >> 2][(k & 3) + 1]} + CW2(0) * xa[kp] + CW2(1) * xb[kp] + CW2(2) * xc[kp] + CW2(3) * x3;
                v2f e; e.x = __expf(-t.x); e.y = __expf(-t.y); e = e + 1.0f;
                v2f rr; rr.x = __builtin_amdgcn_rcpf(e.x); rr.y = __builtin_amdgcn_rcpf(e.y);
                const v2f v = t * rr; o[kp] = pg8::cvt_pk_bf16(v.x, v.y);
                xa[kp] = xb[kp]; xb[kp] = xc[kp]; xc[kp] = x3; }
            *(LAS v4u*)(dst + i * XS) = (v4u){o[0], o[1], o[2], o[3]};
            if ((i & 3) == 3) __builtin_amdgcn_sched_barrier(0); }
    }
#undef CW2
#undef RAW2
}
template <bool SA>
__device__ __forceinline__ void ssd_conv_tile(const bf16* ZX, int row0, int g, int Q, bool hasprev, const float* cw, const float* cb, LAS bf16* XT, LAS bf16* Bd, LAS bf16* Cs,
                                              float* cso_base, int lane, int wave) {
    const int cg = lane & 31, rh = lane >> 5, wq = wave & 3, s0 = 32 * wq + 16 * rh; const bool isx = wave < 4;
    const bool active = s0 < Q && !(!isx && SA && cg >= 16);
    const int cc = isx ? 256 * g + 8 * cg : (cg < 16 ? DI + 128 * g + 8 * cg : DI + NG * NST + 128 * g + 8 * (cg - 16));
    const bf16* src = ZX + (size_t)(row0 + s0) * ZXW + DI + cc;
    float* cso = (cso_base && s0 + 16 == Q) ? cso_base : nullptr;
    if (isx) { if (active) ssd_conv_lane<false>(src, hasprev || s0 > 0, cw, cb, cc, XT + (8 * cg) * XS, s0, XT_SWZ(8 * cg), cso, Q); }
    else if (SA) { if (active) ssd_conv_lane<false>(src, hasprev || s0 > 0, cw, cb, cc, Bd + (8 * cg) * XS, s0, XT_SWZ(8 * cg), cso, Q); }
    else { if (active) ssd_conv_lane<true>(src, hasprev || s0 > 0, cw, cb, cc, (cg < 16 ? Bd + 8 * cg : Cs + 8 * (cg - 16)) + s0 * XS, s0, 0, cso, Q); }
}

__device__ __forceinline__ void ssd_phase_a(unsigned char* ws, float* out, LAS unsigned char* lds, int j, int tid, int lane, int wave) {
    const bf16* ZX = (const bf16*)(ws + WS_ZX); const float* DT = (const float*)(ws + WS_DT); bf16* YN = (bf16*)(ws + WS_YN);
    bf16* CST = (bf16*)(ws + WS_SCR + SC_CST); float* DEC = (float*)(ws + WS_SCR + SC_DEC);
    const float* cw = arg_in(I_SCW) + (size_t)j * 4 * CONVD; const float* cb = arg_in(I_SCB) + (size_t)j * CONVD;
    const float* dtbias = arg_in(I_SDTB) + j * NH; const float* alog = arg_in(I_SALOG) + j * NH; const float* dsk = arg_in(I_SD) + j * NH;
    LAS bf16* XWT = (LAS bf16*)lds;
    LAS bf16* BT = XWT + 256 * XS;
    LAS float* DTL = (LAS float*)(BT + 128 * XS);
    LAS float* CSL = DTL + 512;
    LAS float* WL = CSL + 512;
    const int tid0 = tid;
    const int n_all = N_CITEMS + NS * NG, n_ext = (SUBREP & 4) ? n_all + NS * NG : (SUBREP & 32) ? n_all + 1024 : n_all;
    for (int item_ = blockIdx.x; item_ < n_ext; item_ += gridDim.x) {
        const int item = item_ < n_all ? item_ : (SUBREP & 32) ? item_ - n_all : item_ - NS * NG;
        int tid = tid0; asm volatile("" : "+v"(tid));
        const int lane = tid & 63, fr = lane & 15, fq = lane >> 4;
        __syncthreads();
        if (item < N_CITEMS) {
            const SsdItem it = ssd_item(item); const int Q = it.Q;
            ssd_conv_tile<true>(ZX, it.row0, it.g, Q, it.c > 0, cw, cb, XWT, BT, nullptr, nullptr, lane, wave);
            if (SUBREP & 1) { asm volatile("" ::: "memory"); ssd_conv_tile<true>(ZX, it.row0, it.g, Q, it.c > 0, cw, cb, XWT, BT, nullptr, nullptr, lane, wave); }
            if (wave >= 4) { const int hh = wave - 4, h = 4 * it.g + hh;
                const float tot = ssd_dt_cs(DT, it.row0, Q, h, dtbias[h], -__expf(alog[h]), DTL + hh * 128, CSL + hh * 128, lane);
                LDS_WAIT();
                WL[hh * 128 + lane] = DTL[hh * 128 + lane] * __expf(tot - CSL[hh * 128 + lane]);
                WL[hh * 128 + lane + 64] = DTL[hh * 128 + lane + 64] * __expf(tot - CSL[hh * 128 + lane + 64]);
                if (lane == 0) DEC[(it.b * NCH + it.c) * NH + h] = __expf(tot); }
            __syncthreads();
            for (int rep_ = 0; rep_ < ((SUBREP & 2) ? 2 : 1); ++rep_) { asm volatile("" ::: "memory");
            pg8::f32x4 acc[2][8];
#pragma unroll
            for (int mi = 0; mi < 2; ++mi)
#pragma unroll
                for (int ni = 0; ni < 8; ++ni) acc[mi][ni] = (pg8::f32x4){0.f, 0.f, 0.f, 0.f};
            const int nkb = Q < 32 ? 1 : Q / 32;
            for (int kb = 0; kb < nkb; ++kb) {
                bf16x8 a[2], bq[8];
#pragma unroll
                for (int mi = 0; mi < 2; ++mi) a[mi] = *(const LAS bf16x8*)(XWT + (32 * wave + 16 * mi + fr) * XS + 8 * ((4 * kb + fq) ^ XT_SWZ(32 * wave + 16 * mi)));
                { const LAS float* wlp = WL + (wave >> 1) * 128 + 32 * kb + 8 * fq;
                  const v4f wa = *(const LAS v4f*)wlp, wb = *(const LAS v4f*)(wlp + 4);
#pragma unroll
                  for (int mi = 0; mi < 2; ++mi) { const v4u xa = __builtin_bit_cast(v4u, a[mi]);
                      a[mi] = __builtin_bit_cast(bf16x8, (v4u){pg8::cvt_pk_bf16(bflo(xa.x) * wa.x, bfhi(xa.x) * wa.y), pg8::cvt_pk_bf16(bflo(xa.y) * wa.z, bfhi(xa.y) * wa.w),
                                                               pg8::cvt_pk_bf16(bflo(xa.z) * wb.x, bfhi(xa.z) * wb.y), pg8::cvt_pk_bf16(bflo(xa.w) * wb.z, bfhi(xa.w) * wb.w)}); } }
#pragma unroll
                for (int ni = 0; ni < 8; ++ni) bq[ni] = *(const LAS bf16x8*)(BT + (16 * ni + fr) * XS + 8 * ((4 * kb + fq) ^ XT_SWZ(16 * ni)));
#pragma unroll
                for (int mi = 0; mi < 2; ++mi)
#pragma unroll
                    for (int ni = 0; ni < 8; ++ni) acc[mi][ni] = __builtin_amdgcn_mfma_f32_16x16x32_bf16(bq[ni], a[mi], acc[mi][ni], 0, 0, 0);
            }
            { LAS bf16* stg = XWT + (32 * wave) * XS;
#pragma unroll
              for (int mi = 0; mi < 2; ++mi)
#pragma unroll
                for (int ni = 0; ni < 8; ++ni) *(LAS v2u*)(stg + (16 * mi + fr) * XS + 16 * ni + 4 * fq) = (v2u){pg8::cvt_pk_bf16(acc[mi][ni][0], acc[mi][ni][1]), pg8::cvt_pk_bf16(acc[mi][ni][2], acc[mi][ni][3])};
              const int hp0 = 32 * wave, h = 4 * it.g + (hp0 >> 6), p0 = hp0 & 63;
              bf16* dstb = CST + ((((size_t)(it.b * NCH + it.c) * NH + h) * HD + p0) * NST);
#pragma unroll
              for (int i = 0; i < 8; ++i) { const int rr = 4 * i + (lane >> 4), c16 = lane & 15;
                  *(GAS v4u*)(dstb + rr * NST + 8 * c16) = *(const LAS v4u*)(stg + rr * XS + 8 * c16); } }
            }
        } else {
            const int si = (item - N_CITEMS) / NG, g = (item - N_CITEMS) % NG, row = TP + si;
            LAS float* xs = (LAS float*)lds; LAS float* Bsm = xs + 256; LAS float* Csm = Bsm + 128; LAS float* dtv = Csm + 128; LAS float* dAv = dtv + 4; LAS float* yv = dAv + 4;
            { const int cc = tid < 256 ? 256 * g + tid : (tid < 384 ? DI + 128 * g + (tid - 256) : DI + NG * NST + 128 * g + (tid - 384));
              const float* sp = arg_in(I_SSC) + (((size_t)j * NS + si) * 3) * CONVD + cc;
              const float s0 = sp[0], s1 = sp[CONVD], s2 = sp[2 * CONVD], x3 = bf2f(ZX[(size_t)row * ZXW + DI + cc]);
              const float v = silu_f(cb[cc] + cw[cc] * s0 + cw[CONVD + cc] * s1 + cw[2 * CONVD + cc] * s2 + cw[3 * CONVD + cc] * x3);
              xs[tid] = v;
              float* op = out + O_SSC + (((size_t)j * NS + si) * 3) * CONVD + cc; op[0] = s1; op[CONVD] = s2; op[2 * CONVD] = x3; }
            if (tid < 4) { const int h = 4 * g + tid; const float d = softplus_f(DT[(size_t)row * 32 + h] + dtbias[h]); dtv[tid] = d; dAv[tid] = __expf(-d * __expf(alog[h])); }
            __syncthreads();
            v2u zz_ = (v2u){0u, 0u}; if (wave == 0) zz_ = *(const GAS v2u*)(ZX + (size_t)row * ZXW + 256 * g + 4 * lane);
            { const int r = wave >> 1, h = 4 * g + r; const float d = dtv[r], dA = dAv[r], Dh = dsk[h];
              const v2f Bv = *(const LAS v2f*)(Bsm + 2 * lane), Cv = *(const LAS v2f*)(Csm + 2 * lane);
              const float* h0 = arg_in(I_SSH) + ((((size_t)j * NS + si) * NH + h) * HD + 32 * (wave & 1)) * NST; float* ho = out + O_SSH + ((((size_t)j * NS + si) * NH + h) * HD + 32 * (wave & 1)) * NST;
              LAS float* PR = (LAS float*)(lds + 8192) + wave * (32 * 65);
              v2f hv[32];
#pragma unroll
              for (int pp = 0; pp < 32; ++pp) hv[pp] = *(const GAS v2f*)(h0 + (size_t)pp * NST + 2 * lane);
#pragma unroll
              for (int pp = 0; pp < 32; ++pp) { const float xdt = xs[64 * r + 32 * (wave & 1) + pp] * d;
                  hv[pp].x = fmaf(hv[pp].x, dA, xdt * Bv.x); hv[pp].y = fmaf(hv[pp].y, dA, xdt * Bv.y);
                  *(GAS v2f*)(ho + (size_t)pp * NST + 2 * lane) = hv[pp];
                  PR[pp * 65 + lane] = Cv.x * hv[pp].x + Cv.y * hv[pp].y; }
              LDS_WAIT();
              if (lane < 32) { float y = 0.f;
#pragma unroll 16
                  for (int k = 0; k < 64; ++k) y += PR[lane * 65 + k];
                  const int p = 32 * (wave & 1) + lane; yv[64 * r + p] = y + Dh * xs[64 * r + p]; } }
            __syncthreads();
            if (wave == 0) { const int c0 = 256 * g + 4 * lane; const v2u zz = zz_;
                const v4f y = *(const LAS v4f*)(yv + 4 * lane);
                const float v0 = y.x * silu_f(bflo(zz.x)), v1 = y.y * silu_f(bfhi(zz.x)), v2 = y.z * silu_f(bflo(zz.y)), v3 = y.w * silu_f(bfhi(zz.y));
                const float rs = rsqrtf(wave_sum(v0 * v0 + v1 * v1 + v2 * v2 + v3 * v3) * (1.f / 256.f) + EPS);
                *(GAS v2u*)(YN + (size_t)row * DI + c0) = (v2u){pk2(v0 * rs, v1 * rs), pk2(v2 * rs, v3 * rs)}; }
        }
    }
}

__device__ __forceinline__ void ssd_phase_b(unsigned char* ws, float* out, int j, int tid) {
    const bf16* CST = (const bf16*)(ws + WS_SCR + SC_CST); const float* DEC = (const float*)(ws + WS_SCR + SC_DEC); bf16* HPREV = (bf16*)(ws + WS_SCR + SC_HPREV);
    constexpr int PER_B = NH * HD * NST / 8;
    for (int idx = blockIdx.x * NTHR + tid; idx < NB * PER_B; idx += gridDim.x * NTHR) {
        const int b = idx / PER_B, e = (idx % PER_B) * 8, h = e / (HD * NST);
        v4f H0 = (v4f){0.f, 0.f, 0.f, 0.f}, H1 = H0;
#pragma unroll 4
        for (int c = 0; c < NCH; ++c) {
            const size_t off = (size_t)(b * NCH + c) * (NH * HD * NST) + e;
            if (c > 0) *(GAS v4u*)(HPREV + off) = (v4u){pk2(H0.x, H0.y), pk2(H0.z, H0.w), pk2(H1.x, H1.y), pk2(H1.z, H1.w)};
            const float dec = DEC[(b * NCH + c) * NH + h];
            const v4u sw = *(const GAS v4u*)(CST + off); const v4f s0 = (v4f){bflo(sw.x), bfhi(sw.x), bflo(sw.y), bfhi(sw.y)}, s1 = (v4f){bflo(sw.z), bfhi(sw.z), bflo(sw.w), bfhi(sw.w)};
            H0 = H0 * dec + s0; H1 = H1 * dec + s1;
        }
        float* op = out + O_PSH + ((size_t)j * NB + b) * (NH * HD * NST) + e;
        *(GAS v4f*)op = H0; *(GAS v4f*)(op + 4) = H1;
    }
}

__device__ __forceinline__ void ssd_phase_c(unsigned char* ws, float* out, LAS unsigned char* lds, int j, int tid0, int, int wave) {
    const bf16* ZX = (const bf16*)(ws + WS_ZX); const float* DT = (const float*)(ws + WS_DT); bf16* YN = (bf16*)(ws + WS_YN);
    const bf16* HPREV = (const bf16*)(ws + WS_SCR + SC_HPREV);
    const float* cw = arg_in(I_SCW) + (size_t)j * 4 * CONVD; const float* cb = arg_in(I_SCB) + (size_t)j * CONVD;
    const float* dtbias = arg_in(I_SDTB) + j * NH; const float* alog = arg_in(I_SALOG) + j * NH; const float* dsk = arg_in(I_SD) + j * NH;
    LAS bf16* XT = (LAS bf16*)lds;
    LAS bf16* Bs = XT + 256 * XS;
    LAS bf16* Cs = Bs + 128 * XS;
    LAS float* DTL = (LAS float*)(Cs + 128 * XS);
    LAS float* CSL = DTL + 512;
    for (int item = blockIdx.x; item < N_CITEMS; item += gridDim.x) {
        const SsdItem it = ssd_item(item); const int Q = it.Q;
        int tid = tid0; asm volatile("" : "+v"(tid));
        const int lane = tid & 63, fr = lane & 15, fq = lane >> 4;
        __syncthreads();
        if (wave < 4) { const int h = 4 * it.g + wave; (void)ssd_dt_cs(DT, it.row0, Q, h, dtbias[h], -__expf(alog[h]), DTL + wave * 128, CSL + wave * 128, lane); }
        { float* cso = (it.c == NCH - 1) ? out + O_PSC + (((size_t)j * NB + it.b) * 3) * CONVD : nullptr;
          ssd_conv_tile<false>(ZX, it.row0, it.g, Q, it.c > 0, cw, cb, XT, Bs, Cs, cso, lane, wave);
          if (SUBREP & 8) { asm volatile("" ::: "memory"); ssd_conv_tile<false>(ZX, it.row0, it.g, Q, it.c > 0, cw, cb, XT, Bs, Cs, cso, lane, wave); } }
        __syncthreads();
        const int l0 = 16 * wave, nlt = Q / 16;
        pg8::f32x4 ST[8];
        if (l0 < Q) {
            bf16x8 cf[4];
#pragma unroll
            for (int kb = 0; kb < 4; ++kb) cf[kb] = *(const LAS bf16x8*)(Cs + (l0 + fr) * XS + 32 * kb + 8 * fq);
#pragma unroll
            for (int t = 0; t < 8; ++t) { ST[t] = (pg8::f32x4){0.f, 0.f, 0.f, 0.f};
                if (t <= wave) {
#pragma unroll
                    for (int kb = 0; kb < 4; ++kb) { const bf16x8 bfrag = *(const LAS bf16x8*)(Bs + (16 * t + fr) * XS + 32 * kb + 8 * fq);
                        ST[t] = __builtin_amdgcn_mfma_f32_16x16x32_bf16(bfrag, cf[kb], ST[t], 0, 0, 0); } } }
        }
        __syncthreads();
        LAS bf16* CBL = Bs;
        if (l0 < Q) {
#pragma unroll
            for (int t = 0; t < 8; ++t) if (t <= wave) *(LAS v2u*)(CBL + (l0 + fr) * XS + 16 * t + 4 * fq) = (v2u){pk2(ST[t][0], ST[t][1]), pk2(ST[t][2], ST[t][3])};
        }
        const int r = wave >> 1, ph = wave & 1, h = 4 * it.g + r, hp0 = 64 * r + 32 * ph;
        const bool hasprev = it.c > 0;
        bf16x8 hf[2][4];
        if (hasprev) { const bf16* hpb = HPREV + ((((size_t)(it.b * NCH + it.c) * NH + h) * HD) + 32 * ph + fr) * NST + 8 * fq;
#pragma unroll
            for (int pt = 0; pt < 2; ++pt)
#pragma unroll
                for (int kb = 0; kb < 4; ++kb) hf[pt][kb] = *(const GAS bf16x8*)(hpb + (size_t)(16 * pt) * NST + 32 * kb); }
        __syncthreads();
        const LAS float* csr = CSL + r * 128; const LAS float* dtr = DTL + r * 128; const float Dh = dsk[h];
        float csl[8];
#pragma unroll
        for (int u = 0; u < 8; ++u) csl[u] = csr[(16 * u + fr) & 127];
        pg8::f32x4 ay[2][8];
#pragma unroll
        for (int u = 0; u < 8; ++u) { ay[0][u] = (pg8::f32x4){0.f, 0.f, 0.f, 0.f}; ay[1][u] = ay[0][u]; }
        const int zl = lane >> 2, zck = lane & 3;
        const bf16* zb = ZX + (size_t)(it.row0 + zl) * ZXW + 256 * it.g + hp0 + 8 * zck;
        LAS unsigned char* stg = (LAS unsigned char*)(XT + hp0 * XS);
        const int stg_lin = zl * 64 + 16 * (zck ^ ((zl >> 2) & 3));
        const int stg_acc = fr * 64 + 8 * (fq & 1);
        const int stg_x = (fr >> 2) & 3, stg_c = fq >> 1;
#pragma unroll
        for (int kb = 0; kb < 4; ++kb) if (32 * kb < Q) {
            bf16x8 xf[2];
#pragma unroll
            for (int pt = 0; pt < 2; ++pt) xf[pt] = *(const LAS bf16x8*)(XT + (hp0 + 16 * pt + fr) * XS + 8 * ((4 * kb + fq) ^ XT_SWZ(hp0 + 16 * pt)));
            const v4f c0 = *(const LAS v4f*)(csr + 32 * kb + 8 * fq), c1 = *(const LAS v4f*)(csr + 32 * kb + 8 * fq + 4);
            const v4f d0 = *(const LAS v4f*)(dtr + 32 * kb + 8 * fq), d1 = *(const LAS v4f*)(dtr + 32 * kb + 8 * fq + 4);
            const float csv[8] = {c0.x, c0.y, c0.z, c0.w, c1.x, c1.y, c1.z, c1.w}, dtv[8] = {d0.x, d0.y, d0.z, d0.w, d1.x, d1.y, d1.z, d1.w};
#pragma unroll
            for (int u = 2 * kb; u < 8; ++u) if (u < nlt) {
                const v4u raw = *(const LAS v4u*)(CBL + (16 * u + fr) * XS + 32 * kb + 8 * fq);
                const float cbv[8] = {bflo(raw.x), bfhi(raw.x), bflo(raw.y), bfhi(raw.y), bflo(raw.z), bfhi(raw.z), bflo(raw.w), bfhi(raw.w)};
                const int lrow = 16 * u + fr; float e[8];
#pragma unroll
                for (int jj = 0; jj < 8; ++jj) { const int sidx = 32 * kb + 8 * fq + jj; e[jj] = (sidx <= lrow && sidx < Q) ? cbv[jj] * __expf(csl[u] - csv[jj]) * dtv[jj] : 0.f;
                    if (sidx == lrow) e[jj] += Dh; }
                const bf16x8 sf = __builtin_bit_cast(bf16x8, (v4u){pk2(e[0], e[1]), pk2(e[2], e[3]), pk2(e[4], e[5]), pk2(e[6], e[7])});
#pragma unroll
                for (int pt = 0; pt < 2; ++pt) ay[pt][u] = __builtin_amdgcn_mfma_f32_16x16x32_bf16(xf[pt], sf, ay[pt][u], 0, 0, 0);
            }
            __builtin_amdgcn_sched_barrier(0);
        }
        if (hasprev) {
#pragma unroll
            for (int u = 0; u < 8; ++u) { const float ecs = __expf(csl[u]); pg8::f32x4 ao0 = (pg8::f32x4){0.f, 0.f, 0.f, 0.f}, ao1 = ao0;
#pragma unroll
                for (int kb = 0; kb < 4; ++kb) { const bf16x8 cfr = *(const LAS bf16x8*)(Cs + (16 * u + fr) * XS + 32 * kb + 8 * fq);
                    ao0 = __builtin_amdgcn_mfma_f32_16x16x32_bf16(hf[0][kb], cfr, ao0, 0, 0, 0); ao1 = __builtin_amdgcn_mfma_f32_16x16x32_bf16(hf[1][kb], cfr, ao1, 0, 0, 0); }
                ay[0][u] = ay[0][u] + ao0 * ecs; ay[1][u] = ay[1][u] + ao1 * ecs; } }
        __builtin_amdgcn_sched_barrier(0);
        v2u zz[2][8];
        { v4u zr[8];
#pragma unroll
          for (int i = 0; i < 8; ++i) zr[i] = *(const GAS v4u*)(zb + (size_t)(16 * (i < nlt ? i : 0)) * ZXW);
#pragma unroll
          for (int i = 0; i < 8; ++i) *(LAS v4u*)(stg + 1024 * i + stg_lin) = zr[i]; }
#pragma unroll
        for (int u = 0; u < 8; ++u)
#pragma unroll
            for (int pt = 0; pt < 2; ++pt) zz[pt][u] = *(const LAS v2u*)(stg + 1024 * u + stg_acc + 16 * ((2 * pt + stg_c) ^ stg_x));
        float ssq[8];
#pragma unroll
        for (int u = 0; u < 8; ++u) { ssq[u] = 0.f; if (u < nlt) {
#pragma unroll
            for (int pt = 0; pt < 2; ++pt) { const v2u zw = zz[pt][u]; const float zf[4] = {bflo(zw.x), bfhi(zw.x), bflo(zw.y), bfhi(zw.y)};
#pragma unroll
                for (int q = 0; q < 4; ++q) { const float y = ay[pt][u][q] * silu_f(zf[q]); ay[pt][u][q] = y; ssq[u] += y * y; } }
            ssq[u] += xor16_f(ssq[u], lane); ssq[u] += xor32_f(ssq[u], lane); } }
        LAS float* SSQ = CSL + 512;
        if (fq == 0) {
#pragma unroll
            for (int u = 0; u < 8; ++u) if (u < nlt) SSQ[wave * 128 + 16 * u + fr] = ssq[u]; }
        __syncthreads();
        {
#pragma unroll
            for (int u = 0; u < 8; ++u) if (u < nlt) { float tsum = SSQ[(2 * fq) * 128 + 16 * u + fr] + SSQ[(2 * fq + 1) * 128 + 16 * u + fr];
                tsum += xor16_f(tsum, lane); tsum += xor32_f(tsum, lane);
                const float rs = rsqrtf(tsum * (1.f / 256.f) + EPS);
#pragma unroll
                for (int pt = 0; pt < 2; ++pt) *(LAS v2u*)(stg + 1024 * u + stg_acc + 16 * ((2 * pt + stg_c) ^ stg_x)) = (v2u){pk2(ay[pt][u][0] * rs, ay[pt][u][1] * rs), pk2(ay[pt][u][2] * rs, ay[pt][u][3] * rs)}; }
            bf16* yb = YN + (size_t)(it.row0 + zl) * DI + 256 * it.g + hp0 + 8 * zck;
#pragma unroll
            for (int i = 0; i < 8; ++i) if (i < nlt) *(GAS v4u*)(yb + (size_t)(16 * i) * DI) = *(const LAS v4u*)(stg + 1024 * i + stg_lin); }
    }
}


constexpr size_t SC_LSUM = 0;
constexpr size_t SC_LSUB = SC_LSUM + (size_t)NB * NCH * DR * 2 * 4;
constexpr size_t SC_LAB = SC_LSUB + (size_t)NB * NCH * 8 * DR * 2 * 4;
template <bool FINAL>
__device__ __forceinline__ void lru_phase(unsigned char* ws, float* out, LAS unsigned char* lds, int j, int tid0, int, int wave) {
    const bf16* G = (const bf16*)(ws + WS_ZX); const bf16* XRAW = G + (size_t)T * DR; bf16* YL = (bf16*)(ws + WS_YN);
    const bf16* WAX = (const bf16*)(ws + WS_W) + WE_LRU0 + (size_t)j * WE_LEND + WE_LAX;
    float* LSUM = (float*)(ws + WS_SCR + SC_LSUM); float* LSUB = (float*)(ws + WS_SCR + SC_LSUB); unsigned* LAB = (unsigned*)(ws + WS_SCR + SC_LAB); const float* LCF = (const float*)(ws + WS_LCF) + (size_t)j * DR;
    const float* cw = arg_in(I_LCW) + (size_t)j * 4 * DR; const float* cb = arg_in(I_LCB) + (size_t)j * DR;
    const float* ba = arg_in(I_LBA) + (size_t)j * DR; const float* bx = arg_in(I_LBX) + (size_t)j * DR;
    LAS bf16* WL = (LAS bf16*)lds;
    LAS bf16* XR = WL + 256 * XS;
    LAS bf16* GL = XR + 128 * XS;
    LAS float* WSUM = (LAS float*)(GL + 128 * XS);
    LAS float* CHC = WSUM + 8 * 128 * 2;
    const int nitems = FINAL ? N_CITEMS + 8 : N_CITEMS;
    int kb_staged = -1;
    bool srep_ = false;
    for (int item = blockIdx.x; item < nitems; item += gridDim.x) {
        int tid = tid0; asm volatile("" : "+v"(tid));
        const int lane = tid & 63, fr = lane & 15, fq = lane >> 4;
        const bool samp = item >= N_CITEMS;
        int b = 0, c = -1, kb, Q = 128, row0 = TP;
        if (!samp) { const SsdItem it = ssd_item(item); kb = it.g; c = it.c; b = it.b; Q = it.Q; row0 = it.row0; }
        else kb = item - N_CITEMS;
        if (FINAL && !samp) {
            const int c4 = tid & 31, rg = tid >> 5, nrg = Q / 8, r0 = 8 * rg, dg4 = kb * 128 + 4 * c4;
            LAS float* QS = (LAS float*)lds;
            LAS float* HINL = QS + 16 * 128 * 2;
            __syncthreads();
            v4u ab[8]; v2u gq[8];
            v2f cs_[NCH - 1];
            if (tid < 128) { const int dg = kb * 128 + tid;
#pragma unroll
                for (int cp = 0; cp < NCH - 1; ++cp) { const v2f t = *(const GAS v2f*)(LSUM + ((size_t)(b * NCH + (cp < c ? cp : 0)) * DR + dg) * 2); const float mk = cp < c ? 1.f : 0.f;
                    cs_[cp].x = 1.f + mk * (t.x - 1.f); cs_[cp].y = mk * t.y; } }
            { const int rr = rg < nrg ? r0 : 0;
              const unsigned* labp = LAB + (size_t)(row0 + rr) * DR + dg4; const bf16* gp = G + (size_t)(row0 + rr) * DR + dg4;
#pragma unroll
              for (int i = 0; i < 8; ++i) { ab[i] = *(const GAS v4u*)(labp + (size_t)i * DR); gq[i] = *(const GAS v2u*)(gp + (size_t)i * DR); } }
            if (tid < 128) { float h = 0.f;
#pragma unroll
                for (int cp = 0; cp < NCH - 1; ++cp) h = cs_[cp].x * h + cs_[cp].y;
                HINL[tid] = h; }
            float av[8][4]; v4f A4 = (v4f){1.f, 1.f, 1.f, 1.f}, H4 = (v4f){0.f, 0.f, 0.f, 0.f};
#pragma unroll
            for (int i = 0; i < 8; ++i) { const v4u w = ab[i];
                av[i][0] = __expf(bflo(w.x)); av[i][1] = __expf(bflo(w.y)); av[i][2] = __expf(bflo(w.z)); av[i][3] = __expf(bflo(w.w));
                const v4f a4 = (v4f){av[i][0], av[i][1], av[i][2], av[i][3]}, b4 = (v4f){bfhi(w.x), bfhi(w.y), bfhi(w.z), bfhi(w.w)};
                H4 = a4 * H4 + b4; A4 = A4 * a4; }
            if (rg < nrg) { *(LAS v4f*)(QS + (rg * 128 + 4 * c4) * 2) = (v4f){A4.x, H4.x, A4.y, H4.y}; *(LAS v4f*)(QS + (rg * 128 + 4 * c4) * 2 + 4) = (v4f){A4.z, H4.z, A4.w, H4.w}; }
            __syncthreads();
            if (rg < nrg) {
                v4f h4 = *(const LAS v4f*)(HINL + 4 * c4);
                for (int qq = 0; qq < rg; ++qq) { const v4f s0 = *(const LAS v4f*)(QS + (qq * 128 + 4 * c4) * 2), s1 = *(const LAS v4f*)(QS + (qq * 128 + 4 * c4) * 2 + 4);
                    h4 = (v4f){s0.x * h4.x + s0.y, s0.z * h4.y + s0.w, s1.x * h4.z + s1.y, s1.z * h4.w + s1.w}; }
                bf16* yp = YL + (size_t)(row0 + r0) * DR + dg4;
#pragma unroll
                for (int i = 0; i < 8; ++i) { const v4u w = ab[i]; const v4f a4 = (v4f){av[i][0], av[i][1], av[i][2], av[i][3]}, b4 = (v4f){bfhi(w.x), bfhi(w.y), bfhi(w.z), bfhi(w.w)};
                    h4 = a4 * h4 + b4;
                    const v4f g4 = (v4f){bflo(gq[i].x), bfhi(gq[i].x), bflo(gq[i].y), bfhi(gq[i].y)}, y4 = h4 * g4;
                    *(GAS v2u*)(yp + (size_t)i * DR) = (v2u){pk2(y4.x, y4.y), pk2(y4.z, y4.w)}; }
                if (c == NCH - 1 && rg == nrg - 1) *(GAS v4f*)(out + O_PLH + ((size_t)j * NB + b) * DR + dg4) = h4;
            }
            continue;
        }
        __syncthreads();
        if (kb != kb_staged) { const GAS v4u* src = (const GAS v4u*)(WAX + (size_t)kb * 256 * 128); v4u wv[8];
#pragma unroll
          for (int i = 0; i < 8; ++i) wv[i] = src[tid + NTHR * i];
#pragma unroll
          for (int i = 0; i < 8; ++i) { const int e = tid + NTHR * i; *(LAS v4u*)(WL + (e >> 4) * XS + 8 * (e & 15)) = wv[i]; }
          if (tid < 128) { CHC[tid] = LCF[kb * 128 + tid]; CHC[128 + tid] = ba[kb * 128 + tid]; CHC[256 + tid] = bx[kb * 128 + tid]; }
          kb_staged = kb; }
        v2f cs_[NCH - 1], ws_[7];
        const bool do_hin = FINAL && !samp && tid < 128;
        if (do_hin) {
#pragma unroll
            for (int cp = 0; cp < NCH - 1; ++cp) cs_[cp] = cp < c ? *(const GAS v2f*)(LSUM + ((size_t)(b * NCH + cp) * DR + kb * 128 + tid) * 2) : (v2f){1.f, 0.f};
#pragma unroll
            for (int ww = 0; ww < 7; ++ww) ws_[ww] = *(const GAS v2f*)(LSUB + (((size_t)(b * NCH + c) * 8 + ww) * DR + kb * 128 + tid) * 2); }
        v4u gv[4];
        if (FINAL) {
#pragma unroll
            for (int i = 0; i < 4; ++i) { const int e = tid + NTHR * i; if (e < Q * 16) gv[i] = *(const GAS v4u*)(G + (size_t)(row0 + (e >> 4)) * DR + kb * 128 + 8 * (e & 15)); } }
        for (int rp_ = 0; rp_ < ((!FINAL && (SUBREP & 64)) ? 2 : 1); ++rp_) { asm volatile("" ::: "memory");
        if (!samp) {
            const int c8 = tid & 15, rg = tid >> 4, s0 = 4 * rg, cc = kb * 128 + 8 * c8;
            if (s0 < Q) {
                const bf16* src = XRAW + (size_t)(row0 + s0) * DR + cc; const int tfirst = row0 - b * LP + s0;
                v4u raw[7];
#pragma unroll
                for (int i = 0; i < 3; ++i) { const bool ok = tfirst >= 3 - i; const v4u t = *(const GAS v4u*)(src + (ptrdiff_t)(ok ? i - 3 : 0) * DR); raw[i] = ok ? t : (v4u){0u, 0u, 0u, 0u}; }
#pragma unroll
                for (int i = 0; i < 4; ++i) raw[3 + i] = *(const GAS v4u*)(src + (size_t)i * DR);
                v4f wv[4][2], bv[2];
#pragma unroll
                for (int t = 0; t < 4; ++t) { wv[t][0] = *(const GAS v4f*)(cw + (size_t)t * DR + cc); wv[t][1] = *(const GAS v4f*)(cw + (size_t)t * DR + cc + 4); }
                bv[0] = *(const GAS v4f*)(cb + cc); bv[1] = *(const GAS v4f*)(cb + cc + 4);
                if (!FINAL && c == NCH - 1 && s0 + 4 == Q) { float* cso = out + O_PLC + (((size_t)j * NB + b) * 3) * DR + cc;
#pragma unroll
                    for (int i = 0; i < 3; ++i) { const v4u w = raw[4 + i]; float* o = cso + (size_t)i * DR;
                        *(GAS v4f*)o = (v4f){bflo(w.x), bfhi(w.x), bflo(w.y), bfhi(w.y)}; *(GAS v4f*)(o + 4) = (v4f){bflo(w.z), bfhi(w.z), bflo(w.w), bfhi(w.w)}; } }
                unsigned ow[4][4];
#pragma unroll
                for (int kp = 0; kp < 4; ++kp) { const int k = 2 * kp;
                    const v2f w0 = (v2f){wv[0][k >> 2][k & 3], wv[0][k >> 2][(k & 3) + 1]}, w1 = (v2f){wv[1][k >> 2][k & 3], wv[1][k >> 2][(k & 3) + 1]},
                              w2 = (v2f){wv[2][k >> 2][k & 3], wv[2][k >> 2][(k & 3) + 1]}, w3 = (v2f){wv[3][k >> 2][k & 3], wv[3][k >> 2][(k & 3) + 1]}, bb = (v2f){bv[k >> 2][k & 3], bv[k >> 2][(k & 3) + 1]};
#define RAW2(i) ((v2f){bf_elem(raw[i], k), bf_elem(raw[i], k + 1)})
                    v2f x0 = RAW2(0), x1 = RAW2(1), x2 = RAW2(2);
#pragma unroll
                    for (int i = 0; i < 4; ++i) { const v2f x3 = RAW2(3 + i); const v2f t = bb + w0 * x0 + w1 * x1 + w2 * x2 + w3 * x3; ow[i][kp] = pk2(t.x, t.y); x0 = x1; x1 = x2; x2 = x3; }
#undef RAW2
                }
#pragma unroll
                for (int i = 0; i < 4; ++i) *(LAS v4u*)(XR + (s0 + i) * XS + 8 * c8) = (v4u){ow[i][0], ow[i][1], ow[i][2], ow[i][3]};
            }
        } else {
            const int ch = tid & 127, sub = tid >> 7, cc = kb * 128 + ch, nr = Q / 4, s0 = sub * nr;
            const float w0 = cw[cc], w1 = cw[DR + cc], w2 = cw[2 * DR + cc], w3 = cw[3 * DR + cc], bias = cb[cc];
            {
                const float* spb = arg_in(I_SLC) + ((size_t)j * NS * 3) * DR + cc; float* opb = out + O_SLC + ((size_t)j * NS * 3) * DR + cc;
#pragma unroll 8
                for (int s = s0; s < s0 + nr; ++s) { const float* sp = spb + (size_t)s * 3 * DR;
                    const float q0 = sp[0], q1 = sp[DR], q2 = sp[2 * DR], x3 = bf2f(XRAW[(size_t)(TP + s) * DR + cc]);
                    XR[s * XS + ch] = (bf16)f2bf(bias + w0 * q0 + w1 * q1 + w2 * q2 + w3 * x3);
                    float* op = opb + (size_t)s * 3 * DR; op[0] = q1; op[DR] = q2; op[2 * DR] = x3; }
            }
        }
        }
        if (FINAL) {
#pragma unroll
            for (int i = 0; i < 4; ++i) { const int e = tid + NTHR * i; if (e < Q * 16) *(LAS v4u*)(GL + (e >> 4) * XS + 8 * (e & 15)) = gv[i]; } }
        if (do_hin) { float h = 0.f;
#pragma unroll
            for (int cp = 0; cp < NCH - 1; ++cp) h = cs_[cp].x * h + cs_[cp].y;
            WSUM[tid] = h;
#pragma unroll
            for (int ww = 0; ww < 7; ++ww) { h = ws_[ww].x * h + ws_[ww].y; WSUM[(ww + 1) * 128 + tid] = h; } }
        __syncthreads();
        const bool act = 16 * wave < Q; const int l0 = 16 * wave;
        if (act) {
            pg8::f32x4 acc[16];
            for (int rm_ = 0; rm_ < ((SUBREP & 128) ? 2 : 1); ++rm_) { asm volatile("" ::: "memory");
#pragma unroll
            for (int nt = 0; nt < 16; ++nt) acc[nt] = (pg8::f32x4){0.f, 0.f, 0.f, 0.f};
#pragma unroll
            for (int kk = 0; kk < 4; ++kk) { const bf16x8 af = *(const LAS bf16x8*)(XR + (l0 + fr) * XS + 32 * kk + 8 * fq);
#pragma unroll
                for (int nt = 0; nt < 16; ++nt) { const bf16x8 wf = *(const LAS bf16x8*)(WL + (16 * nt + fr) * XS + 32 * kk + 8 * fq);
                    acc[nt] = __builtin_amdgcn_mfma_f32_16x16x32_bf16(af, wf, acc[nt], 0, 0, 0); }
                __builtin_amdgcn_sched_barrier(0); }
            }
            if (samp) {
                if (FINAL) { const float* h0p = arg_in(I_SLH) + (size_t)j * NS * DR; float* hop = out + O_SLH + (size_t)j * NS * DR;
#pragma unroll 1
                    for (int nt = 0; nt < 8; ++nt) { const int d = 16 * nt + fr, dg = kb * 128 + d; const float cfac = CHC[d], bav = CHC[128 + d], bxv = CHC[256 + d];
                        const pg8::f32x4 ga = nt == 0 ? acc[0] : nt == 1 ? acc[1] : nt == 2 ? acc[2] : nt == 3 ? acc[3] : nt == 4 ? acc[4] : nt == 5 ? acc[5] : nt == 6 ? acc[6] : acc[7];
                        const pg8::f32x4 gx = nt == 0 ? acc[8] : nt == 1 ? acc[9] : nt == 2 ? acc[10] : nt == 3 ? acc[11] : nt == 4 ? acc[12] : nt == 5 ? acc[13] : nt == 6 ? acc[14] : acc[15];
#pragma unroll
                        for (int q = 0; q < 4; ++q) { const int l = l0 + 4 * fq + q;
                            const float rg = sigmoid_f(ga[q] + bav), ig = sigmoid_f(gx[q] + bxv), la = -cfac * rg, av = __expf(la), mult = __builtin_amdgcn_sqrtf(one_minus_exp2x(la, av));
                            const float bt = mult * ig * bf2f(XR[l * XS + d]);
                            const float h = av * h0p[(size_t)l * DR + dg] + bt; hop[(size_t)l * DR + dg] = h;
                            GL[l * XS + d] = (bf16)f2bf(h * bf2f(GL[l * XS + d])); } } }
            } else {
                for (int rg_ = 0; rg_ < ((!FINAL && (SUBREP & 256)) ? 2 : 1); ++rg_) { asm volatile("" ::: "memory");
#pragma unroll
                for (int nt = 0; nt < 8; ++nt) { const int d = 16 * nt + fr, dg = kb * 128 + d; const float cfac = CHC[d], bav = CHC[128 + d], bxv = CHC[256 + d];
                    float aq[4], bq[4], A = 1.f, H = 0.f;
#pragma unroll
                    for (int q = 0; q < 4; q += 2) { const int l = l0 + 4 * fq + q; v2f av2, bt2, la2;
                        lru_gate2((v2f){acc[nt][q], acc[nt][q + 1]}, (v2f){acc[nt + 8][q], acc[nt + 8][q + 1]}, bav, bxv, cfac, (v2f){bf2f(XR[l * XS + d]), bf2f(XR[(l + 1) * XS + d])}, av2, bt2, la2);
                        aq[q] = av2.x; aq[q + 1] = av2.y; bq[q] = bt2.x; bq[q + 1] = bt2.y;
                        H = av2.x * H + bt2.x; H = av2.y * H + bt2.y; A *= av2.x * av2.y;
                        if (!FINAL) { LAB[(size_t)(row0 + l) * DR + dg] = pk2(la2.x, bt2.x); LAB[(size_t)(row0 + l + 1) * DR + dg] = pk2(la2.y, bt2.y); } }
                    const float Ap = xor16_f(A, lane), Hp = xor16_f(H, lane);
                    const bool odd = (fq & 1) != 0;
                    const float AT = A * Ap, HT = odd ? A * Hp + H : Ap * H + Hp;
                    const float A01 = xor32_f(AT, lane), H01 = xor32_f(HT, lane);
                    const float Aex = fq == 0 ? 1.f : fq == 1 ? Ap : fq == 2 ? A01 : Ap * A01, Hex = fq == 0 ? 0.f : fq == 1 ? Hp : fq == 2 ? H01 : Ap * H01 + Hp;
                    if (!FINAL) { if (fq == 3) { const v2f tot = (v2f){A01 * AT, AT * H01 + HT};
                            *(LAS v2f*)(WSUM + (wave * 128 + d) * 2) = tot; } }
                    else { float h = Aex * WSUM[wave * 128 + d] + Hex;
#pragma unroll
                        for (int q = 0; q < 4; ++q) { const int l = l0 + 4 * fq + q; h = aq[q] * h + bq[q];
                            GL[l * XS + d] = (bf16)f2bf(h * bf2f(GL[l * XS + d]));
                            if (c == NCH - 1 && l == Q - 1) out[O_PLH + ((size_t)j * NB + b) * DR + dg] = h; } }
                    __builtin_amdgcn_sched_barrier(0); }
                }
            }
        }
        if (!FINAL) { __syncthreads();
            if (tid < 128) { float A = 1.f, H = 0.f; const int nw = Q / 16;
                for (int ww = 0; ww < nw; ++ww) { const v2f sm = *(const LAS v2f*)(WSUM + (ww * 128 + tid) * 2); H = sm.x * H + sm.y; A *= sm.x; }
                *(GAS v2f*)(LSUM + ((size_t)(b * NCH + c) * DR + kb * 128 + tid) * 2) = (v2f){A, H}; } }
        if (FINAL && act) { LDS_WAIT();
#pragma unroll
            for (int k = 0; k < 4; ++k) { const int ci = lane + 64 * k, rr = l0 + (ci >> 4), c16 = ci & 15;
                *(GAS v4u*)(YL + (size_t)(row0 + rr) * DR + kb * 128 + 8 * c16) = *(const LAS v4u*)(GL + rr * XS + 8 * c16); } }
        if (FINAL && (SUBREP & 16) && samp && !srep_) { srep_ = true; item -= gridDim.x; }
    }
}

__device__ __forceinline__ void lru_sample_item(unsigned char* ws, float* out, LAS unsigned char* lds, int j, int kb, int rgp, int tid, int wave) {
    const bf16* G = (const bf16*)(ws + WS_ZX); const bf16* XRAW = G + (size_t)T * DR; bf16* YL = (bf16*)(ws + WS_YN);
    const bf16* WAX = (const bf16*)(ws + WS_W) + WE_LRU0 + (size_t)j * WE_LEND + WE_LAX + (size_t)kb * 256 * 128;
    const float* LCF = (const float*)(ws + WS_LCF) + (size_t)j * DR;
    const float* cw = arg_in(I_LCW) + (size_t)j * 4 * DR; const float* cb = arg_in(I_LCB) + (size_t)j * DR;
    const float* ba = arg_in(I_LBA) + (size_t)j * DR; const float* bx = arg_in(I_LBX) + (size_t)j * DR;
    LAS bf16* XR = (LAS bf16*)(lds + 32768);
    LAS bf16* GLs = XR + 16 * XS;
    const int lane = tid & 63, fr = lane & 15, fq = lane >> 4, s0 = 16 * rgp, d = 16 * wave + fr, dg = kb * 128 + d;
    float h0v[4];
    { const float* h0p = arg_in(I_SLH) + (size_t)j * NS * DR;
#pragma unroll
      for (int q = 0; q < 4; ++q) h0v[q] = h0p[(size_t)(s0 + 4 * fq + q) * DR + dg]; }
    const float cfac = LCF[dg], bav = ba[dg], bxv = bx[dg];
    bf16x8 wa[4], wx[4];
#pragma unroll
    for (int kk = 0; kk < 4; ++kk) { wa[kk] = *(const GAS bf16x8*)(WAX + (size_t)(16 * wave + fr) * 128 + 32 * kk + 8 * fq); wx[kk] = *(const GAS bf16x8*)(WAX + (size_t)(128 + 16 * wave + fr) * 128 + 32 * kk + 8 * fq); }
    __syncthreads();
    { const int rr = tid >> 5, c4 = tid & 31, cc = kb * 128 + 4 * c4, s = s0 + rr;
      const float* sp = arg_in(I_SLC) + (((size_t)j * NS + s) * 3) * DR + cc; float* op = out + O_SLC + (((size_t)j * NS + s) * 3) * DR + cc;
      const v4f q0 = *(const GAS v4f*)sp, q1 = *(const GAS v4f*)(sp + DR), q2 = *(const GAS v4f*)(sp + 2 * DR);
      const v2u xr = *(const GAS v2u*)(XRAW + (size_t)(TP + s) * DR + cc), gg = *(const GAS v2u*)(G + (size_t)(TP + s) * DR + cc);
      const v4f w0 = *(const GAS v4f*)(cw + cc), w1 = *(const GAS v4f*)(cw + DR + cc), w2 = *(const GAS v4f*)(cw + 2 * DR + cc), w3 = *(const GAS v4f*)(cw + 3 * DR + cc), bb = *(const GAS v4f*)(cb + cc);
      const v4f x3 = (v4f){bflo(xr.x), bfhi(xr.x), bflo(xr.y), bfhi(xr.y)};
      const v4f t = bb + w0 * q0 + w1 * q1 + w2 * q2 + w3 * x3;
      *(GAS v4f*)op = q1; *(GAS v4f*)(op + DR) = q2; *(GAS v4f*)(op + 2 * DR) = x3;
      *(LAS v2u*)(XR + rr * XS + 4 * c4) = (v2u){pk2(t.x, t.y), pk2(t.z, t.w)};
      *(LAS v2u*)(GLs + rr * XS + 4 * c4) = gg; }
    __syncthreads();
    pg8::f32x4 aa = (pg8::f32x4){0.f, 0.f, 0.f, 0.f}, ax = aa;
#pragma unroll
    for (int kk = 0; kk < 4; ++kk) { const bf16x8 af = *(const LAS bf16x8*)(XR + fr * XS + 32 * kk + 8 * fq);
        aa = __builtin_amdgcn_mfma_f32_16x16x32_bf16(af, wa[kk], aa, 0, 0, 0); ax = __builtin_amdgcn_mfma_f32_16x16x32_bf16(af, wx[kk], ax, 0, 0, 0); }
    float* hop = out + O_SLH + (size_t)j * NS * DR;
#pragma unroll
    for (int q = 0; q < 4; ++q) { const int l = 4 * fq + q;
        const float rgt = sigmoid_f(aa[q] + bav), ig = sigmoid_f(ax[q] + bxv), la = -cfac * rgt, av = __expf(la), mult = __builtin_amdgcn_sqrtf(one_minus_exp2x(la, av));
        const float bt = mult * ig * bf2f(XR[l * XS + d]);
        const float h = av * h0v[q] + bt; hop[(size_t)(s0 + l) * DR + dg] = h;
        YL[(size_t)(TP + s0 + l) * DR + dg] = (bf16)f2bf(h * bf2f(GLs[l * XS + d])); }
}

__device__ __forceinline__ void lru_phase_b(unsigned char* ws, float* out, LAS unsigned char* lds, int j, int tid0, int wave) {
    const bf16* G = (const bf16*)(ws + WS_ZX); bf16* YL = (bf16*)(ws + WS_YN);
    const float* LSUM = (const float*)(ws + WS_SCR + SC_LSUM); const unsigned* LAB = (const unsigned*)(ws + WS_SCR + SC_LAB);
    int tid = tid0; asm volatile("" : "+v"(tid));
    const int c4 = tid & 31, rg = tid >> 5;
    LAS float* QS = (LAS float*)lds;
    LAS float* HINL = QS + 16 * 128 * 2;
    v4u abn[8]; v2u gqn[8];
#define LB_ISSUE(item_) { const SsdItem it_ = ssd_item(item_); const int rr_ = rg < it_.Q / 8 ? 8 * rg : 0; \
        const unsigned* labp_ = LAB + (size_t)(it_.row0 + rr_) * DR + it_.g * 128 + 4 * c4; const bf16* gp_ = G + (size_t)(it_.row0 + rr_) * DR + it_.g * 128 + 4 * c4; \
        _Pragma("unroll") for (int i = 0; i < 8; ++i) { abn[i] = *(const GAS v4u*)(labp_ + (size_t)i * DR); gqn[i] = *(const GAS v2u*)(gp_ + (size_t)i * DR); } }
    int item = blockIdx.x;
    if (item < N_CITEMS) LB_ISSUE(item)
    for (; item < N_CITEMS; item += gridDim.x) {
        const SsdItem it = ssd_item(item); const int b = it.b, c = it.c, kb = it.g, Q = it.Q, row0 = it.row0;
        const int nrg = Q / 8, r0 = 8 * rg, dg4 = kb * 128 + 4 * c4;
        v2f cs_[NCH - 1];
        if (tid < 128) { const int dg = kb * 128 + tid;
#pragma unroll
            for (int cp = 0; cp < NCH - 1; ++cp) { const v2f t = *(const GAS v2f*)(LSUM + ((size_t)(b * NCH + (cp < c ? cp : 0)) * DR + dg) * 2); const float mk = cp < c ? 1.f : 0.f;
                cs_[cp].x = 1.f + mk * (t.x - 1.f); cs_[cp].y = mk * t.y; } }
        v4u ab[8]; v2u gq[8];
#pragma unroll
        for (int i = 0; i < 8; ++i) { ab[i] = abn[i]; gq[i] = gqn[i]; }
        if (item + (int)gridDim.x < N_CITEMS) LB_ISSUE(item + (int)gridDim.x)
        __syncthreads();
        if (tid < 128) { float h = 0.f;
#pragma unroll
            for (int cp = 0; cp < NCH - 1; ++cp) h = cs_[cp].x * h + cs_[cp].y;
            HINL[tid] = h; }
        float av[8][4]; v4f A4 = (v4f){1.f, 1.f, 1.f, 1.f}, H4 = (v4f){0.f, 0.f, 0.f, 0.f};
#pragma unroll
        for (int i = 0; i < 8; ++i) { const v4u w = ab[i];
            av[i][0] = __expf(bflo(w.x)); av[i][1] = __expf(bflo(w.y)); av[i][2] = __expf(bflo(w.z)); av[i][3] = __expf(bflo(w.w));
            const v4f a4 = (v4f){av[i][0], av[i][1], av[i][2], av[i][3]}, b4 = (v4f){bfhi(w.x), bfhi(w.y), bfhi(w.z), bfhi(w.w)};
            H4 = a4 * H4 + b4; A4 = A4 * a4; }
        if (rg < nrg) { *(LAS v4f*)(QS + (rg * 128 + 4 * c4) * 2) = (v4f){A4.x, H4.x, A4.y, H4.y}; *(LAS v4f*)(QS + (rg * 128 + 4 * c4) * 2 + 4) = (v4f){A4.z, H4.z, A4.w, H4.w}; }
        __syncthreads();
        if (rg < nrg) {
            v4f h4 = *(const LAS v4f*)(HINL + 4 * c4);
            for (int qq = 0; qq < rg; ++qq) { const v4f s0 = *(const LAS v4f*)(QS + (qq * 128 + 4 * c4) * 2), s1 = *(const LAS v4f*)(QS + (qq * 128 + 4 * c4) * 2 + 4);
                h4 = (v4f){s0.x * h4.x + s0.y, s0.z * h4.y + s0.w, s1.x * h4.z + s1.y, s1.z * h4.w + s1.w}; }
            bf16* yp = YL + (size_t)(row0 + r0) * DR + dg4;
#pragma unroll
            for (int i = 0; i < 8; ++i) { const v4u w = ab[i]; const v4f a4 = (v4f){av[i][0], av[i][1], av[i][2], av[i][3]}, b4 = (v4f){bfhi(w.x), bfhi(w.y), bfhi(w.z), bfhi(w.w)};
                h4 = a4 * h4 + b4;
                const v4f g4 = (v4f){bflo(gq[i].x), bfhi(gq[i].x), bflo(gq[i].y), bfhi(gq[i].y)}, y4 = h4 * g4;
                *(GAS v2u*)(yp + (size_t)i * DR) = (v2u){pk2(y4.x, y4.y), pk2(y4.z, y4.w)}; }
            if (c == NCH - 1 && rg == nrg - 1) *(GAS v4f*)(out + O_PLH + ((size_t)j * NB + b) * DR + dg4) = h4;
        }
    }
#undef LB_ISSUE
    for (; item < N_CITEMS + 64; item += gridDim.x) { const int si = item - N_CITEMS; lru_sample_item(ws, out, lds, j, si & 7, si >> 3, tid, wave); }
}
#define RLX_AGENT __ATOMIC_RELAXED, __HIP_MEMORY_SCOPE_AGENT
#define XB_TMO      128
#define XB_XCNT(j)  (256  + 64 * (j))
#define XB_XSUB(j)  (1280 + 64 * (j))
#define XB_XGEN(j)  (2304 + 64 * (j))
#define XB_TOP      3328
#define XB_TOPGEN   3392
#define XCD_BAR_WORDS 3456
#define XB_SPIN_CAP (1u << 18)

__device__ __forceinline__ unsigned xb_ld(unsigned* p)              { return __hip_atomic_load(p, __ATOMIC_RELAXED, __HIP_MEMORY_SCOPE_AGENT); }
__device__ __forceinline__ unsigned xb_add(unsigned* p, unsigned v) { return __hip_atomic_fetch_add(p, v, __ATOMIC_RELAXED, __HIP_MEMORY_SCOPE_AGENT); }
__device__ __forceinline__ unsigned xb_xcc_id() { return (unsigned)__builtin_amdgcn_s_getreg((3 << 11) | 20) & 0xFu; }
#define XB_SPIN(cond, bar) do { unsigned _sp = 0; while (cond) { __builtin_amdgcn_s_sleep(1); \
    if ((++_sp & 255u) == 0u) { if (xb_ld(&(bar)[XB_TMO])) break; if (_sp > XB_SPIN_CAP) { atomicAdd(&(bar)[XB_TMO], 1u); break; } } } } while (0)

struct XcdBarrier {
    unsigned* bar; unsigned x;
    volatile LAS unsigned* st;
};

__device__ __forceinline__ XcdBarrier xcd_barrier_post(unsigned* bar, volatile LAS unsigned* st) {
    XcdBarrier b; b.bar = bar; b.x = xb_xcc_id(); b.st = st;
    if (threadIdx.x == 0) (void)xb_add(&bar[XB_XCNT(b.x)], 1u);
    return b;
}
__device__ __forceinline__ void xcd_barrier_complete(unsigned* bar, unsigned x, unsigned& nloc, unsigned& nx) {
    const unsigned G = gridDim.x * gridDim.y * gridDim.z;
    unsigned sum, cnt, mine, sp = 0u;
    for (;;) {
        sum = 0u; cnt = 0u; mine = 0u;
#pragma unroll
        for (unsigned j = 0; j < 16; ++j) { const unsigned c = xb_ld(&bar[XB_XCNT(j)]); sum += c; cnt += (c > 0u) ? 1u : 0u; mine = (j == x) ? c : mine; }
        if (sum == G) break;
        __builtin_amdgcn_s_sleep(1);
        if ((++sp & 255u) == 0u) { if (xb_ld(&bar[XB_TMO])) break; if (sp > XB_SPIN_CAP) { atomicAdd(&bar[XB_TMO], 1u); break; } }
    }
    nloc = mine > 0u ? mine : 1u; nx = cnt > 0u ? cnt : 1u;
}

__device__ __forceinline__ void xcd_barrier(const XcdBarrier& b) {
    asm volatile("s_waitcnt vmcnt(0)" ::: "memory");
    __syncthreads();
    if (threadIdx.x == 0) {
        unsigned* bar = b.bar;
        __builtin_amdgcn_s_waitcnt(0);
        unsigned nloc = b.st[0], nx = b.st[1];
        if (nloc == 0u) { xcd_barrier_complete(bar, b.x, nloc, nx); b.st[0] = nloc; b.st[1] = nx; }
        const unsigned old = xb_add(&bar[XB_XSUB(b.x)], 1u);
        const unsigned gen = old / nloc;
        if (old + 1u == (gen + 1u) * nloc) {
            __builtin_amdgcn_fence(__ATOMIC_RELEASE, "agent");
            asm volatile("s_waitcnt vmcnt(0)" ::: "memory");
            const unsigned og = xb_add(&bar[XB_TOP], 1u);
            const unsigned tg = og / nx;
            if (og + 1u == (tg + 1u) * nx) xb_add(&bar[XB_TOPGEN], 1u);
            else XB_SPIN(xb_ld(&bar[XB_TOPGEN]) == tg, bar);
            __builtin_amdgcn_fence(__ATOMIC_ACQUIRE, "agent");
            xb_add(&bar[XB_XGEN(b.x)], 1u);
            asm volatile("s_waitcnt vmcnt(0)" ::: "memory");
        } else {
            XB_SPIN(xb_ld(&bar[XB_XGEN(b.x)]) == gen, bar);
            __builtin_amdgcn_fence(__ATOMIC_ACQUIRE, "agent");
            asm volatile("s_waitcnt vmcnt(0)" ::: "memory");
        }
    }
    __syncthreads();
}

typedef float f32x16 __attribute__((ext_vector_type(16)));
constexpr int SG_SP = 136, SG_WREG = 2 * 32 * SG_SP * 2;
template <int K, int RT, class Epi>
__device__ __forceinline__ void small_gemm(LAS unsigned char* lds, const bf16* A, const bf16* Bt, int rt0, int nrt, int ct0, int nct, const Epi& E) {
    static_assert(RT == 1 && K % 1024 == 0, "small_gemm shape");
    int tid_ = threadIdx.x; asm volatile("" : "+v"(tid_));
    const int tid = tid_, lane = tid & 63, wave = __builtin_amdgcn_readfirstlane(tid >> 6), r = lane & 31, hh = lane >> 5, c16 = lane & 15, rs = lane >> 4;
    constexpr int KW = K / 8, NBAT = KW / 128;
    LAS bf16* As = (LAS bf16*)(lds + wave * SG_WREG); LAS bf16* Bs = As + 32 * SG_SP;
    LAS float* Pw = (LAS float*)(lds + wave * SG_WREG);
    const int ntiles = nrt * nct;
    v4u sa[8], sb[8];
#define SG_ISSUE(tile_, b_) { const bf16* ap_ = A + (size_t)(32 * (rt0 + (tile_) / nct) + rs) * K + wave * KW + 128 * (b_) + 8 * c16; \
        const bf16* bp_ = Bt + (size_t)(32 * (ct0 + (tile_) % nct) + rs) * K + wave * KW + 128 * (b_) + 8 * c16; \
        _Pragma("unroll") for (int i = 0; i < 8; ++i) { sa[i] = *(const GAS v4u*)(ap_ + (size_t)(4 * i) * K); sb[i] = *(const GAS v4u*)(bp_ + (size_t)(4 * i) * K); } }
    int tile = blockIdx.x;
    if (tile < ntiles) SG_ISSUE(tile, 0)
    for (; tile < ntiles; tile += gridDim.x) {
        const int row0 = 32 * (rt0 + tile / nct), col0 = 32 * (ct0 + tile % nct);
        f32x16 acc;
#pragma unroll
        for (int i = 0; i < 16; ++i) acc[i] = 0.f;
        __syncthreads();
#pragma unroll 1
        for (int b = 0; b < NBAT; ++b) {
#pragma unroll
            for (int i = 0; i < 8; ++i) { *(LAS v4u*)(As + (4 * i + rs) * SG_SP + 8 * c16) = sa[i]; *(LAS v4u*)(Bs + (4 * i + rs) * SG_SP + 8 * c16) = sb[i]; }
            bf16x8 af[8], bfr[8];
#pragma unroll
            for (int i = 0; i < 8; ++i) { af[i] = *(const LAS bf16x8*)(As + r * SG_SP + 16 * i + 8 * hh); bfr[i] = *(const LAS bf16x8*)(Bs + r * SG_SP + 16 * i + 8 * hh); }
            if (b + 1 < NBAT) SG_ISSUE(tile, b + 1)
            else if (tile + (int)gridDim.x < ntiles) SG_ISSUE(tile + (int)gridDim.x, 0)
#pragma unroll
            for (int i = 0; i < 8; ++i) acc = __builtin_amdgcn_mfma_f32_32x32x16_bf16(af[i], bfr[i], acc, 0, 0, 0);
        }
#pragma unroll
        for (int i = 0; i < 16; ++i) Pw[((i & 3) + 8 * (i >> 2) + 4 * hh) * 33 + r] = acc[i];
        __syncthreads();
#pragma unroll
        for (int e = 0; e < 2; ++e) { const int idx = tid + 512 * e, rr = idx >> 5, cc = idx & 31; float v = 0.f;
#pragma unroll
            for (int w = 0; w < 8; ++w) v += *(const LAS float*)(lds + w * SG_WREG + (rr * 33 + cc) * 4);
            E.elem(row0 + rr, col0 + cc, v); }
    }
#undef SG_ISSUE
}
constexpr int TM = 16384;
__device__ __forceinline__ void touch_region(const void* p, size_t bytes, int gthread, int nthreads) {
    const GAS v4u* q = (const GAS v4u*)p; const size_t n = bytes / 16;
    for (size_t i = gthread; i < n; i += (size_t)nthreads * 4) { v4u a = q[i], b = (i + nthreads < n) ? q[i + nthreads] : a, c = (i + 2 * (size_t)nthreads < n) ? q[i + 2 * (size_t)nthreads] : a, d = (i + 3 * (size_t)nthreads < n) ? q[i + 3 * (size_t)nthreads] : a;
        asm volatile("" :: "v"(a), "v"(b), "v"(c), "v"(d)); }
}
template <int N, int K, class Epi>
__device__ __forceinline__ void run_gemm(LAS unsigned char* lds, const bf16* A, const bf16* Bt, const Epi& E) {
    pg8::Gemm g{A, Bt, TM, N, K}; pg8::StaticOrder S; S.init(TM, N, (int)gridDim.x, (int)blockIdx.x);
    pg8::gemm_phase<Epi, pg8::StaticOrder, true, true>(lds, g, S, E);
    small_gemm<K, 1>(lds, A, Bt, TM / 32, (T - TM) / 32, 0, N / 32, E);
    if (SUBREP & 512) { asm volatile("" ::: "memory"); small_gemm<K, 1>(lds, A, Bt, TM / 32, (T - TM) / 32, 0, N / 32, E); }
}
__global__ void __launch_bounds__(NTHR, 2) mk_fwd(Args args) {
    extern __shared__ __attribute__((aligned(16))) unsigned char lds_raw[];
    LAS unsigned char* lds = (LAS unsigned char*)lds_raw;
    if (threadIdx.x < 2) ((LAS unsigned*)(lds + LDS_MISC_OFF))[threadIdx.x] = 0u;
    __syncthreads();
    const XcdBarrier bar = xcd_barrier_post((unsigned*)(args.ws + WS_CTL) + CW_BAR, (volatile LAS unsigned*)(lds + LDS_MISC_OFF));
    for (int ph = args.ph_lo, rep = 0; ph < args.ph_hi; ++ph) {
        if (ph > 0 && ((ph - 1) / PL) % 2 == 1 && (ph - 1) % PL == 3) continue;
        if (ph == args.ph_lo + 1 && rep == 0) cg::this_grid().sync();
        else if (ph > args.ph_lo || rep) xcd_barrier(bar);
        int tid = threadIdx.x; asm volatile("" : "+v"(tid));
        unsigned char* ws = args.ws; asm volatile("" : "+s"(ws));
        const int lane = tid & 63, wave = __builtin_amdgcn_readfirstlane(tid >> 6);
        const int G = gridDim.x, gw = blockIdx.x * NWAVES + wave, NGW = G * NWAVES;
        bf16* WB = (bf16*)(ws + WS_W); bf16* XB = (bf16*)(ws + WS_XB); float* RS = (float*)(ws + WS_RS); bf16* Mb = (bf16*)(ws + WS_M);
        bf16* ZX = (bf16*)(ws + WS_ZX); float* DT = (float*)(ws + WS_DT); bf16* YN = (bf16*)(ws + WS_YN);
        if (ph == 0) { p0_prologue(args, lds, gw, NGW, wave, lane); if (((REP_MASK >> 6) & 1) && rep == 0) { rep = 1; --ph; } else rep = 0; continue; }
        const int i = (ph - 1) / PL, k = (ph - 1) % PL, j = i >> 1; const bool ssd = (i & 1) == 0;
        bf16* wl = ssd ? WB + WE_SSD0 + (size_t)j * WE_SEND : WB + WE_LRU0 + (size_t)j * WE_LEND;
        bf16* wf = WB + WE_FFN0 + (size_t)i * WE_FEND;
        if (k == 0) {
            if (ssd) { pg8::EpiSsdIn E{ZX, DT, RS}; run_gemm<ZXW, DM>(lds, XB, wl + WE_SIN, E);
                small_gemm<DM, 1>(lds, XB, wl + WE_SIN, 0, T / 32, ZXW / 32, 1, E); }
            else { pg8::EpiLruIn E{ZX, ZX + (size_t)T * DR, RS, arg_in(I_LBIN) + (size_t)j * 2048}; run_gemm<2048, DM>(lds, XB, wl + WE_LIN, E); }
        } else if (k == 4) {
            if (ssd) { pg8::EpiM E{Mb, nullptr}; run_gemm<DM, DI>(lds, YN, wl + WE_SOUT, E); }
            else { pg8::EpiM E{Mb, arg_in(I_LBOUT) + (size_t)j * DM}; run_gemm<DM, DR>(lds, YN, wl + WE_LOUT, E); }
        } else if (k == 5) { if (TOUCH_W) touch_region(wf, (size_t)WE_FEND * 2, blockIdx.x * NTHR + tid, G * NTHR);
            resid_phase(args, arg_in(I_NMPOST) + (size_t)i * DM, false, gw, NGW, lane);
        } else if (k == 6) { pg8::EpiFfn1 E{ZX, RS}; run_gemm<DFF, DM>(lds, XB, wf + WE_F1, E);
        } else if (k == 7) { pg8::EpiM E{Mb, nullptr}; run_gemm<DM, DFF>(lds, ZX, wf + WE_F2, E);
        } else if (k == 8) { resid_phase(args, arg_in(I_NFPOST) + (size_t)i * DM, i == 3, gw, NGW, lane);
        }
        else if (ssd && k == 1) ssd_phase_a(ws, args.out, lds, j, tid, lane, wave);
        else if (ssd && k == 2) ssd_phase_b(ws, args.out, j, tid);
        else if (ssd && k == 3) ssd_phase_c(ws, args.out, lds, j, tid, lane, wave);
        else if (!ssd && k == 1) lru_phase<false>(ws, args.out, lds, j, tid, lane, wave);
        else if (!ssd && k == 2) lru_phase_b(ws, args.out, lds, j, tid, wave);
        if (REP_MASK) { const int kind = (k == 0 || k == 4 || k == 6 || k == 7) ? 0 : (ssd && k >= 1 && k <= 3) ? k : (!ssd && k >= 1 && k <= 2) ? 3 + k : 9;
            if (((REP_MASK >> kind) & 1) && rep == 0) { rep = 1; --ph; } else rep = 0; }
    }
}

__global__ void k_ssd_conv(const bf16* __restrict__ ZX, const float* __restrict__ st, const float* __restrict__ cw, const float* __restrict__ cb,
                           float* __restrict__ XBC, float* __restrict__ o_p, float* __restrict__ o_s) {
    const int r = blockIdx.x, c = blockIdx.y * 256 + threadIdx.x;
    float x0, x1, x2; const float x3 = bf2f(ZX[(size_t)r * ZXW + DI + c]);
    if (r < TP) { const int t = r % LP;
        x2 = t >= 1 ? bf2f(ZX[(size_t)(r - 1) * ZXW + DI + c]) : 0.f; x1 = t >= 2 ? bf2f(ZX[(size_t)(r - 2) * ZXW + DI + c]) : 0.f; x0 = t >= 3 ? bf2f(ZX[(size_t)(r - 3) * ZXW + DI + c]) : 0.f;
        if (t >= LP - 3) o_p[((size_t)(r / LP) * 3 + (t - (LP - 3))) * CONVD + c] = x3;
    } else { const int s = r - TP; const float* sp = st + (size_t)s * 3 * CONVD + c; x0 = sp[0]; x1 = sp[CONVD]; x2 = sp[2 * CONVD];
        float* op = o_s + (size_t)s * 3 * CONVD + c; op[0] = x1; op[CONVD] = x2; op[2 * CONVD] = x3; }
    const float v = cb[c] + cw[c] * x0 + cw[CONVD + c] * x1 + cw[2 * CONVD + c] * x2 + cw[3 * CONVD + c] * x3;
    XBC[(size_t)r * CONVD + c] = silu_f(v);
}
__global__ void __launch_bounds__(64) k_ssd_scan(const float* __restrict__ DT, const float* __restrict__ XBC, const float* __restrict__ h0,
                                                 const float* __restrict__ dt_bias, const float* __restrict__ a_log, const float* __restrict__ dsk,
                                                 float* __restrict__ Y, float* __restrict__ o_ph, float* __restrict__ o_sh) {
    const int q = blockIdx.x / NH, h = blockIdx.x % NH, p = threadIdx.x, g = h / 4;
    const int row0 = seq_row0(q), L = seq_len(q);
    float hs[NST];
    if (q < NB) {
#pragma unroll
        for (int n = 0; n < NST; ++n) hs[n] = 0.f;
    } else { const float* hp = h0 + (((size_t)(q - NB) * NH + h) * HD + p) * NST;
#pragma unroll
        for (int n = 0; n < NST; n += 4) { const float4 v = *(const float4*)(hp + n); hs[n] = v.x; hs[n + 1] = v.y; hs[n + 2] = v.z; hs[n + 3] = v.w; } }
    const float Aneg = -__expf(a_log[h]), dtb = dt_bias[h], Dh = dsk[h];
    for (int t = 0; t < L; ++t) {
        const size_t row = (size_t)(row0 + t);
        const float dtv = softplus_f(DT[row * 32 + h] + dtb);
        const float dA = __expf(dtv * Aneg);
        const float xv = XBC[row * CONVD + h * HD + p], xdt = xv * dtv;
        const float* Bp = XBC + row * CONVD + DI + g * NST; const float* Cp = Bp + NG * NST;
        float y = 0.f;
#pragma unroll
        for (int n = 0; n < NST; ++n) { hs[n] = fmaf(hs[n], dA, xdt * Bp[n]); y = fmaf(Cp[n], hs[n], y); }
        Y[row * DI + h * HD + p] = y + Dh * xv;
    }
    float* op = (q < NB ? o_ph + (((size_t)q * NH + h) * HD + p) * NST : o_sh + (((size_t)(q - NB) * NH + h) * HD + p) * NST);
#pragma unroll
    for (int n = 0; n < NST; n += 4) *(float4*)(op + n) = make_float4(hs[n], hs[n + 1], hs[n + 2], hs[n + 3]);
}
__global__ void k_ssd_gate_norm(const float* __restrict__ Y, const bf16* __restrict__ ZX, bf16* __restrict__ YN) {
    const int wv = blockIdx.x * 4 + (threadIdx.x >> 6), lane = threadIdx.x & 63, r = wv / NG, g = wv % NG, c = g * 256 + lane * 4;
    const float4 y = *(const float4*)(Y + (size_t)r * DI + c); const v2u zz = *(const v2u*)(ZX + (size_t)r * ZXW + c);
    float4 v = make_float4(y.x * silu_f(bflo(zz.x)), y.y * silu_f(bfhi(zz.x)), y.z * silu_f(bflo(zz.y)), y.w * silu_f(bfhi(zz.y)));
    const float s = wave_sum(v.x * v.x + v.y * v.y + v.z * v.z + v.w * v.w);
    const float rs = rsqrtf(s * (1.f / 256.f) + EPS);
    *(v2u*)(YN + (size_t)r * DI + c) = (v2u){pk2(v.x * rs, v.y * rs), pk2(v.z * rs, v.w * rs)};
}
__global__ void k_lru_conv(const bf16* __restrict__ XRAW, const float* __restrict__ st, const float* __restrict__ cw, const float* __restrict__ cb,
                           float* __restrict__ XR, float* __restrict__ o_p, float* __restrict__ o_s) {
    const int r = blockIdx.x, c = blockIdx.y * 256 + threadIdx.x;
    float x0, x1, x2; const float x3 = bf2f(XRAW[(size_t)r * DR + c]);
    if (r < TP) { const int t = r % LP;
        x2 = t >= 1 ? bf2f(XRAW[(size_t)(r - 1) * DR + c]) : 0.f; x1 = t >= 2 ? bf2f(XRAW[(size_t)(r - 2) * DR + c]) : 0.f; x0 = t >= 3 ? bf2f(XRAW[(size_t)(r - 3) * DR + c]) : 0.f;
        if (t >= LP - 3) o_p[((size_t)(r / LP) * 3 + (t - (LP - 3))) * DR + c] = x3;
    } else { const int s = r - TP; const float* sp = st + (size_t)s * 3 * DR + c; x0 = sp[0]; x1 = sp[DR]; x2 = sp[2 * DR];
        float* op = o_s + (size_t)s * 3 * DR + c; op[0] = x1; op[DR] = x2; op[2 * DR] = x3; }
    XR[(size_t)r * DR + c] = cb[c] + cw[c] * x0 + cw[DR + c] * x1 + cw[2 * DR + c] * x2 + cw[3 * DR + c] * x3;
}
__global__ void k_lru_gates(const float* __restrict__ XR, const float* __restrict__ wa, const float* __restrict__ ba, const float* __restrict__ wx, const float* __restrict__ bx,
                            const float* __restrict__ lam, float* __restrict__ AV, float* __restrict__ BV) {
    const int r = blockIdx.x, d = blockIdx.y * 256 + threadIdx.x, k = d >> 7, dd = d & 127;
    const float* xr = XR + (size_t)r * DR + k * 128; const float* wap = wa + (size_t)k * 128 * 128 + dd; const float* wxp = wx + (size_t)k * 128 * 128 + dd;
    float sa = ba[d], sx = bx[d];
    for (int c = 0; c < 128; ++c) { const float xv = xr[c]; sa = fmaf(xv, wap[c * 128], sa); sx = fmaf(xv, wxp[c * 128], sx); }
    const float rg = sigmoid_f(sa), ig = sigmoid_f(sx);
    const float log_a = -8.0f * rg * softplus_f(-lam[d]);
    const float av = __expf(log_a), mult = sqrtf(-expm1f(2.f * log_a));
    AV[(size_t)r * DR + d] = av; BV[(size_t)r * DR + d] = mult * ig * XR[(size_t)r * DR + d];
}
__global__ void k_lru_scan(const float* __restrict__ AV, const float* __restrict__ BV, const bf16* __restrict__ Gt, const float* __restrict__ h0,
                           bf16* __restrict__ YL, float* __restrict__ o_p, float* __restrict__ o_s) {
    const int q = blockIdx.x, d = blockIdx.y * 256 + threadIdx.x, row0 = seq_row0(q), L = seq_len(q);
    float h = q < NB ? 0.f : h0[(size_t)(q - NB) * DR + d];
    for (int t = 0; t < L; ++t) { const size_t row = (size_t)(row0 + t);
        h = fmaf(AV[row * DR + d], h, BV[row * DR + d]);
        YL[row * DR + d] = (bf16)f2bf(h * bf2f(Gt[row * DR + d])); }
    if (q < NB) o_p[(size_t)q * DR + d] = h; else o_s[(size_t)(q - NB) * DR + d] = h;
}

extern "C" void kernel_launch(void* const* d_in, const int* in_sizes, int n_in, void* d_out, int out_size, void* d_ws, size_t ws_size, hipStream_t stream) {
    static int grid = 0;
    if (grid == 0) {
        if (n_in != N_IN || (size_t)out_size != O_END || ws_size < WS_END) { fprintf(stderr, "kernel_launch: unexpected sizes n_in %d out %d ws %zu (need %zu)\n", n_in, out_size, ws_size, (size_t)WS_END); grid = -1; return; }
        int dev = 0, cus = 0, per_cu = 0;
        if (hipGetDevice(&dev) != hipSuccess || hipDeviceGetAttribute(&cus, hipDeviceAttributeMultiprocessorCount, dev) != hipSuccess) { grid = -1; return; }
        if (hipFuncSetAttribute((const void*)mk_fwd, hipFuncAttributeMaxDynamicSharedMemorySize, LDS_BYTES) != hipSuccess) { fprintf(stderr, "kernel_launch: hipFuncSetAttribute failed\n"); grid = -1; return; }
        if (hipOccupancyMaxActiveBlocksPerMultiprocessor(&per_cu, (const void*)mk_fwd, NTHR, LDS_BYTES) != hipSuccess || per_cu < 1) { fprintf(stderr, "kernel_launch: occupancy query %d\n", per_cu); grid = -1; return; }
        grid = cus;
    }
    if (grid < 0) return;
    const float* const* in = (const float* const*)d_in; float* out = (float*)d_out; unsigned char* ws = (unsigned char*)d_ws;
    (void)hipMemsetAsync(ws + WS_CTL, 0, CTL_ZERO_BYTES, stream);
    Args a{};
    for (int i = 0; i < N_IN; ++i) a.in[i] = in[i];
    a.out = out; a.ws = ws;
    bf16* ZX = (bf16*)(ws + WS_ZX); float* DT = (float*)(ws + WS_DT); bf16* YN = (bf16*)(ws + WS_YN);
    float* SCR = (float*)(ws + WS_SCR);
    constexpr size_t SZ_X = (size_t)T * DM;
    int ph = 0;
    while (ph < NPH) {
        const int i = ph ? (ph - 1) / PL : -1, k = ph ? (ph - 1) % PL : -1, j = i >> 1;
        if (false) {
            if (k == 1) {
            if ((i & 1) == 0) {
                float* XBC = SCR; float* Y = SCR + (size_t)T * CONVD;
                hipLaunchKernelGGL(k_ssd_conv, dim3(T, CONVD / 256), dim3(256), 0, stream, ZX, in[I_SSC] + (size_t)j * NS * 3 * CONVD, in[I_SCW] + (size_t)j * 4 * CONVD, in[I_SCB] + (size_t)j * CONVD,
                                   XBC, out + O_PSC + (size_t)j * NB * 3 * CONVD, out + O_SSC + (size_t)j * NS * 3 * CONVD);
                hipLaunchKernelGGL(k_ssd_scan, dim3(NSEQ * NH), dim3(64), 0, stream, DT, XBC, in[I_SSH] + (size_t)j * NS * NH * HD * NST, in[I_SDTB] + j * NH, in[I_SALOG] + j * NH, in[I_SD] + j * NH,
                                   Y, out + O_PSH + (size_t)j * NB * NH * HD * NST, out + O_SSH + (size_t)j * NS * NH * HD * NST);
                hipLaunchKernelGGL(k_ssd_gate_norm, dim3(T * NG / 4), dim3(256), 0, stream, Y, ZX, YN);
            } else {
                float* XR = SCR; float* AV = SCR + SZ_X; float* BV = SCR + 2 * SZ_X;
                hipLaunchKernelGGL(k_lru_conv, dim3(T, DR / 256), dim3(256), 0, stream, ZX + (size_t)T * DR, in[I_SLC] + (size_t)j * NS * 3 * DR, in[I_LCW] + (size_t)j * 4 * DR, in[I_LCB] + (size_t)j * DR,
                                   XR, out + O_PLC + (size_t)j * NB * 3 * DR, out + O_SLC + (size_t)j * NS * 3 * DR);
                hipLaunchKernelGGL(k_lru_gates, dim3(T, DR / 256), dim3(256), 0, stream, XR, in[I_LWA] + (size_t)j * 8 * 128 * 128, in[I_LBA] + (size_t)j * DR, in[I_LWX] + (size_t)j * 8 * 128 * 128, in[I_LBX] + (size_t)j * DR,
                                   in[I_LLAM] + (size_t)j * DR, AV, BV);
                hipLaunchKernelGGL(k_lru_scan, dim3(NSEQ, DR / 256), dim3(256), 0, stream, AV, BV, ZX, in[I_SLH] + (size_t)j * NS * DR, YN, out + O_PLH + (size_t)j * NB * DR, out + O_SLH + (size_t)j * NS * DR);
            }
            }
            ++ph; continue;
        }
        int hi = ph + 1;
        hi = NPH;
        a.ph_lo = ph; a.ph_hi = hi;
        void* kargs[] = {(void*)&a};
        const hipError_t e = hipLaunchCooperativeKernel((const void*)mk_fwd, dim3(grid), dim3(NTHR), kargs, LDS_BYTES, stream);
        if (e != hipSuccess) fprintf(stderr, "kernel_launch: cooperative launch failed: %s (grid %d)\n", hipGetErrorString(e), grid);
        ph = hi;
    }
}
```

```cpp
#include <hip/hip_runtime.h>
#include <hip/hip_cooperative_groups.h>
#include <cstdio>
#include <cstdint>
namespace cg = cooperative_groups;

constexpr int DM = 1024, NB = 8, SEQ = 2048, NMETA = 16, LP = SEQ + NMETA  , NS = 128;
constexpr int TP = NB * LP  , T = TP + NS  ;
constexpr int DI = 2048, HD = 64, NH = 32, NG = 8, NST = 128, CONVD = 4096, INDIM = 6176, DFF = 4096, DR = 1024;
constexpr int ZXW = 6144;
constexpr int NPAD_SSD = 6400;
constexpr int NSEQ = NB + NS;
constexpr float EPS = 1e-6f;

constexpr size_t O_YP = 0, O_YS = O_YP + (size_t)NB * SEQ * DM, O_PSC = O_YS + (size_t)NS * DM, O_PSH = O_PSC + (size_t)2 * NB * 3 * CONVD,
                 O_PLC = O_PSH + (size_t)2 * NB * NH * HD * NST, O_PLH = O_PLC + (size_t)2 * NB * 3 * DR, O_SSC = O_PLH + (size_t)2 * NB * DR,
                 O_SSH = O_SSC + (size_t)2 * NS * 3 * CONVD, O_SLC = O_SSH + (size_t)2 * NS * NH * HD * NST, O_SLH = O_SLC + (size_t)2 * NS * 3 * DR,
                 O_END = O_SLH + (size_t)2 * NS * DR;

enum { I_XP = 0, I_XS, I_SSC, I_SSH, I_SLC, I_SLH, I_META, I_NMPRE, I_NMPOST, I_NFPRE, I_NFPOST, I_SWIN, I_SCW, I_SCB, I_SDTB, I_SALOG, I_SD, I_SNORM, I_SWOUT,
       I_LWIN, I_LBIN, I_LCW, I_LCB, I_LWA, I_LBA, I_LWX, I_LBX, I_LLAM, I_LWOUT, I_LBOUT, I_W1, I_W2, N_IN };

#ifndef SUBREP
#define SUBREP 0
#endif
typedef unsigned short bf16;

constexpr size_t MiB = 1u << 20;
constexpr size_t WS_CTL = 0, CTL_ZERO_BYTES = 32768;
constexpr size_t WS_LCF = 512 * 1024;
constexpr size_t WE_SIN = 0, WE_SOUT = WE_SIN + (size_t)NPAD_SSD * DM, WE_SEND = WE_SOUT + (size_t)DM * DI;
constexpr size_t WE_LIN = 0, WE_LAX = WE_LIN + (size_t)2048 * DM, WE_LOUT = WE_LAX + (size_t)8 * 256 * 128, WE_LEND = WE_LOUT + (size_t)DM * DR;
constexpr size_t WE_F1 = 0, WE_F2 = WE_F1 + (size_t)DFF * DM, WE_FEND = WE_F2 + (size_t)DM * DFF;
constexpr size_t WE_SSD0 = 0, WE_LRU0 = WE_SSD0 + 2 * WE_SEND, WE_FFN0 = WE_LRU0 + 2 * WE_LEND, WE_TOTAL = WE_FFN0 + 4 * WE_FEND;
constexpr size_t WS_W = 1 * MiB;
constexpr size_t WS_X = 121 * MiB;
constexpr size_t WS_XB = WS_X + 65 * MiB;
constexpr size_t WS_RS = WS_XB + 33 * MiB;
constexpr size_t WS_M = WS_RS + 1 * MiB;
constexpr size_t WS_ZX = WS_M + 65 * MiB;
constexpr size_t WS_DT = WS_ZX + 195 * MiB;
constexpr size_t WS_YN = WS_DT + 3 * MiB;
constexpr size_t WS_SCR = WS_YN + 65 * MiB;
constexpr size_t WS_END = WS_SCR + 400 * MiB;
static_assert(WE_TOTAL * 2 <= 120 * MiB, "weight region");
static_assert(WS_END <= 1024 * MiB, "d_ws map");

#define GAS __attribute__((address_space(1)))
#define LAS __attribute__((address_space(3)))
typedef unsigned v4u __attribute__((ext_vector_type(4)));
typedef unsigned v2u __attribute__((ext_vector_type(2)));
typedef float v4f __attribute__((ext_vector_type(4)));
typedef float v2f __attribute__((ext_vector_type(2)));
#define LDS_WAIT() asm volatile("s_waitcnt lgkmcnt(0)" ::: "memory")
#define VM_WAIT() asm volatile("s_waitcnt vmcnt(0)" ::: "memory")

__device__ __forceinline__ float silu_f(float x) { return x * __builtin_amdgcn_rcpf(1.f + __expf(-x)); }
__device__ __forceinline__ float sigmoid_f(float x) { return __builtin_amdgcn_rcpf(1.f + __expf(-x)); }
__device__ __forceinline__ float neg_expm1_f(float x) { const float p = x * (1.f + x * (0.5f + x * (0.16666667f + x * (0.041666668f + x * (0.0083333338f + x * 0.0013888889f)))));
    return x > -0.35f ? -p : 1.f - __expf(x); }
__device__ __forceinline__ float softplus_f(float x) { return fmaxf(x, 0.f) + log1pf(__expf(-fabsf(x))); }
__device__ __forceinline__ float one_minus_exp2x(float x, float e) { const float t = 2.f * x;
    const float p = t * (1.f + t * (0.5f + t * (0.16666667f + t * (0.041666668f + t * (0.0083333338f + t * 0.0013888889f)))));
    return t > -0.35f ? -p : 1.f - e * e; }
__device__ __forceinline__ void lru_gate2(v2f ga, v2f gx, float bav, float bxv, float cfac, v2f xr, v2f& av, v2f& bt, v2f& la) {
    const v2f ta = ga + bav, tx = gx + bxv;
    v2f ea, ex; ea.x = __expf(-ta.x); ea.y = __expf(-ta.y); ex.x = __expf(-tx.x); ex.y = __expf(-tx.y);
    ea = ea + 1.0f; ex = ex + 1.0f;
    v2f rg, ig; rg.x = __builtin_amdgcn_rcpf(ea.x); rg.y = __builtin_amdgcn_rcpf(ea.y); ig.x = __builtin_amdgcn_rcpf(ex.x); ig.y = __builtin_amdgcn_rcpf(ex.y);
    la = rg * (-cfac);
    av.x = __expf(la.x); av.y = __expf(la.y);
    const v2f t = la * 2.0f;
    const v2f p = t * (1.0f + t * (0.5f + t * (0.16666667f + t * (0.041666668f + t * (0.0083333338f + t * 0.0013888889f)))));
    const v2f q = 1.0f - av * av;
    v2f om; om.x = t.x > -0.35f ? -p.x : q.x; om.y = t.y > -0.35f ? -p.y : q.y;
    v2f mu; mu.x = __builtin_amdgcn_sqrtf(om.x); mu.y = __builtin_amdgcn_sqrtf(om.y);
    bt = mu * ig * xr;
}
__device__ __forceinline__ float gelu_tanh_f(float x) { const float u = 0.7978845608028654f * (x + 0.044715f * x * x * x); return x * __builtin_amdgcn_rcpf(1.f + __expf(-2.f * u)); }
__device__ __forceinline__ float dpp_add(float v, float w) { return v + w; }
#define WS_DPP(v, ctrl, rmask) ((v) + __builtin_bit_cast(float, __builtin_amdgcn_update_dpp(0, __builtin_bit_cast(int, (v)), (ctrl), (rmask), 0xf, true)))
__device__ __forceinline__ float wave_sum(float v) {
    v = WS_DPP(v, 0xB1, 0xf);
    v = WS_DPP(v, 0x4E, 0xf);
    v = WS_DPP(v, 0x141, 0xf);
    v = WS_DPP(v, 0x140, 0xf);
    v = WS_DPP(v, 0x142, 0xa);
    v = WS_DPP(v, 0x143, 0xc);
    return __builtin_bit_cast(float, __builtin_amdgcn_readlane(__builtin_bit_cast(int, v), 63));
}
__device__ __forceinline__ float xor32_f(float x, int lane) { const unsigned u = __builtin_bit_cast(unsigned, x); const auto r = __builtin_amdgcn_permlane32_swap(u, u, false, false);
    return __builtin_bit_cast(float, lane < 32 ? r[1] : r[0]); }
__device__ __forceinline__ float xor16_f(float x, int lane) { const unsigned u = __builtin_bit_cast(unsigned, x); const auto r = __builtin_amdgcn_permlane16_swap(u, u, false, false);
    return __builtin_bit_cast(float, (lane & 16) ? r[0] : r[1]); }
typedef __bf16 bf16x2_hw __attribute__((ext_vector_type(2)));
__device__ __forceinline__ unsigned pk2(float lo, float hi) { const v2f v = {lo, hi}; return __builtin_bit_cast(unsigned, __builtin_convertvector(v, bf16x2_hw)); }
__device__ __forceinline__ unsigned f2bf(float f) { return pk2(f, 0.f) & 0xffffu; }
__device__ __forceinline__ float bf2f(bf16 b) { return __builtin_bit_cast(float, (unsigned)b << 16); }
__device__ __forceinline__ float bflo(unsigned w) { return __builtin_bit_cast(float, w << 16); }
__device__ __forceinline__ float bfhi(unsigned w) { return __builtin_bit_cast(float, w & 0xffff0000u); }
__device__ __forceinline__ int seq_row0(int q) { return q < NB ? q * LP : TP + (q - NB); }
__device__ __forceinline__ int seq_len(int q) { return q < NB ? LP : 1; }

namespace pg8 {
#define PG8_LAS __attribute__((address_space(3)))
typedef unsigned short bf16_t;
typedef short bf16x8 __attribute__((ext_vector_type(8)));
typedef float f32x4 __attribute__((ext_vector_type(4)));
typedef unsigned u32x4 __attribute__((ext_vector_type(4)));
constexpr int BM = 256, BK = 64, HALF = 128, HTB = HALF * BK * 2  , STAGE_BYTES = 8 * HTB, NXCD = 8, WGM = 4;

__host__ __device__ __forceinline__ int lds_byte(int r, int c) { const int st = (r >> 4) * 2 + (c >> 5), rr = r & 15, cc = c & 31, ob = rr * 64 + cc * 2; return st * 1024 + (ob ^ (((ob >> 9) & 1) << 5)); }
__host__ __device__ __forceinline__ void stage_rc(int b, int& R, int& C) { const int st = b / 1024, sb = b % 1024, swz = sb ^ (((sb >> 9) & 1) << 5); R = (st >> 1) * 16 + swz / 64; C = (st & 1) * 32 + (swz % 64) / 2; }
__host__ __device__ __forceinline__ int perm32(int rho) { const int n = rho >> 4, i = rho & 15; return 8 * (i >> 2) + 4 * n + (i & 3); }

struct Unit { int pm, pn; };
struct Gemm { const bf16_t* A; const bf16_t* Bt; int M, N, K; };

struct StaticOrder {
    int nM, nN, nwg, G, c;
    __host__ __device__ void init(int M, int N, int G_, int c_) { nM = M / BM; nN = N / BM; nwg = nM * nN; G = G_; c = c_; }
    __host__ __device__ bool next(int i, Unit& u) const {
        const long L = (long)i * G + c; if (L >= nwg) return false;
        int wgid = (int)L; { const int q = nwg / NXCD, r = nwg % NXCD, xcd = wgid % NXCD, off = wgid / NXCD; wgid = (xcd < r ? xcd * (q + 1) : r * (q + 1) + (xcd - r) * q) + off; }
        const int nig = WGM * nN, gid = wgid / nig, fm = gid * WGM, gsz = (nM - fm) < WGM ? (nM - fm) : WGM;
        u.pm = fm + ((wgid % nig) % gsz); u.pn = (wgid % nig) / gsz; return true;
    }
    __device__ __forceinline__ void a_ready(const Unit&) const {}
    __device__ __forceinline__ void done(const Unit&) const {}
};
__device__ __forceinline__ unsigned cvt_pk_bf16(float lo, float hi) { return ::pk2(lo, hi); }

template <class Epi, class Sched, bool ALIGN_EPI = false, bool SP2 = false>
__device__ __forceinline__ void gemm_phase(PG8_LAS unsigned char* lds, const Gemm g, const Sched& S, const Epi& E) {
    int tid_ = threadIdx.x; asm volatile("" : "+v"(tid_));
    const int tid = tid_, wid = __builtin_amdgcn_readfirstlane(tid >> 6), lane = tid & 63, wr = wid >> 2, wc = wid & 3, fr = lane & 15, fq = lane >> 4;
    const int K = g.K, nt = K / BK;
    unsigned voffA[2], voffB[2];
#pragma unroll
    for (int i = 0; i < 2; ++i) { int R, C; stage_rc(tid * 16 + i * 8192, R, C); const int Rb = Epi::PERM ? ((R & ~31) + perm32(R & 31)) : R;
        voffA[i] = (unsigned)(R * K + C) * 2u; voffB[i] = (unsigned)(Rb * K + C) * 2u; }
    const size_t kstep = (size_t)(BK * 2);
    const size_t hstep = (size_t)HALF * K * 2;
    const size_t tstep = 2 * hstep;
    const unsigned ldsw = (unsigned)wid * 1024u;
    const int aoff = lds_byte(wr * 64 + fr, fq * 8), boff = lds_byte(wc * 32 + fr, fq * 8);
#define PG8_SA(b, h) (((b) * 2 + (h)) * HTB)
#define PG8_SB(b, h) ((4 + (b) * 2 + (h)) * HTB)
#define PG8_STAGE(bufoff, gbase, voff) do { _Pragma("unroll") for (int _i = 0; _i < 2; ++_i) \
        __builtin_amdgcn_global_load_lds((const unsigned*)((const char*)(gbase) + (voff)[_i]), (PG8_LAS unsigned*)(lds + (bufoff) + ldsw + _i * 8192), 16, 0, 0); } while (0)
#define PG8_LDA(dst, b, h) do { _Pragma("unroll") for (int m = 0; m < 4; ++m) _Pragma("unroll") for (int k = 0; k < 2; ++k) dst[m][k] = *(const PG8_LAS bf16x8*)(lds + PG8_SA(b, h) + aoff + m * 2048 + k * 1024); } while (0)
#define PG8_LDB(dst, b, h) do { _Pragma("unroll") for (int n = 0; n < 2; ++n) _Pragma("unroll") for (int k = 0; k < 2; ++k) dst[n][k] = *(const PG8_LAS bf16x8*)(lds + PG8_SB(b, h) + boff + n * 2048 + k * 1024); } while (0)
#define PG8_MMA(ai, bj, At, Bt) do { __builtin_amdgcn_s_setprio(1); _Pragma("unroll") for (int m = 0; m < 4; ++m) _Pragma("unroll") for (int n = 0; n < 2; ++n) _Pragma("unroll") for (int k = 0; k < 2; ++k) \
        acc[ai][bj][m][n] = __builtin_amdgcn_mfma_f32_16x16x32_bf16(Bt[n][k], At[m][k], acc[ai][bj][m][n], 0, 0, 0); __builtin_amdgcn_s_setprio(0); } while (0)
#define PG8_WAIT_V(n) asm volatile("s_waitcnt vmcnt(" #n ")" ::: "memory")
#define PG8_WAIT_L(n) asm volatile("s_waitcnt lgkmcnt(" #n ")" ::: "memory")
#define PG8_BAR __builtin_amdgcn_s_barrier()
#define PG8_SCHED __builtin_amdgcn_sched_barrier(0)
    Unit cur, nxt; int ui = 0;
    if (!S.next(0, cur)) return;
    f32x4 acc[2][2][4][2];
#pragma unroll
    for (int a = 0; a < 2; ++a)
#pragma unroll
        for (int b = 0; b < 2; ++b)
#pragma unroll
            for (int m = 0; m < 4; ++m)
#pragma unroll
                for (int n = 0; n < 2; ++n) acc[a][b][m][n] = (f32x4){0.f, 0.f, 0.f, 0.f};
    bf16x8 At[4][2], B0[2][2], B1[2][2];
    const char* cA = (const char*)g.A + (size_t)cur.pm * tstep; const char* cB = (const char*)g.Bt + (size_t)cur.pn * tstep;
    S.a_ready(cur);
    if constexpr (SP2) {
        PG8_STAGE(PG8_SB(0, 0), cB, voffB); PG8_STAGE(PG8_SB(0, 1), cB + hstep, voffB); PG8_STAGE(PG8_SA(0, 0), cA, voffA); PG8_STAGE(PG8_SA(0, 1), cA + hstep, voffA);
        if (wr == 1) PG8_BAR;
        PG8_WAIT_V(2); PG8_BAR;
        PG8_STAGE(PG8_SB(1, 0), cB + kstep, voffB); PG8_STAGE(PG8_SA(1, 0), cA + kstep, voffA); PG8_STAGE(PG8_SB(1, 1), cB + hstep + kstep, voffB);
        PG8_WAIT_V(6); PG8_BAR;
    } else {
        PG8_STAGE(PG8_SB(0, 0), cB, voffB); PG8_STAGE(PG8_SA(0, 0), cA, voffA); PG8_STAGE(PG8_SB(0, 1), cB + hstep, voffB); PG8_STAGE(PG8_SA(0, 1), cA + hstep, voffA);
        if (wr == 1) PG8_BAR;
        PG8_WAIT_V(4); PG8_BAR;
        PG8_STAGE(PG8_SB(1, 0), cB + kstep, voffB); PG8_STAGE(PG8_SA(1, 0), cA + kstep, voffA); PG8_STAGE(PG8_SB(1, 1), cB + hstep + kstep, voffB);
        PG8_WAIT_V(6); PG8_BAR;
    }
    for (;;) {
        const bool has_next = S.next(ui + 1, nxt);
        const char* nA = has_next ? (const char*)g.A + (size_t)nxt.pm * tstep : cA; const char* nB = has_next ? (const char*)g.Bt + (size_t)nxt.pn * tstep : cB;
        for (int t = 0; t < nt; t += 2) {
            const bool last = (t == nt - 2);
            const char* a1 = cA + (size_t)(t + 1) * kstep;
            const char* a2 = last ? nA : cA + (size_t)(t + 2) * kstep; const char* b2 = last ? nB : cB + (size_t)(t + 2) * kstep;
            const char* a3 = a2 + kstep; const char* b3 = b2 + kstep;
            if (last && has_next) S.a_ready(nxt);
            if constexpr (SP2) {
            PG8_LDB(B0, 0, 0); PG8_LDB(B1, 0, 1); PG8_SCHED; PG8_LDA(At, 0, 0); PG8_STAGE(PG8_SA(1, 1), a1 + hstep, voffA);
            PG8_WAIT_V(8); PG8_WAIT_L(0); PG8_BAR; PG8_MMA(0, 0, At, B0); PG8_MMA(0, 1, At, B1); PG8_BAR; PG8_SCHED;
            PG8_LDA(At, 0, 1); PG8_STAGE(PG8_SB(0, 0), b2, voffB); PG8_STAGE(PG8_SB(0, 1), b2 + hstep, voffB); PG8_STAGE(PG8_SA(0, 0), a2, voffA);
            PG8_WAIT_V(8); PG8_WAIT_L(0); PG8_BAR; PG8_MMA(1, 0, At, B0); PG8_MMA(1, 1, At, B1); PG8_BAR; PG8_SCHED;
            PG8_LDB(B0, 1, 0); PG8_LDB(B1, 1, 1); PG8_SCHED; PG8_LDA(At, 1, 0); PG8_STAGE(PG8_SA(0, 1), a2 + hstep, voffA);
            PG8_WAIT_V(8); PG8_WAIT_L(0); PG8_BAR; PG8_MMA(0, 0, At, B0); PG8_MMA(0, 1, At, B1); PG8_BAR; PG8_SCHED;
            PG8_LDA(At, 1, 1); PG8_STAGE(PG8_SB(1, 0), b3, voffB); PG8_STAGE(PG8_SB(1, 1), b3 + hstep, voffB); PG8_STAGE(PG8_SA(1, 0), a3, voffA);
            PG8_WAIT_V(8); PG8_WAIT_L(0); PG8_BAR; PG8_MMA(1, 0, At, B0); PG8_MMA(1, 1, At, B1); PG8_BAR; PG8_SCHED;
            } else {
            PG8_LDB(B0, 0, 0); PG8_SCHED; PG8_LDA(At, 0, 0); PG8_STAGE(PG8_SA(1, 1), a1 + hstep, voffA);
            PG8_WAIT_L(8); PG8_BAR; PG8_WAIT_L(0); PG8_MMA(0, 0, At, B0); PG8_BAR; PG8_SCHED;
            PG8_LDB(B1, 0, 1); PG8_STAGE(PG8_SB(0, 0), b2, voffB);
            PG8_BAR; PG8_WAIT_L(0); PG8_MMA(0, 1, At, B1); PG8_BAR;
            PG8_LDA(At, 0, 1); PG8_STAGE(PG8_SA(0, 0), a2, voffA);
            PG8_BAR; PG8_WAIT_L(0); PG8_MMA(1, 0, At, B0); PG8_BAR; PG8_SCHED;
            PG8_STAGE(PG8_SB(0, 1), b2 + hstep, voffB);
            PG8_WAIT_V(6); PG8_BAR; PG8_MMA(1, 1, At, B1); PG8_BAR;
            PG8_LDB(B0, 1, 0); PG8_SCHED; PG8_LDA(At, 1, 0); PG8_STAGE(PG8_SA(0, 1), a2 + hstep, voffA);
            PG8_WAIT_L(8); PG8_BAR; PG8_WAIT_L(0); PG8_MMA(0, 0, At, B0); PG8_BAR; PG8_SCHED;
            PG8_LDB(B1, 1, 1); PG8_STAGE(PG8_SB(1, 0), b3, voffB);
            PG8_BAR; PG8_WAIT_L(0); PG8_MMA(0, 1, At, B1); PG8_BAR;
            PG8_LDA(At, 1, 1); PG8_STAGE(PG8_SA(1, 0), a3, voffA);
            PG8_BAR; PG8_WAIT_L(0); PG8_MMA(1, 0, At, B0); PG8_BAR; PG8_SCHED;
            PG8_STAGE(PG8_SB(1, 1), b3 + hstep, voffB);
            PG8_WAIT_V(6); PG8_BAR; PG8_MMA(1, 1, At, B1); PG8_BAR;
            }
        }
        if constexpr (ALIGN_EPI) { if (wr == 0) PG8_BAR; }
        if constexpr (!Epi::AFTER_DRAIN) { E(acc, cur, wr, wc, fr, fq); if (SUBREP & 2048) asm volatile("s_waitcnt vmcnt(0)" ::: "memory"); if (SUBREP & 1024) { asm volatile("" ::: "memory"); E(acc, cur, wr, wc, fr, fq); } S.done(cur); }
        if (!has_next) break;
#pragma unroll
        for (int a = 0; a < 2; ++a)
#pragma unroll
            for (int b = 0; b < 2; ++b)
#pragma unroll
                for (int m = 0; m < 4; ++m)
#pragma unroll
                    for (int n = 0; n < 2; ++n) acc[a][b][m][n] = (f32x4){0.f, 0.f, 0.f, 0.f};
        cur = nxt; cA = nA; cB = nB; ++ui;
        if constexpr (ALIGN_EPI) { if (wr == 1) PG8_BAR; }
    }
    PG8_WAIT_V(0);
    if constexpr (!ALIGN_EPI) { if (wr == 0) PG8_BAR; }
    PG8_BAR;
    if constexpr (Epi::AFTER_DRAIN) { E.fused(acc, cur, wr, wc, fr, fq, lds, wid, lane); S.done(cur); }
#undef PG8_SA
#undef PG8_SB
#undef PG8_STAGE
#undef PG8_LDA
#undef PG8_LDB
#undef PG8_MMA
#undef PG8_WAIT_V
#undef PG8_WAIT_L
#undef PG8_BAR
#undef PG8_SCHED
}
}

namespace pg8 {
#define EPI_STORE16(p, v) (*(u32x4*)(p) = (v))
struct EpiSsdIn {
    static constexpr bool PERM = true, AFTER_DRAIN = false;
    bf16_t* ZX; float* DT; const float* rs;
    __device__ __forceinline__ void elem(int r, int c, float v) const { if (c < ZXW) ZX[(size_t)r * ZXW + c] = (bf16_t)f2bf(v); else DT[(size_t)r * 32 + (c - ZXW)] = v; }
    __device__ __forceinline__ void operator()(const f32x4 (&acc)[2][2][4][2], const Unit& u, int wr, int wc, int fr, int fq) const {
        const int row0 = u.pm * BM + wr * 64 + fr;
        if (u.pn < 24) {
            const int col0 = u.pn * BM + wc * 32 + 8 * fq;
#pragma unroll
            for (int ai = 0; ai < 2; ++ai)
#pragma unroll
                for (int m = 0; m < 4; ++m) { const int r = row0 + ai * HALF + m * 16; bf16_t* rowp = ZX + (size_t)r * ZXW + col0;
#pragma unroll
                    for (int bj = 0; bj < 2; ++bj) { const f32x4 v0 = acc[ai][bj][m][0], v1 = acc[ai][bj][m][1];
                        u32x4 w; w.x = cvt_pk_bf16(v0[0], v0[1]); w.y = cvt_pk_bf16(v0[2], v0[3]); w.z = cvt_pk_bf16(v1[0], v1[1]); w.w = cvt_pk_bf16(v1[2], v1[3]);
                        EPI_STORE16(rowp + bj * HALF, w); } }
        } else if (wc == 0) {
#pragma unroll
            for (int ai = 0; ai < 2; ++ai)
#pragma unroll
                for (int m = 0; m < 4; ++m) { const int r = row0 + ai * HALF + m * 16; float* p = DT + (size_t)r * 32 + 8 * fq;
                    *(f32x4*)p = acc[ai][0][m][0]; *(f32x4*)(p + 4) = acc[ai][0][m][1]; }
        }
    }
};
struct EpiLruIn {
    static constexpr bool PERM = true, AFTER_DRAIN = false;
    bf16_t* G; bf16_t* XRAW; const float* rs; const float* bias;
    __device__ __forceinline__ void elem(int r, int c, float v) const { v = v + bias[c]; if (c < DR) G[(size_t)r * DR + c] = (bf16_t)f2bf(gelu_tanh_f(v)); else XRAW[(size_t)r * DR + (c - DR)] = (bf16_t)f2bf(v); }
    __device__ __forceinline__ void operator()(const f32x4 (&acc)[2][2][4][2], const Unit& u, int wr, int wc, int fr, int fq) const {
        const int row0 = u.pm * BM + wr * 64 + fr, bcol0 = u.pn * BM + wc * 32 + 8 * fq; const bool gate = u.pn < 4;
        bf16_t* base = gate ? G : XRAW; const int col0 = (gate ? bcol0 : bcol0 - DR);
        f32x4 bv[2][2];
#pragma unroll
        for (int bj = 0; bj < 2; ++bj)
#pragma unroll
            for (int n = 0; n < 2; ++n) bv[bj][n] = *(const f32x4*)(bias + bcol0 + bj * HALF + 4 * n);
#pragma unroll
        for (int ai = 0; ai < 2; ++ai)
#pragma unroll
            for (int m = 0; m < 4; ++m) { const int r = row0 + ai * HALF + m * 16; bf16_t* rowp = base + (size_t)r * DR + col0;
#pragma unroll
                for (int bj = 0; bj < 2; ++bj) { f32x4 v0 = acc[ai][bj][m][0] + bv[bj][0], v1 = acc[ai][bj][m][1] + bv[bj][1];
                    if (gate) {
#pragma unroll
                        for (int j = 0; j < 4; ++j) { v0[j] = gelu_tanh_f(v0[j]); v1[j] = gelu_tanh_f(v1[j]); } }
                    u32x4 w; w.x = cvt_pk_bf16(v0[0], v0[1]); w.y = cvt_pk_bf16(v0[2], v0[3]); w.z = cvt_pk_bf16(v1[0], v1[1]); w.w = cvt_pk_bf16(v1[2], v1[3]);
                    EPI_STORE16(rowp + bj * HALF, w); } }
    }
};
struct EpiFfn1 {
    static constexpr bool PERM = true, AFTER_DRAIN = false;
    bf16_t* H1; const float* rs;
    __device__ __forceinline__ void elem(int r, int c, float v) const { v = fmaxf(v, 0.f); H1[(size_t)r * DFF + c] = (bf16_t)f2bf(v * v); }
    __device__ __forceinline__ void operator()(const f32x4 (&acc)[2][2][4][2], const Unit& u, int wr, int wc, int fr, int fq) const {
        const int row0 = u.pm * BM + wr * 64 + fr, col0 = u.pn * BM + wc * 32 + 8 * fq;
#pragma unroll
        for (int ai = 0; ai < 2; ++ai)
#pragma unroll
            for (int m = 0; m < 4; ++m) { const int r = row0 + ai * HALF + m * 16; bf16_t* rowp = H1 + (size_t)r * DFF + col0;
#pragma unroll
                for (int bj = 0; bj < 2; ++bj) { f32x4 v0 = acc[ai][bj][m][0], v1 = acc[ai][bj][m][1];
#pragma unroll
                    for (int j = 0; j < 4; ++j) { v0[j] = fmaxf(v0[j], 0.f); v0[j] *= v0[j]; v1[j] = fmaxf(v1[j], 0.f); v1[j] *= v1[j]; }
                    u32x4 w; w.x = cvt_pk_bf16(v0[0], v0[1]); w.y = cvt_pk_bf16(v0[2], v0[3]); w.z = cvt_pk_bf16(v1[0], v1[1]); w.w = cvt_pk_bf16(v1[2], v1[3]);
                    EPI_STORE16(rowp + bj * HALF, w); } }
    }
};
struct EpiM {
    static constexpr bool PERM = true, AFTER_DRAIN = false;
    bf16_t* C; const float* bias;
    __device__ __forceinline__ void elem(int r, int c, float v) const { C[(size_t)r * DM + c] = (bf16_t)f2bf(v + (bias ? bias[c] : 0.f)); }
    __device__ __forceinline__ void operator()(const f32x4 (&acc)[2][2][4][2], const Unit& u, int wr, int wc, int fr, int fq) const {
        const int row0 = u.pm * BM + wr * 64 + fr, col0 = u.pn * BM + wc * 32 + 8 * fq;
        f32x4 bv[2][2];
#pragma unroll
        for (int bj = 0; bj < 2; ++bj)
#pragma unroll
            for (int n = 0; n < 2; ++n) bv[bj][n] = bias ? *(const f32x4*)(bias + col0 + bj * HALF + 4 * n) : (f32x4){0.f, 0.f, 0.f, 0.f};
#pragma unroll
        for (int ai = 0; ai < 2; ++ai)
#pragma unroll
            for (int m = 0; m < 4; ++m) { bf16_t* rowp = C + (size_t)(row0 + ai * HALF + m * 16) * DM + col0;
#pragma unroll
                for (int bj = 0; bj < 2; ++bj) { const f32x4 v0 = acc[ai][bj][m][0] + bv[bj][0], v1 = acc[ai][bj][m][1] + bv[bj][1];
                    u32x4 w; w.x = cvt_pk_bf16(v0[0], v0[1]); w.y = cvt_pk_bf16(v0[2], v0[3]); w.z = cvt_pk_bf16(v1[0], v1[1]); w.w = cvt_pk_bf16(v1[2], v1[3]);
                    EPI_STORE16(rowp + bj * HALF, w); } }
    }
};
}

constexpr int NWAVES = 8, NTHR = 512;
constexpr int RING_BYTES = 131072, LDS_BYTES = 153600;
constexpr int LDS_MISC_OFF = 152576;
constexpr int CW_BAR = 4096;
#ifndef TOUCH_W
#define TOUCH_W 0
#endif
#ifndef REP_MASK
#define REP_MASK 0
#endif
constexpr int PL = 9, NPH = 1 + 4 * PL;

struct Args { const float* in[N_IN]; float* out; unsigned char* ws; int ph_lo, ph_hi; };
__device__ __forceinline__ const float* arg_in(int k) {
    const auto ka = __builtin_amdgcn_kernarg_segment_ptr();
    unsigned long long p;
    asm volatile("s_load_dwordx2 %0, %1, %2\n\ts_waitcnt lgkmcnt(0)" : "=s"(p) : "s"(ka), "s"(k * 8) : "memory");
    return (const float*)p;
}

constexpr int TP_PITCH = 68, TP_WAVE_BYTES = 64 * TP_PITCH * 4;
__device__ __forceinline__ void p0_transpose_item(const float* W, int ldw, int N, int nblk, bf16* WT, int ldt, int row_off, const float* scale, LAS float* scr, int item, int lane) {
    const int kb = item / nblk, nb = item % nblk, k0 = 64 * kb, n0 = 64 * nb, c4 = 4 * (lane & 15), rq = lane >> 4;
    v4f v[16];
#pragma unroll
    for (int i = 0; i < 16; ++i) v[i] = (n0 + c4 < N) ? *(const GAS v4f*)(W + (size_t)(k0 + 4 * i + rq) * ldw + n0 + c4) : (v4f){0.f, 0.f, 0.f, 0.f};
#pragma unroll
    for (int i = 0; i < 16; ++i) { const float sc = scale ? scale[k0 + 4 * i + rq] : 1.f; *(LAS v4f*)(scr + (4 * i + rq) * TP_PITCH + c4) = v[i] * sc; }
    LDS_WAIT(); asm volatile("" ::: "memory");
    const int c = lane & 7;
#pragma unroll
    for (int jj = 0; jj < 8; ++jj) { const int n = (lane >> 3) + 8 * jj; const LAS float* sp = scr + (8 * c) * TP_PITCH + n;
        v4u o; o.x = pk2(sp[0 * TP_PITCH], sp[1 * TP_PITCH]); o.y = pk2(sp[2 * TP_PITCH], sp[3 * TP_PITCH]); o.z = pk2(sp[4 * TP_PITCH], sp[5 * TP_PITCH]); o.w = pk2(sp[6 * TP_PITCH], sp[7 * TP_PITCH]);
        if (n0 + n < N) *(GAS v4u*)(WT + (size_t)(row_off + n0 + n) * ldt + k0 + 8 * c) = o; }
    LDS_WAIT(); asm volatile("" ::: "memory");
}
constexpr int IT_SIN = (DM / 64) * ((INDIM + 63) / 64), IT_SOUT = (DI / 64) * (DM / 64), IT_LIN = (DM / 64) * (2048 / 64), IT_LAX = 8 * 2 * 4, IT_LOUT = (DR / 64) * (DM / 64),
              IT_F1 = (DM / 64) * (DFF / 64), IT_F2 = (DFF / 64) * (DM / 64), IT_PAIR = IT_SIN + IT_SOUT + IT_LIN + IT_LAX + IT_LOUT + 2 * (IT_F1 + IT_F2);

__device__ __forceinline__ void p0_prologue(const Args& a, LAS unsigned char* lds, int gw, int NGW, int wave, int lane) {
    bf16* WB = (bf16*)(a.ws + WS_W);
    LAS float* scr = (LAS float*)(lds + wave * TP_WAVE_BYTES);
    for (int it = gw; it < 2 * IT_PAIR; it += NGW) {
        const int j = it / IT_PAIR; int r = it % IT_PAIR;
        bf16* ws_ssd = WB + WE_SSD0 + (size_t)j * WE_SEND; bf16* ws_lru = WB + WE_LRU0 + (size_t)j * WE_LEND;
        if (r < IT_SIN) { p0_transpose_item(arg_in(I_SWIN) + (size_t)j * DM * INDIM, INDIM, INDIM, (INDIM + 63) / 64, ws_ssd + WE_SIN, DM, 0, arg_in(I_NMPRE) + (size_t)(2 * j) * DM, scr, r, lane); continue; } r -= IT_SIN;
        if (r < IT_SOUT) { p0_transpose_item(arg_in(I_SWOUT) + (size_t)j * DI * DM, DM, DM, DM / 64, ws_ssd + WE_SOUT, DI, 0, arg_in(I_SNORM) + (size_t)j * DI, scr, r, lane); continue; } r -= IT_SOUT;
        if (r < IT_LIN) { p0_transpose_item(arg_in(I_LWIN) + (size_t)j * DM * 2048, 2048, 2048, 2048 / 64, ws_lru + WE_LIN, DM, 0, arg_in(I_NMPRE) + (size_t)(2 * j + 1) * DM, scr, r, lane); continue; } r -= IT_LIN;
        if (r < IT_LAX) { const int blk = r >> 3, mat = (r >> 2) & 1, sub = r & 3;
            p0_transpose_item(arg_in(mat ? I_LWX : I_LWA) + ((size_t)j * 8 + blk) * 128 * 128, 128, 128, 2, ws_lru + WE_LAX + (size_t)blk * 256 * 128, 128, mat * 128, nullptr, scr, sub, lane); continue; } r -= IT_LAX;
        if (r < IT_LOUT) { p0_transpose_item(arg_in(I_LWOUT) + (size_t)j * DR * DM, DM, DM, DM / 64, ws_lru + WE_LOUT, DR, 0, nullptr, scr, r, lane); continue; } r -= IT_LOUT;
        const int f = r / (IT_F1 + IT_F2), i = 2 * j + f; r -= f * (IT_F1 + IT_F2);
        bf16* ws_ffn = WB + WE_FFN0 + (size_t)i * WE_FEND;
        if (r < IT_F1) { p0_transpose_item(arg_in(I_W1) + (size_t)i * DM * DFF, DFF, DFF, DFF / 64, ws_ffn + WE_F1, DM, 0, arg_in(I_NFPRE) + (size_t)i * DM, scr, r, lane); continue; } r -= IT_F1;
        p0_transpose_item(arg_in(I_W2) + (size_t)i * DFF * DM, DM, DM, DM / 64, ws_ffn + WE_F2, DFF, 0, nullptr, scr, r, lane);
    }
    for (int idx = gw * 64 + lane; idx < 2 * (NPAD_SSD - INDIM) * DM / 8; idx += NGW * 64) { const int j = idx / ((NPAD_SSD - INDIM) * DM / 8), o = idx % ((NPAD_SSD - INDIM) * DM / 8);
        ((GAS v4u*)(WB + WE_SSD0 + (size_t)j * WE_SEND + WE_SIN + (size_t)INDIM * DM))[o] = (v4u){0u, 0u, 0u, 0u}; }
    for (int idx = gw * 64 + lane; idx < 2 * DR; idx += NGW * 64) ((float*)(a.ws + WS_LCF))[idx] = 8.0f * softplus_f(-arg_in(I_LLAM)[idx]);
    float* X = (float*)(a.ws + WS_X); bf16* XB = (bf16*)(a.ws + WS_XB); float* RS = (float*)(a.ws + WS_RS);
    for (int r = gw; r < T; r += NGW) {
        const float* src;
        if (r < TP) { const int b = r / LP, t = r % LP; src = t < NMETA ? arg_in(I_META) + (size_t)t * DM : arg_in(I_XP) + ((size_t)b * SEQ + (t - NMETA)) * DM; }
        else src = arg_in(I_XS) + (size_t)(r - TP) * DM;
        v4f v[4]; float s = 0.f;
#pragma unroll
        for (int j = 0; j < 4; ++j) { v[j] = ((const GAS v4f*)src)[lane + 64 * j]; s += (v[j].x * v[j].x + v[j].y * v[j].y) + (v[j].z * v[j].z + v[j].w * v[j].w); }
        const float msx = wave_sum(s) * (1.f / DM) + EPS, rsx = rsqrtf(msx);
        if (lane == 0) RS[r] = sqrtf(msx);
#pragma unroll
        for (int j = 0; j < 4; ++j) {
            ((GAS v2u*)(XB + (size_t)r * DM))[lane + 64 * j] = (v2u){pk2(v[j].x * rsx, v[j].y * rsx), pk2(v[j].z * rsx, v[j].w * rsx)}; }
    }
}
__device__ __forceinline__ void resid_phase(const Args& a, const float* g, bool last, int gw, int NGW, int lane) {
    bf16* XB = (bf16*)(a.ws + WS_XB); float* RS = (float*)(a.ws + WS_RS); const bf16* Mb = (const bf16*)(a.ws + WS_M);
    v4f gg[4];
#pragma unroll
    for (int j = 0; j < 4; ++j) gg[j] = ((const GAS v4f*)g)[lane + 64 * j];
    v2u mwn[4], xwn[4]; float invn = 0.f;
    if (gw < T) { invn = RS[gw];
#pragma unroll
        for (int j = 0; j < 4; ++j) { mwn[j] = ((const GAS v2u*)(Mb + (size_t)gw * DM))[lane + 64 * j]; xwn[j] = ((const GAS v2u*)(XB + (size_t)gw * DM))[lane + 64 * j]; } }
    for (int r = gw; r < T; r += NGW) {
        v4f m[4], x[4]; float s = 0.f; const float inv = invn;
#pragma unroll
        for (int j = 0; j < 4; ++j) { m[j] = (v4f){bflo(mwn[j].x), bfhi(mwn[j].x), bflo(mwn[j].y), bfhi(mwn[j].y)};
            x[j] = (v4f){bflo(xwn[j].x), bfhi(xwn[j].x), bflo(xwn[j].y), bfhi(xwn[j].y)} * inv;
            s += (m[j].x * m[j].x + m[j].y * m[j].y) + (m[j].z * m[j].z + m[j].w * m[j].w); }
        if (r + NGW < T) { invn = RS[r + NGW];
#pragma unroll
            for (int j = 0; j < 4; ++j) { mwn[j] = ((const GAS v2u*)(Mb + (size_t)(r + NGW) * DM))[lane + 64 * j]; xwn[j] = ((const GAS v2u*)(XB + (size_t)(r + NGW) * DM))[lane + 64 * j]; } }
        const float rm = rsqrtf(wave_sum(s) * (1.f / DM) + EPS); float s2 = 0.f;
#pragma unroll
        for (int j = 0; j < 4; ++j) { x[j] = x[j] + m[j] * rm * gg[j]; s2 += (x[j].x * x[j].x + x[j].y * x[j].y) + (x[j].z * x[j].z + x[j].w * x[j].w); }
        s2 = wave_sum(s2);
        if (!last) {
            const float msx = s2 * (1.f / DM) + EPS, rsx = rsqrtf(msx);
            if (lane == 0) RS[r] = sqrtf(msx);
#pragma unroll
            for (int j = 0; j < 4; ++j) ((GAS v2u*)(XB + (size_t)r * DM))[lane + 64 * j] = (v2u){pk2(x[j].x * rsx, x[j].y * rsx), pk2(x[j].z * rsx, x[j].w * rsx)};
        } else {
            float* dst = nullptr;
            if (r < TP) { const int b = r / LP, t = r % LP; if (t >= NMETA) dst = a.out + O_YP + ((size_t)b * SEQ + (t - NMETA)) * DM; }
            else dst = a.out + O_YS + (size_t)(r - TP) * DM;
            if (dst) {
#pragma unroll
                for (int j = 0; j < 4; ++j) ((GAS v4f*)dst)[lane + 64 * j] = x[j]; }
        }
    }
}


#ifndef SUBREP
#define SUBREP 0
#endif
typedef short bf16x8 __attribute__((ext_vector_type(8)));
typedef short bf16x4 __attribute__((ext_vector_type(4)));
constexpr int NCH = 17, N_CITEMS = NB * NCH * NG;
constexpr int YSP = 264;
constexpr int XS = 136;
constexpr size_t SC_CST = 0;
constexpr size_t SC_HPREV = SC_CST + (size_t)NB * NCH * NH * HD * NST * 2;
constexpr size_t SC_DEC = SC_HPREV + (size_t)NB * NCH * NH * HD * NST * 2;
constexpr size_t SC_XC = SC_DEC + 65536;
constexpr size_t SC_BC = SC_XC + (size_t)N_CITEMS * 256 * 128 * 2;
constexpr size_t SC_END = SC_BC + (size_t)N_CITEMS * 2 * 128 * 128 * 2;
static_assert(SC_END <= 400 * MiB, "ssd scratch");

struct SsdItem { int b, c, g, Q, row0; };
__device__ __forceinline__ SsdItem ssd_item(int item) { SsdItem it; it.g = item % NG;
    if (item < NB * 16 * NG) { it.c = 1 + (item / NG) % 16; it.b = item / (NG * 16); } else { it.c = 0; it.b = (item - NB * 16 * NG) / NG; }
    it.Q = it.c == 0 ? NMETA : 128; it.row0 = it.b * LP + (it.c == 0 ? 0 : NMETA + 128 * (it.c - 1)); return it; }

struct DtRaw { float r0, r1; };
__device__ __forceinline__ DtRaw ssd_dt_load(const float* DT, int row0, int Q, int h, int lane) { DtRaw d; d.r0 = 0.f; d.r1 = 0.f;
    if (lane < Q) d.r0 = DT[(size_t)(row0 + lane) * 32 + h];
    if (lane + 64 < Q) d.r1 = DT[(size_t)(row0 + lane + 64) * 32 + h];
    return d; }
__device__ __forceinline__ float ssd_dt_finish(const DtRaw dr, int Q, float dtb, float Aneg, LAS float* dtl, LAS float* csl, int lane) {
    float d0 = 0.f, d1 = 0.f;
    if (lane < Q) d0 = softplus_f(dr.r0 + dtb);
    if (lane + 64 < Q) d1 = softplus_f(dr.r1 + dtb);
    float a0 = d0 * Aneg, a1 = d1 * Aneg;
#pragma unroll
    for (int o = 1; o < 64; o <<= 1) { const float t0 = __shfl_up(a0, o), t1 = __shfl_up(a1, o); if (lane >= o) { a0 += t0; a1 += t1; } }
    const float tot0 = __shfl(a0, 63); a1 += tot0;
    const float tot = __shfl(a1, 63);
    dtl[lane] = d0; dtl[lane + 64] = d1; csl[lane] = a0; csl[lane + 64] = a1;
    return tot;
}
__device__ __forceinline__ float ssd_dt_cs(const float* DT, int row0, int Q, int h, float dtb, float Aneg, LAS float* dtl, LAS float* csl, int lane) {
    return ssd_dt_finish(ssd_dt_load(DT, row0, Q, h, lane), Q, dtb, Aneg, dtl, csl, lane); }


__device__ __forceinline__ float bf_elem(const v4u& w, int k) { const unsigned x = k < 2 ? w.x : k < 4 ? w.y : k < 6 ? w.z : w.w; return (k & 1) ? bfhi(x) : bflo(x); }
#define XT_SWZ(row) (((row) >> 4) & 7)
template <bool ROWMAJOR>
__device__ __forceinline__ void ssd_conv_lane(const bf16* src  , bool hasprev, const float* cw, const float* cb, int cc, LAS bf16* dst, int s0, int swz, float* cso  , int Q) {
    v4u raw[19];
#pragma unroll
    for (int i = 0; i < 3; ++i) { const v4u t = *(const GAS v4u*)(src + (ptrdiff_t)(hasprev ? i - 3 : 0) * ZXW); raw[i] = hasprev ? t : (v4u){0u, 0u, 0u, 0u}; }
#pragma unroll
    for (int i = 0; i < 16; ++i) raw[3 + i] = *(const GAS v4u*)(src + (size_t)i * ZXW);
    v4f wv[4][2], bv[2];
#pragma unroll
    for (int t = 0; t < 4; ++t) { wv[t][0] = *(const GAS v4f*)(cw + (size_t)t * CONVD + cc); wv[t][1] = *(const GAS v4f*)(cw + (size_t)t * CONVD + cc + 4); }
    bv[0] = *(const GAS v4f*)(cb + cc); bv[1] = *(const GAS v4f*)(cb + cc + 4);
    if (cso) {
#pragma unroll
        for (int i = 0; i < 3; ++i) { float* o = cso + (size_t)i * CONVD + cc; const v4u w = raw[16 + i];
            *(GAS v4f*)o = (v4f){bflo(w.x), bfhi(w.x), bflo(w.y), bfhi(w.y)}; *(GAS v4f*)(o + 4) = (v4f){bflo(w.z), bfhi(w.z), bflo(w.w), bfhi(w.w)}; } }
#define RAW2(i) ((v2f){bf_elem(raw[i], k), bf_elem(raw[i], k + 1)})
#define CW2(t) ((v2f){wv[t][k >> 2][k & 3], wv[t][k >> 2][(k & 3) + 1]})
    if (!ROWMAJOR) {
        const int c0 = s0 >> 3;
#pragma unroll
        for (int kp = 0; kp < 4; ++kp) { const int k = 2 * kp;
            const v2f w0 = CW2(0), w1 = CW2(1), w2 = CW2(2), w3 = CW2(3), bb = (v2f){bv[k >> 2][k & 3], bv[k >> 2][(k & 3) + 1]};
            v2f x0 = RAW2(0), x1 = RAW2(1), x2 = RAW2(2);
            unsigned pa[4], pb[4]; v2f pv = (v2f){0.f, 0.f}; LAS bf16* d0 = dst + k * XS; LAS bf16* d1 = d0 + XS;
#pragma unroll
            for (int i = 0; i < 16; ++i) { const v2f x3 = RAW2(3 + i);
                const v2f t = bb + w0 * x0 + w1 * x1 + w2 * x2 + w3 * x3;
                v2f e; e.x = __expf(-t.x); e.y = __expf(-t.y); e = e + 1.0f;
                v2f rr; rr.x = __builtin_amdgcn_rcpf(e.x); rr.y = __builtin_amdgcn_rcpf(e.y);
                const v2f v = t * rr;
                if (i & 1) { pa[(i >> 1) & 3] = pg8::cvt_pk_bf16(pv.x, v.x); pb[(i >> 1) & 3] = pg8::cvt_pk_bf16(pv.y, v.y);
                    if ((i & 7) == 7) { const int co = 8 * ((c0 + (i >> 3)) ^ swz); *(LAS v4u*)(d0 + co) = (v4u){pa[0], pa[1], pa[2], pa[3]}; *(LAS v4u*)(d1 + co) = (v4u){pb[0], pb[1], pb[2], pb[3]}; } } else pv = v;
                x0 = x1; x1 = x2; x2 = x3; }
            if (Q < 32) { const int z0 = 8 * ((c0 + 2) ^ swz), z1 = 8 * ((c0 + 3) ^ swz);
                *(LAS v4u*)(d0 + z0) = (v4u){0u, 0u, 0u, 0u}; *(LAS v4u*)(d0 + z1) = (v4u){0u, 0u, 0u, 0u}; *(LAS v4u*)(d1 + z0) = (v4u){0u, 0u, 0u, 0u}; *(LAS v4u*)(d1 + z1) = (v4u){0u, 0u, 0u, 0u}; }
            __builtin_amdgcn_sched_barrier(0); }
    } else {
        v2f xa[4], xb[4], xc[4];
#pragma unroll
        for (int kp = 0; kp < 4; ++kp) { const int k = 2 * kp; xa[kp] = RAW2(0); xb[kp] = RAW2(1); xc[kp] = RAW2(2); }
#pragma unroll
        for (int i = 0; i < 16; ++i) { unsigned o[4];
#pragma unroll
            for (int kp = 0; kp < 4; ++kp) { const int k = 2 * kp; const v2f x3 = RAW2(3 + i);
                const v2f t = (v2f){bv[k >> 2][k & 3], bv[k >> 2][(k & 3) + 1]} + CW2(0) * xa[kp] + CW2(1) * xb[kp] + CW2(2) * xc[kp] + CW2(3) * x3;
                v2f e; e.x = __expf(-t.x); e.y = __expf(-t.y); e = e + 1.0f;
                v2f rr; rr.x = __builtin_amdgcn_rcpf(e.x); rr.y = __builtin_amdgcn_rcpf(e.y);
                const v2f v = t * rr; o[kp] = pg8::cvt_pk_bf16(v.x, v.y);
                xa[kp] = xb[kp]; xb[kp] = xc[kp]; xc[kp] = x3; }
            *(LAS v4u*)(dst + i * XS) = (v4u){o[0], o[1], o[2], o[3]};
            if ((i & 3) == 3) __builtin_amdgcn_sched_barrier(0); }
    }
#undef CW2
#undef RAW2
}
__device__ __forceinline__ void ssd_conv_lane_bc(const bf16* src, bool hasprev, const float* cw, const float* cb, int cc, bf16* gdst  , bool toT,
                                                 LAS bf16* dstT  , int s0, int swz, float* cso  , int Q) {
    v4u raw[19];
#pragma unroll
    for (int i = 0; i < 3; ++i) { const v4u t = *(const GAS v4u*)(src + (ptrdiff_t)(hasprev ? i - 3 : 0) * ZXW); raw[i] = hasprev ? t : (v4u){0u, 0u, 0u, 0u}; }
#pragma unroll
    for (int i = 0; i < 16; ++i) raw[3 + i] = *(const GAS v4u*)(src + (size_t)i * ZXW);
    v4f wv[4][2], bv[2];
#pragma unroll
    for (int t = 0; t < 4; ++t) { wv[t][0] = *(const GAS v4f*)(cw + (size_t)t * CONVD + cc); wv[t][1] = *(const GAS v4f*)(cw + (size_t)t * CONVD + cc + 4); }
    bv[0] = *(const GAS v4f*)(cb + cc); bv[1] = *(const GAS v4f*)(cb + cc + 4);
    if (cso) {
#pragma unroll
        for (int i = 0; i < 3; ++i) { float* o = cso + (size_t)i * CONVD + cc; const v4u w = raw[16 + i];
            *(GAS v4f*)o = (v4f){bflo(w.x), bfhi(w.x), bflo(w.y), bfhi(w.y)}; *(GAS v4f*)(o + 4) = (v4f){bflo(w.z), bfhi(w.z), bflo(w.w), bfhi(w.w)}; } }
#define RAW2(i) ((v2f){bf_elem(raw[i], k), bf_elem(raw[i], k + 1)})
#define CW2(t) ((v2f){wv[t][k >> 2][k & 3], wv[t][k >> 2][(k & 3) + 1]})
    const int c0 = s0 >> 3;
    v2f xa[4], xb[4], xc[4], pv[4];
    unsigned pw[8][4];
#pragma unroll
    for (int kp = 0; kp < 4; ++kp) { const int k = 2 * kp; xa[kp] = RAW2(0); xb[kp] = RAW2(1); xc[kp] = RAW2(2); pv[kp] = (v2f){0.f, 0.f}; }
#pragma unroll
    for (int i = 0; i < 16; ++i) { unsigned o[4];
#pragma unroll
        for (int kp = 0; kp < 4; ++kp) { const int k = 2 * kp; const v2f x3 = RAW2(3 + i);
            const v2f t = (v2f){bv[k >> 2][k & 3], bv[k >> 2][(k & 3) + 1]} + CW2(0) * xa[kp] + CW2(1) * xb[kp] + CW2(2) * xc[kp] + CW2(3) * x3;
            v2f e; e.x = __expf(-t.x); e.y = __expf(-t.y); e = e + 1.0f;
            v2f rr; rr.x = __builtin_amdgcn_rcpf(e.x); rr.y = __builtin_amdgcn_rcpf(e.y);
            const v2f v = t * rr; o[kp] = pg8::cvt_pk_bf16(v.x, v.y);
            if (i & 1) { pw[k][(i >> 1) & 3] = pg8::cvt_pk_bf16(pv[kp].x, v.x); pw[k + 1][(i >> 1) & 3] = pg8::cvt_pk_bf16(pv[kp].y, v.y); } else pv[kp] = v;
            xa[kp] = xb[kp]; xb[kp] = xc[kp]; xc[kp] = x3; }
        *(GAS v4u*)(gdst + (size_t)i * 128) = (v4u){o[0], o[1], o[2], o[3]};
        if ((i & 7) == 7 && toT) { const int co = 8 * ((c0 + (i >> 3)) ^ swz);
#pragma unroll
            for (int ch = 0; ch < 8; ++ch) *(LAS v4u*)(dstT + ch * XS + co) = (v4u){pw[ch][0], pw[ch][1], pw[ch][2], pw[ch][3]}; }
        if ((i & 3) == 3) __builtin_amdgcn_sched_barrier(0); }
    if (Q < 32 && toT) { const int z0 = 8 * ((c0 + 2) ^ swz), z1 = 8 * ((c0 + 3) ^ swz);
#pragma unroll
        for (int ch = 0; ch < 8; ++ch) { *(LAS v4u*)(dstT + ch * XS + z0) = (v4u){0u, 0u, 0u, 0u}; *(LAS v4u*)(dstT + ch * XS + z1) = (v4u){0u, 0u, 0u, 0u}; } }
#undef CW2
#undef RAW2
}
__device__ __forceinline__ void ssd_conv_tile_a(const bf16* ZX, int row0, int g, int Q, bool hasprev, const float* cw, const float* cb, LAS bf16* XT, LAS bf16* BT, bf16* gBC,
                                                float* cso_base, int lane, int wave) {
    const int cg = lane & 31, rh = lane >> 5, wq = wave & 3, s0 = 32 * wq + 16 * rh; const bool isx = wave < 4;
    const bool active = s0 < Q;
    const int cc = isx ? 256 * g + 8 * cg : (cg < 16 ? DI + 128 * g + 8 * cg : DI + NG * NST + 128 * g + 8 * (cg - 16));
    const bf16* src = ZX + (size_t)(row0 + s0) * ZXW + DI + cc;
    float* cso = (cso_base && s0 + 16 == Q) ? cso_base : nullptr;
    if (isx) { if (active) ssd_conv_lane<false>(src, hasprev || s0 > 0, cw, cb, cc, XT + (8 * cg) * XS, s0, XT_SWZ(8 * cg), cso, Q); }
    else { if (active) ssd_conv_lane_bc(src, hasprev || s0 > 0, cw, cb, cc, gBC + (cg < 16 ? 0 : 128 * 128) + (size_t)s0 * 128 + 8 * (cg & 15), cg < 16, BT + (8 * (cg & 15)) * XS, s0, XT_SWZ(8 * (cg & 15)), cso, Q); }
}

__device__ __forceinline__ void ssd_phase_a(unsigned char* ws, float* out, LAS unsigned char* lds, int j, int tid, int lane, int wave) {
    const bf16* ZX = (const bf16*)(ws + WS_ZX); const float* DT = (const float*)(ws + WS_DT); bf16* YN = (bf16*)(ws + WS_YN);
    bf16* CST = (bf16*)(ws + WS_SCR + SC_CST); float* DEC = (float*)(ws + WS_SCR + SC_DEC); bf16* XC = (bf16*)(ws + WS_SCR + SC_XC); bf16* BC = (bf16*)(ws + WS_SCR + SC_BC);
    const float* cw = arg_in(I_SCW) + (size_t)j * 4 * CONVD; const float* cb = arg_in(I_SCB) + (size_t)j * CONVD;
    const float* dtbias = arg_in(I_SDTB) + j * NH; const float* alog = arg_in(I_SALOG) + j * NH; const float* dsk = arg_in(I_SD) + j * NH;
    LAS bf16* XWT = (LAS bf16*)lds;
    LAS bf16* BT = XWT + 256 * XS;
    LAS float* DTL = (LAS float*)(BT + 128 * XS);
    LAS float* CSL = DTL + 512;
    LAS float* WL = CSL + 512;
    const int tid0 = tid;
    const int n_all = N_CITEMS + NS * NG, n_ext = (SUBREP & 4) ? n_all + NS * NG : (SUBREP & 32) ? n_all + 1024 : n_all;
    for (int item_ = blockIdx.x; item_ < n_ext; item_ += gridDim.x) {
        const int item = item_ < n_all ? item_ : (SUBREP & 32) ? item_ - n_all : item_ - NS * NG;
        int tid = tid0; asm volatile("" : "+v"(tid));
        const int lane = tid & 63, fr = lane & 15, fq = lane >> 4;
        __syncthreads();
        if (item < N_CITEMS) {
            const SsdItem it = ssd_item(item); const int Q = it.Q;
            { float* cso = (it.c == NCH - 1) ? out + O_PSC + (((size_t)j * NB + it.b) * 3) * CONVD : nullptr;
              ssd_conv_tile_a(ZX, it.row0, it.g, Q, it.c > 0, cw, cb, XWT, BT, BC + (size_t)item * 2 * 128 * 128, cso, lane, wave); }
            if (wave >= 4) { const int hh = wave - 4, h = 4 * it.g + hh;
                const float tot = ssd_dt_cs(DT, it.row0, Q, h, dtbias[h], -__expf(alog[h]), DTL + hh * 128, CSL + hh * 128, lane);
                LDS_WAIT();
                WL[hh * 128 + lane] = DTL[hh * 128 + lane] * __expf(tot - CSL[hh * 128 + lane]);
                WL[hh * 128 + lane + 64] = DTL[hh * 128 + lane + 64] * __expf(tot - CSL[hh * 128 + lane + 64]);
                if (lane == 0) DEC[(it.b * NCH + it.c) * NH + h] = __expf(tot); }
            __syncthreads();
            { bf16* xg = XC + (size_t)item * 256 * 128 + (size_t)(32 * wave) * 128;
#pragma unroll
              for (int i = 0; i < 8; ++i) { const int rr = 4 * i + (lane >> 4), c16 = lane & 15;
                  *(GAS v4u*)(xg + rr * 128 + 8 * c16) = *(const LAS v4u*)(XWT + (32 * wave + rr) * XS + 8 * c16); } }
            for (int rep_ = 0; rep_ < ((SUBREP & 2) ? 2 : 1); ++rep_) { asm volatile("" ::: "memory");
            pg8::f32x4 acc[2][8];
#pragma unroll
            for (int mi = 0; mi < 2; ++mi)
#pragma unroll
                for (int ni = 0; ni < 8; ++ni) acc[mi][ni] = (pg8::f32x4){0.f, 0.f, 0.f, 0.f};
            const int nkb = Q < 32 ? 1 : Q / 32;
            for (int kb = 0; kb < nkb; ++kb) {
                bf16x8 a[2], bq[8];
#pragma unroll
                for (int mi = 0; mi < 2; ++mi) a[mi] = *(const LAS bf16x8*)(XWT + (32 * wave + 16 * mi + fr) * XS + 8 * ((4 * kb + fq) ^ XT_SWZ(32 * wave + 16 * mi)));
                { const LAS float* wlp = WL + (wave >> 1) * 128 + 32 * kb + 8 * fq;
                  const v4f wa = *(const LAS v4f*)wlp, wb = *(const LAS v4f*)(wlp + 4);
#pragma unroll
                  for (int mi = 0; mi < 2; ++mi) { const v4u xa = __builtin_bit_cast(v4u, a[mi]);
                      a[mi] = __builtin_bit_cast(bf16x8, (v4u){pg8::cvt_pk_bf16(bflo(xa.x) * wa.x, bfhi(xa.x) * wa.y), pg8::cvt_pk_bf16(bflo(xa.y) * wa.z, bfhi(xa.y) * wa.w),
                                                               pg8::cvt_pk_bf16(bflo(xa.z) * wb.x, bfhi(xa.z) * wb.y), pg8::cvt_pk_bf16(bflo(xa.w) * wb.z, bfhi(xa.w) * wb.w)}); } }
#pragma unroll
                for (int ni = 0; ni < 8; ++ni) bq[ni] = *(const LAS bf16x8*)(BT + (16 * ni + fr) * XS + 8 * ((4 * kb + fq) ^ XT_SWZ(16 * ni)));
#pragma unroll
                for (int mi = 0; mi < 2; ++mi)
#pragma unroll
                    for (int ni = 0; ni < 8; ++ni) acc[mi][ni] = __builtin_amdgcn_mfma_f32_16x16x32_bf16(bq[ni], a[mi], acc[mi][ni], 0, 0, 0);
            }
            { LAS bf16* stg = XWT + (32 * wave) * XS;
#pragma unroll
              for (int mi = 0; mi < 2; ++mi)
#pragma unroll
                for (int ni = 0; ni < 8; ++ni) *(LAS v2u*)(stg + (16 * mi + fr) * XS + 16 * ni + 4 * fq) = (v2u){pg8::cvt_pk_bf16(acc[mi][ni][0], acc[mi][ni][1]), pg8::cvt_pk_bf16(acc[mi][ni][2], acc[mi][ni][3])};
              const int hp0 = 32 * wave, h = 4 * it.g + (hp0 >> 6), p0 = hp0 & 63;
              bf16* dstb = CST + ((((size_t)(it.b * NCH + it.c) * NH + h) * HD + p0) * NST);
#pragma unroll
              for (int i = 0; i < 8; ++i) { const int rr = 4 * i + (lane >> 4), c16 = lane & 15;
                  *(GAS v4u*)(dstb + rr * NST + 8 * c16) = *(const LAS v4u*)(stg + rr * XS + 8 * c16); } }
            }
        } else {
            const int si = (item - N_CITEMS) / NG, g = (item - N_CITEMS) % NG, row = TP + si;
            LAS float* xs = (LAS float*)lds; LAS float* Bsm = xs + 256; LAS float* Csm = Bsm + 128; LAS float* dtv = Csm + 128; LAS float* dAv = dtv + 4; LAS float* yv = dAv + 4;
            { const int cc = tid < 256 ? 256 * g + tid : (tid < 384 ? DI + 128 * g + (tid - 256) : DI + NG * NST + 128 * g + (tid - 384));
              const float* sp = arg_in(I_SSC) + (((size_t)j * NS + si) * 3) * CONVD + cc;
              const float s0 = sp[0], s1 = sp[CONVD], s2 = sp[2 * CONVD], x3 = bf2f(ZX[(size_t)row * ZXW + DI + cc]);
              const float v = silu_f(cb[cc] + cw[cc] * s0 + cw[CONVD + cc] * s1 + cw[2 * CONVD + cc] * s2 + cw[3 * CONVD + cc] * x3);
              xs[tid] = v;
              float* op = out + O_SSC + (((size_t)j * NS + si) * 3) * CONVD + cc; op[0] = s1; op[CONVD] = s2; op[2 * CONVD] = x3; }
            if (tid < 4) { const int h = 4 * g + tid; const float d = softplus_f(DT[(size_t)row * 32 + h] + dtbias[h]); dtv[tid] = d; dAv[tid] = __expf(-d * __expf(alog[h])); }
            __syncthreads();
            v2u zz_ = (v2u){0u, 0u}; if (wave == 0) zz_ = *(const GAS v2u*)(ZX + (size_t)row * ZXW + 256 * g + 4 * lane);
            { const int r = wave >> 1, h = 4 * g + r; const float d = dtv[r], dA = dAv[r], Dh = dsk[h];
              const v2f Bv = *(const LAS v2f*)(Bsm + 2 * lane), Cv = *(const LAS v2f*)(Csm + 2 * lane);
              const float* h0 = arg_in(I_SSH) + ((((size_t)j * NS + si) * NH + h) * HD + 32 * (wave & 1)) * NST; float* ho = out + O_SSH + ((((size_t)j * NS + si) * NH + h) * HD + 32 * (wave & 1)) * NST;
              LAS float* PR = (LAS float*)(lds + 8192) + wave * (32 * 65);
              v2f hv[32];
#pragma unroll
              for (int pp = 0; pp < 32; ++pp) hv[pp] = *(const GAS v2f*)(h0 + (size_t)pp * NST + 2 * lane);
#pragma unroll
              for (int pp = 0; pp < 32; ++pp) { const float xdt = xs[64 * r + 32 * (wave & 1) + pp] * d;
                  hv[pp].x = fmaf(hv[pp].x, dA, xdt * Bv.x); hv[pp].y = fmaf(hv[pp].y, dA, xdt * Bv.y);
                  *(GAS v2f*)(ho + (size_t)pp * NST + 2 * lane) = hv[pp];
                  PR[pp * 65 + lane] = Cv.x * hv[pp].x + Cv.y * hv[pp].y; }
              LDS_WAIT();
              if (lane < 32) { float y = 0.f;
#pragma unroll 16
                  for (int k = 0; k < 64; ++k) y += PR[lane * 65 + k];
                  const int p = 32 * (wave & 1) + lane; yv[64 * r + p] = y + Dh * xs[64 * r + p]; } }
            __syncthreads();
            if (wave == 0) { const int c0 = 256 * g + 4 * lane; const v2u zz = zz_;
                const v4f y = *(const LAS v4f*)(yv + 4 * lane);
                const float v0 = y.x * silu_f(bflo(zz.x)), v1 = y.y * silu_f(bfhi(zz.x)), v2 = y.z * silu_f(bflo(zz.y)), v3 = y.w * silu_f(bfhi(zz.y));
                const float rs = rsqrtf(wave_sum(v0 * v0 + v1 * v1 + v2 * v2 + v3 * v3) * (1.f / 256.f) + EPS);
                *(GAS v2u*)(YN + (size_t)row * DI + c0) = (v2u){pk2(v0 * rs, v1 * rs), pk2(v2 * rs, v3 * rs)}; }
        }
    }
}

__device__ __forceinline__ void ssd_phase_b(unsigned char* ws, float* out, int j, int tid) {
    const bf16* CST = (const bf16*)(ws + WS_SCR + SC_CST); const float* DEC = (const float*)(ws + WS_SCR + SC_DEC); bf16* HPREV = (bf16*)(ws + WS_SCR + SC_HPREV);
    constexpr int PER_B = NH * HD * NST / 8;
    for (int idx = blockIdx.x * NTHR + tid; idx < NB * PER_B; idx += gridDim.x * NTHR) {
        const int b = idx / PER_B, e = (idx % PER_B) * 8, h = e / (HD * NST);
        v4f H0 = (v4f){0.f, 0.f, 0.f, 0.f}, H1 = H0;
#pragma unroll 4
        for (int c = 0; c < NCH; ++c) {
            const size_t off = (size_t)(b * NCH + c) * (NH * HD * NST) + e;
            if (c > 0) *(GAS v4u*)(HPREV + off) = (v4u){pk2(H0.x, H0.y), pk2(H0.z, H0.w), pk2(H1.x, H1.y), pk2(H1.z, H1.w)};
            const float dec = DEC[(b * NCH + c) * NH + h];
            const v4u sw = *(const GAS v4u*)(CST + off); const v4f s0 = (v4f){bflo(sw.x), bfhi(sw.x), bflo(sw.y), bfhi(sw.y)}, s1 = (v4f){bflo(sw.z), bfhi(sw.z), bflo(sw.w), bfhi(sw.w)};
            H0 = H0 * dec + s0; H1 = H1 * dec + s1;
        }
        float* op = out + O_PSH + ((size_t)j * NB + b) * (NH * HD * NST) + e;
        *(GAS v4f*)op = H0; *(GAS v4f*)(op + 4) = H1;
    }
}

__device__ __forceinline__ void ssd_phase_c(unsigned char* ws, float* out, LAS unsigned char* lds, int j, int tid0, int, int wave) {
    const bf16* ZX = (const bf16*)(ws + WS_ZX); const float* DT = (const float*)(ws + WS_DT); bf16* YN = (bf16*)(ws + WS_YN);
    const bf16* HPREV = (const bf16*)(ws + WS_SCR + SC_HPREV); const bf16* XC = (const bf16*)(ws + WS_SCR + SC_XC); const bf16* BC = (const bf16*)(ws + WS_SCR + SC_BC);
    const float* dtbias = arg_in(I_SDTB) + j * NH; const float* alog = arg_in(I_SALOG) + j * NH; const float* dsk = arg_in(I_SD) + j * NH;
    LAS bf16* XT = (LAS bf16*)lds;
    LAS bf16* Bs = XT + 256 * XS;
    LAS bf16* Cs = Bs + 128 * XS;
    LAS float* DTL = (LAS float*)(Cs + 128 * XS);
    LAS float* CSL = DTL + 512;
    for (int item = blockIdx.x; item < N_CITEMS; item += gridDim.x) {
        const SsdItem it = ssd_item(item); const int Q = it.Q;
        int tid = tid0; asm volatile("" : "+v"(tid));
        const int lane = tid & 63, fr = lane & 15, fq = lane >> 4;
        __syncthreads();
        { const bf16* xg = XC + (size_t)item * 256 * 128; const bf16* bg = BC + (size_t)item * 2 * 128 * 128;
          DtRaw dr; dr.r0 = 0.f; dr.r1 = 0.f; const int hq = 4 * it.g + (wave & 3);
          if (wave < 4) dr = ssd_dt_load(DT, it.row0, Q, hq, lane);
          const int lr = tid >> 4, lc = tid & 15;
          v4u tx[8], tb[4], tc[4];
#pragma unroll
          for (int i = 0; i < 8; ++i) tx[i] = *(const GAS v4u*)(xg + (size_t)(32 * i + lr) * 128 + 8 * lc);
#pragma unroll
          for (int i = 0; i < 4; ++i) { const int r = 32 * i + lr; const bool ok = r < Q; const size_t ro = (size_t)(ok ? r : 0) * 128 + 8 * lc;
              const v4u b_ = *(const GAS v4u*)(bg + ro), c_ = *(const GAS v4u*)(bg + 128 * 128 + ro);
              tb[i] = ok ? b_ : (v4u){0u, 0u, 0u, 0u}; tc[i] = ok ? c_ : (v4u){0u, 0u, 0u, 0u}; }
          if (wave < 4) (void)ssd_dt_finish(dr, Q, dtbias[hq], -__expf(alog[hq]), DTL + wave * 128, CSL + wave * 128, lane);
#pragma unroll
          for (int i = 0; i < 8; ++i) *(LAS v4u*)(XT + (32 * i + lr) * XS + 8 * lc) = tx[i];
#pragma unroll
          for (int i = 0; i < 4; ++i) { *(LAS v4u*)(Bs + (32 * i + lr) * XS + 8 * lc) = tb[i]; *(LAS v4u*)(Cs + (32 * i + lr) * XS + 8 * lc) = tc[i]; } }
        __syncthreads();
        const int l0 = 16 * wave, nlt = Q / 16;
        pg8::f32x4 ST[8];
        if (l0 < Q) {
            bf16x8 cf[4];
#pragma unroll
            for (int kb = 0; kb < 4; ++kb) cf[kb] = *(const LAS bf16x8*)(Cs + (l0 + fr) * XS + 32 * kb + 8 * fq);
#pragma unroll
            for (int t = 0; t < 8; ++t) { ST[t] = (pg8::f32x4){0.f, 0.f, 0.f, 0.f};
                if (t <= wave) {
#pragma unroll
                    for (int kb = 0; kb < 4; ++kb) { const bf16x8 bfrag = *(const LAS bf16x8*)(Bs + (16 * t + fr) * XS + 32 * kb + 8 * fq);
                        ST[t] = __builtin_amdgcn_mfma_f32_16x16x32_bf16(bfrag, cf[kb], ST[t], 0, 0, 0); } } }
        }
        __syncthreads();
        LAS bf16* CBL = Bs;
        if (l0 < Q) {
#pragma unroll
            for (int t = 0; t < 8; ++t) if (t <= wave) *(LAS v2u*)(CBL + (l0 + fr) * XS + 16 * t + 4 * fq) = (v2u){pk2(ST[t][0], ST[t][1]), pk2(ST[t][2], ST[t][3])};
        }
        const int r = wave >> 1, ph = wave & 1, h = 4 * it.g + r, hp0 = 64 * r + 32 * ph;
        const bool hasprev = it.c > 0;
        bf16x8 hf[2][4];
        if (hasprev) { const bf16* hpb = HPREV + ((((size_t)(it.b * NCH + it.c) * NH + h) * HD) + 32 * ph + fr) * NST + 8 * fq;
#pragma unroll
            for (int pt = 0; pt < 2; ++pt)
#pragma unroll
                for (int kb = 0; kb < 4; ++kb) hf[pt][kb] = *(const GAS bf16x8*)(hpb + (size_t)(16 * pt) * NST + 32 * kb); }
        __syncthreads();
        const LAS float* csr = CSL + r * 128; const LAS float* dtr = DTL + r * 128; const float Dh = dsk[h];
        float csl[8];
#pragma unroll
        for (int u = 0; u < 8; ++u) csl[u] = csr[(16 * u + fr) & 127];
        pg8::f32x4 ay[2][8];
#pragma unroll
        for (int u = 0; u < 8; ++u) { ay[0][u] = (pg8::f32x4){0.f, 0.f, 0.f, 0.f}; ay[1][u] = ay[0][u]; }
        const int zl = lane >> 2, zck = lane & 3;
        const bf16* zb = ZX + (size_t)(it.row0 + zl) * ZXW + 256 * it.g + hp0 + 8 * zck;
        LAS unsigned char* stg = (LAS unsigned char*)(XT + hp0 * XS);
        const int stg_lin = zl * 64 + 16 * (zck ^ ((zl >> 2) & 3));
        const int stg_acc = fr * 64 + 8 * (fq & 1);
        const int stg_x = (fr >> 2) & 3, stg_c = fq >> 1;
#pragma unroll
        for (int kb = 0; kb < 4; ++kb) if (32 * kb < Q) {
            bf16x8 xf[2];
#pragma unroll
            for (int pt = 0; pt < 2; ++pt) xf[pt] = *(const LAS bf16x8*)(XT + (hp0 + 16 * pt + fr) * XS + 8 * ((4 * kb + fq) ^ XT_SWZ(hp0 + 16 * pt)));
            const v4f c0 = *(const LAS v4f*)(csr + 32 * kb + 8 * fq), c1 = *(const LAS v4f*)(csr + 32 * kb + 8 * fq + 4);
            const v4f d0 = *(const LAS v4f*)(dtr + 32 * kb + 8 * fq), d1 = *(const LAS v4f*)(dtr + 32 * kb + 8 * fq + 4);
            const float csv[8] = {c0.x, c0.y, c0.z, c0.w, c1.x, c1.y, c1.z, c1.w}, dtv[8] = {d0.x, d0.y, d0.z, d0.w, d1.x, d1.y, d1.z, d1.w};
#pragma unroll
            for (int u = 2 * kb; u < 8; ++u) if (u < nlt) {
                const v4u raw = *(const LAS v4u*)(CBL + (16 * u + fr) * XS + 32 * kb + 8 * fq);
                const float cbv[8] = {bflo(raw.x), bfhi(raw.x), bflo(raw.y), bfhi(raw.y), bflo(raw.z), bfhi(raw.z), bflo(raw.w), bfhi(raw.w)};
                const int lrow = 16 * u + fr; float e[8];
#pragma unroll
                for (int jj = 0; jj < 8; ++jj) { const int sidx = 32 * kb + 8 * fq + jj; e[jj] = (sidx <= lrow && sidx < Q) ? cbv[jj] * __expf(csl[u] - csv[jj]) * dtv[jj] : 0.f;
                    if (sidx == lrow) e[jj] += Dh; }
                const bf16x8 sf = __builtin_bit_cast(bf16x8, (v4u){pk2(e[0], e[1]), pk2(e[2], e[3]), pk2(e[4], e[5]), pk2(e[6], e[7])});
#pragma unroll
                for (int pt = 0; pt < 2; ++pt) ay[pt][u] = __builtin_amdgcn_mfma_f32_16x16x32_bf16(xf[pt], sf, ay[pt][u], 0, 0, 0);
            }
            __builtin_amdgcn_sched_barrier(0);
        }
        if (hasprev) {
#pragma unroll
            for (int u = 0; u < 8; ++u) { const float ecs = __expf(csl[u]); pg8::f32x4 ao0 = (pg8::f32x4){0.f, 0.f, 0.f, 0.f}, ao1 = ao0;
#pragma unroll
                for (int kb = 0; kb < 4; ++kb) { const bf16x8 cfr = *(const LAS bf16x8*)(Cs + (16 * u + fr) * XS + 32 * kb + 8 * fq);
                    ao0 = __builtin_amdgcn_mfma_f32_16x16x32_bf16(hf[0][kb], cfr, ao0, 0, 0, 0); ao1 = __builtin_amdgcn_mfma_f32_16x16x32_bf16(hf[1][kb], cfr, ao1, 0, 0, 0); }
                ay[0][u] = ay[0][u] + ao0 * ecs; ay[1][u] = ay[1][u] + ao1 * ecs; } }
        __builtin_amdgcn_sched_barrier(0);
        v2u zz[2][8];
        { v4u zr[8];
#pragma unroll
          for (int i = 0; i < 8; ++i) zr[i] = *(const GAS v4u*)(zb + (size_t)(16 * (i < nlt ? i : 0)) * ZXW);
#pragma unroll
          for (int i = 0; i < 8; ++i) *(LAS v4u*)(stg + 1024 * i + stg_lin) = zr[i]; }
#pragma unroll
        for (int u = 0; u < 8; ++u)
#pragma unroll
            for (int pt = 0; pt < 2; ++pt) zz[pt][u] = *(const LAS v2u*)(stg + 1024 * u + stg_acc + 16 * ((2 * pt + stg_c) ^ stg_x));
        float ssq[8];
#pragma unroll
        for (int u = 0; u < 8; ++u) { ssq[u] = 0.f; if (u < nlt) {
#pragma unroll
            for (int pt = 0; pt < 2; ++pt) { const v2u zw = zz[pt][u]; const float zf[4] = {bflo(zw.x), bfhi(zw.x), bflo(zw.y), bfhi(zw.y)};
#pragma unroll
                for (int q = 0; q < 4; ++q) { const float y = ay[pt][u][q] * silu_f(zf[q]); ay[pt][u][q] = y; ssq[u] += y * y; } }
            ssq[u] += xor16_f(ssq[u], lane); ssq[u] += xor32_f(ssq[u], lane); } }
        LAS float* SSQ = CSL + 512;
        if (fq == 0) {
#pragma unroll
            for (int u = 0; u < 8; ++u) if (u < nlt) SSQ[wave * 128 + 16 * u + fr] = ssq[u]; }
        __syncthreads();
        {
#pragma unroll
            for (int u = 0; u < 8; ++u) if (u < nlt) { float tsum = SSQ[(2 * fq) * 128 + 16 * u + fr] + SSQ[(2 * fq + 1) * 128 + 16 * u + fr];
                tsum += xor16_f(tsum, lane); tsum += xor32_f(tsum, lane);
                const float rs = rsqrtf(tsum * (1.f / 256.f) + EPS);
#pragma unroll
                for (int pt = 0; pt < 2; ++pt) *(LAS v2u*)(stg + 1024 * u + stg_acc + 16 * ((2 * pt + stg_c) ^ stg_x)) = (v2u){pk2(ay[pt][u][0] * rs, ay[pt][u][1] * rs), pk2(ay[pt][u][2] * rs, ay[pt][u][3] * rs)}; }
            bf16* yb = YN + (size_t)(it.row0 + zl) * DI + 256 * it.g + hp0 + 8 * zck;
#pragma unroll
            for (int i = 0; i < 8; ++i) if (i < nlt) *(GAS v4u*)(yb + (size_t)(16 * i) * DI) = *(const LAS v4u*)(stg + 1024 * i + stg_lin); }
    }
}


constexpr size_t SC_LSUM = 0;
constexpr size_t SC_LSUB = SC_LSUM + (size_t)NB * NCH * DR * 2 * 4;
constexpr size_t SC_LAB = SC_LSUB + (size_t)NB * NCH * 8 * DR * 2 * 4;
template <bool FINAL>
__device__ __forceinline__ void lru_phase(unsigned char* ws, float* out, LAS unsigned char* lds, int j, int tid0, int, int wave) {
    const bf16* G = (const bf16*)(ws + WS_ZX); const bf16* XRAW = G + (size_t)T * DR; bf16* YL = (bf16*)(ws + WS_YN);
    const bf16* WAX = (const bf16*)(ws + WS_W) + WE_LRU0 + (size_t)j * WE_LEND + WE_LAX;
    float* LSUM = (float*)(ws + WS_SCR + SC_LSUM); float* LSUB = (float*)(ws + WS_SCR + SC_LSUB); unsigned* LAB = (unsigned*)(ws + WS_SCR + SC_LAB); const float* LCF = (const float*)(ws + WS_LCF) + (size_t)j * DR;
    const float* cw = arg_in(I_LCW) + (size_t)j * 4 * DR; const float* cb = arg_in(I_LCB) + (size_t)j * DR;
    const float* ba = arg_in(I_LBA) + (size_t)j * DR; const float* bx = arg_in(I_LBX) + (size_t)j * DR;
    LAS bf16* WL = (LAS bf16*)lds;
    LAS bf16* XR = WL + 256 * XS;
    LAS bf16* GL = XR + 128 * XS;
    LAS float* WSUM = (LAS float*)(GL + 128 * XS);
    LAS float* CHC = WSUM + 8 * 128 * 2;
    const int nitems = FINAL ? N_CITEMS + 8 : N_CITEMS;
    int kb_staged = -1;
    bool srep_ = false;
    for (int item = blockIdx.x; item < nitems; item += gridDim.x) {
        int tid = tid0; asm volatile("" : "+v"(tid));
        const int lane = tid & 63, fr = lane & 15, fq = lane >> 4;
        const bool samp = item >= N_CITEMS;
        int b = 0, c = -1, kb, Q = 128, row0 = TP;
        if (!samp) { const SsdItem it = ssd_item(item); kb = it.g; c = it.c; b = it.b; Q = it.Q; row0 = it.row0; }
        else kb = item - N_CITEMS;
        if (FINAL && !samp) {
            const int c4 = tid & 31, rg = tid >> 5, nrg = Q / 8, r0 = 8 * rg, dg4 = kb * 128 + 4 * c4;
            LAS float* QS = (LAS float*)lds;
            LAS float* HINL = QS + 16 * 128 * 2;
            __syncthreads();
            v4u ab[8]; v2u gq[8];
            v2f cs_[NCH - 1];
            if (tid < 128) { const int dg = kb * 128 + tid;
#pragma unroll
                for (int cp = 0; cp < NCH - 1; ++cp) { const v2f t = *(const GAS v2f*)(LSUM + ((size_t)(b * NCH + (cp < c ? cp : 0)) * DR + dg) * 2); const float mk = cp < c ? 1.f : 0.f;
                    cs_[cp].x = 1.f + mk * (t.x - 1.f); cs_[cp].y = mk * t.y; } }
            { const int rr = rg < nrg ? r0 : 0;
              const unsigned* labp = LAB + (size_t)(row0 + rr) * DR + dg4; const bf16* gp = G + (size_t)(row0 + rr) * DR + dg4;
#pragma unroll
              for (int i = 0; i < 8; ++i) { ab[i] = *(const GAS v4u*)(labp + (size_t)i * DR); gq[i] = *(const GAS v2u*)(gp + (size_t)i * DR); } }
            if (tid < 128) { float h = 0.f;
#pragma unroll
                for (int cp = 0; cp < NCH - 1; ++cp) h = cs_[cp].x * h + cs_[cp].y;
                HINL[tid] = h; }
            float av[8][4]; v4f A4 = (v4f){1.f, 1.f, 1.f, 1.f}, H4 = (v4f){0.f, 0.f, 0.f, 0.f};
#pragma unroll
            for (int i = 0; i < 8; ++i) { const v4u w = ab[i];
                av[i][0] = __expf(bflo(w.x)); av[i][1] = __expf(bflo(w.y)); av[i][2] = __expf(bflo(w.z)); av[i][3] = __expf(bflo(w.w));
                const v4f a4 = (v4f){av[i][0], av[i][1], av[i][2], av[i][3]}, b4 = (v4f){bfhi(w.x), bfhi(w.y), bfhi(w.z), bfhi(w.w)};
                H4 = a4 * H4 + b4; A4 = A4 * a4; }
            if (rg < nrg) { *(LAS v4f*)(QS + (rg * 128 + 4 * c4) * 2) = (v4f){A4.x, H4.x, A4.y, H4.y}; *(LAS v4f*)(QS + (rg * 128 + 4 * c4) * 2 + 4) = (v4f){A4.z, H4.z, A4.w, H4.w}; }
            __syncthreads();
            if (rg < nrg) {
                v4f h4 = *(const LAS v4f*)(HINL + 4 * c4);
                for (int qq = 0; qq < rg; ++qq) { const v4f s0 = *(const LAS v4f*)(QS + (qq * 128 + 4 * c4) * 2), s1 = *(const LAS v4f*)(QS + (qq * 128 + 4 * c4) * 2 + 4);
                    h4 = (v4f){s0.x * h4.x + s0.y, s0.z * h4.y + s0.w, s1.x * h4.z + s1.y, s1.z * h4.w + s1.w}; }
                bf16* yp = YL + (size_t)(row0 + r0) * DR + dg4;
#pragma unroll
                for (int i = 0; i < 8; ++i) { const v4u w = ab[i]; const v4f a4 = (v4f){av[i][0], av[i][1], av[i][2], av[i][3]}, b4 = (v4f){bfhi(w.x), bfhi(w.y), bfhi(w.z), bfhi(w.w)};
                    h4 = a4 * h4 + b4;
                    const v4f g4 = (v4f){bflo(gq[i].x), bfhi(gq[i].x), bflo(gq[i].y), bfhi(gq[i].y)}, y4 = h4 * g4;
                    *(GAS v2u*)(yp + (size_t)i * DR) = (v2u){pk2(y4.x, y4.y), pk2(y4.z, y4.w)}; }
                if (c == NCH - 1 && rg == nrg - 1) *(GAS v4f*)(out + O_PLH + ((size_t)j * NB + b) * DR + dg4) = h4;
            }
            continue;
        }
        __syncthreads();
        if (kb != kb_staged) { const GAS v4u* src = (const GAS v4u*)(WAX + (size_t)kb * 256 * 128); v4u wv[8];
#pragma unroll
          for (int i = 0; i < 8; ++i) wv[i] = src[tid + NTHR * i];
#pragma unroll
          for (int i = 0; i < 8; ++i) { const int e = tid + NTHR * i; *(LAS v4u*)(WL + (e >> 4) * XS + 8 * (e & 15)) = wv[i]; }
          if (tid < 128) { CHC[tid] = LCF[kb * 128 + tid]; CHC[128 + tid] = ba[kb * 128 + tid]; CHC[256 + tid] = bx[kb * 128 + tid]; }
          kb_staged = kb; }
        v2f cs_[NCH - 1], ws_[7];
        const bool do_hin = FINAL && !samp && tid < 128;
        if (do_hin) {
#pragma unroll
            for (int cp = 0; cp < NCH - 1; ++cp) cs_[cp] = cp < c ? *(const GAS v2f*)(LSUM + ((size_t)(b * NCH + cp) * DR + kb * 128 + tid) * 2) : (v2f){1.f, 0.f};
#pragma unroll
            for (int ww = 0; ww < 7; ++ww) ws_[ww] = *(const GAS v2f*)(LSUB + (((size_t)(b * NCH + c) * 8 + ww) * DR + kb * 128 + tid) * 2); }
        v4u gv[4];
        if (FINAL) {
#pragma unroll
            for (int i = 0; i < 4; ++i) { const int e = tid + NTHR * i; if (e < Q * 16) gv[i] = *(const GAS v4u*)(G + (size_t)(row0 + (e >> 4)) * DR + kb * 128 + 8 * (e & 15)); } }
        for (int rp_ = 0; rp_ < ((!FINAL && (SUBREP & 64)) ? 2 : 1); ++rp_) { asm volatile("" ::: "memory");
        if (!samp) {
            const int c8 = tid & 15, rg = tid >> 4, s0 = 4 * rg, cc = kb * 128 + 8 * c8;
            if (s0 < Q) {
                const bf16* src = XRAW + (size_t)(row0 + s0) * DR + cc; const int tfirst = row0 - b * LP + s0;
                v4u raw[7];
#pragma unroll
                for (int i = 0; i < 3; ++i) { const bool ok = tfirst >= 3 - i; const v4u t = *(const GAS v4u*)(src + (ptrdiff_t)(ok ? i - 3 : 0) * DR); raw[i] = ok ? t : (v4u){0u, 0u, 0u, 0u}; }
#pragma unroll
                for (int i = 0; i < 4; ++i) raw[3 + i] = *(const GAS v4u*)(src + (size_t)i * DR);
                v4f wv[4][2], bv[2];
#pragma unroll
                for (int t = 0; t < 4; ++t) { wv[t][0] = *(const GAS v4f*)(cw + (size_t)t * DR + cc); wv[t][1] = *(const GAS v4f*)(cw + (size_t)t * DR + cc + 4); }
                bv[0] = *(const GAS v4f*)(cb + cc); bv[1] = *(const GAS v4f*)(cb + cc + 4);
                if (!FINAL && c == NCH - 1 && s0 + 4 == Q) { float* cso = out + O_PLC + (((size_t)j * NB + b) * 3) * DR + cc;
#pragma unroll
                    for (int i = 0; i < 3; ++i) { const v4u w = raw[4 + i]; float* o = cso + (size_t)i * DR;
                        *(GAS v4f*)o = (v4f){bflo(w.x), bfhi(w.x), bflo(w.y), bfhi(w.y)}; *(GAS v4f*)(o + 4) = (v4f){bflo(w.z), bfhi(w.z), bflo(w.w), bfhi(w.w)}; } }
                unsigned ow[4][4];
#pragma unroll
                for (int kp = 0; kp < 4; ++kp) { const int k = 2 * kp;
                    const v2f w0 = (v2f){wv[0][k >> 2][k & 3], wv[0][k >> 2][(k & 3) + 1]}, w1 = (v2f){wv[1][k >> 2][k & 3], wv[1][k >> 2][(k & 3) + 1]},
                              w2 = (v2f){wv[2][k >> 2][k & 3], wv[2][k >> 2][(k & 3) + 1]}, w3 = (v2f){wv[3][k >> 2][k & 3], wv[3][k >> 2][(k & 3) + 1]}, bb = (v2f){bv[k >> 2][k & 3], bv[k >> 2][(k & 3) + 1]};
#define RAW2(i) ((v2f){bf_elem(raw[i], k), bf_elem(raw[i], k + 1)})
                    v2f x0 = RAW2(0), x1 = RAW2(1), x2 = RAW2(2);
#pragma unroll
                    for (int i = 0; i < 4; ++i) { const v2f x3 = RAW2(3 + i); const v2f t = bb + w0 * x0 + w1 * x1 + w2 * x2 + w3 * x3; ow[i][kp] = pk2(t.x, t.y); x0 = x1; x1 = x2; x2 = x3; }
#undef RAW2
                }
#pragma unroll
                for (int i = 0; i < 4; ++i) *(LAS v4u*)(XR + (s0 + i) * XS + 8 * c8) = (v4u){ow[i][0], ow[i][1], ow[i][2], ow[i][3]};
            }
        } else {
            const int ch = tid & 127, sub = tid >> 7, cc = kb * 128 + ch, nr = Q / 4, s0 = sub * nr;
            const float w0 = cw[cc], w1 = cw[DR + cc], w2 = cw[2 * DR + cc], w3 = cw[3 * DR + cc], bias = cb[cc];
            {
                const float* spb = arg_in(I_SLC) + ((size_t)j * NS * 3) * DR + cc; float* opb = out + O_SLC + ((size_t)j * NS * 3) * DR + cc;
#pragma unroll 8
                for (int s = s0; s < s0 + nr; ++s) { const float* sp = spb + (size_t)s * 3 * DR;
                    const float q0 = sp[0], q1 = sp[DR], q2 = sp[2 * DR], x3 = bf2f(XRAW[(size_t)(TP + s) * DR + cc]);
                    XR[s * XS + ch] = (bf16)f2bf(bias + w0 * q0 + w1 * q1 + w2 * q2 + w3 * x3);
                    float* op = opb + (size_t)s * 3 * DR; op[0] = q1; op[DR] = q2; op[2 * DR] = x3; }
            }
        }
        }
        if (FINAL) {
#pragma unroll
            for (int i = 0; i < 4; ++i) { const int e = tid + NTHR * i; if (e < Q * 16) *(LAS v4u*)(GL + (e >> 4) * XS + 8 * (e & 15)) = gv[i]; } }
        if (do_hin) { float h = 0.f;
#pragma unroll
            for (int cp = 0; cp < NCH - 1; ++cp) h = cs_[cp].x * h + cs_[cp].y;
            WSUM[tid] = h;
#pragma unroll
            for (int ww = 0; ww < 7; ++ww) { h = ws_[ww].x * h + ws_[ww].y; WSUM[(ww + 1) * 128 + tid] = h; } }
        __syncthreads();
        const bool act = 16 * wave < Q; const int l0 = 16 * wave;
        if (act) {
            pg8::f32x4 acc[16];
            for (int rm_ = 0; rm_ < ((SUBREP & 128) ? 2 : 1); ++rm_) { asm volatile("" ::: "memory");
#pragma unroll
            for (int nt = 0; nt < 16; ++nt) acc[nt] = (pg8::f32x4){0.f, 0.f, 0.f, 0.f};
#pragma unroll
            for (int kk = 0; kk < 4; ++kk) { const bf16x8 af = *(const LAS bf16x8*)(XR + (l0 + fr) * XS + 32 * kk + 8 * fq);
#pragma unroll
                for (int nt = 0; nt < 16; ++nt) { const bf16x8 wf = *(const LAS bf16x8*)(WL + (16 * nt + fr) * XS + 32 * kk + 8 * fq);
                    acc[nt] = __builtin_amdgcn_mfma_f32_16x16x32_bf16(af, wf, acc[nt], 0, 0, 0); }
                __builtin_amdgcn_sched_barrier(0); }
            }
            if (samp) {
                if (FINAL) { const float* h0p = arg_in(I_SLH) + (size_t)j * NS * DR; float* hop = out + O_SLH + (size_t)j * NS * DR;
#pragma unroll 1
                    for (int nt = 0; nt < 8; ++nt) { const int d = 16 * nt + fr, dg = kb * 128 + d; const float cfac = CHC[d], bav = CHC[128 + d], bxv = CHC[256 + d];
                        const pg8::f32x4 ga = nt == 0 ? acc[0] : nt == 1 ? acc[1] : nt == 2 ? acc[2] : nt == 3 ? acc[3] : nt == 4 ? acc[4] : nt == 5 ? acc[5] : nt == 6 ? acc[6] : acc[7];
                        const pg8::f32x4 gx = nt == 0 ? acc[8] : nt == 1 ? acc[9] : nt == 2 ? acc[10] : nt == 3 ? acc[11] : nt == 4 ? acc[12] : nt == 5 ? acc[13] : nt == 6 ? acc[14] : acc[15];
#pragma unroll
                        for (int q = 0; q < 4; ++q) { const int l = l0 + 4 * fq + q;
                            const float rg = sigmoid_f(ga[q] + bav), ig = sigmoid_f(gx[q] + bxv), la = -cfac * rg, av = __expf(la), mult = __builtin_amdgcn_sqrtf(one_minus_exp2x(la, av));
                            const float bt = mult * ig * bf2f(XR[l * XS + d]);
                            const float h = av * h0p[(size_t)l * DR + dg] + bt; hop[(size_t)l * DR + dg] = h;
                            GL[l * XS + d] = (bf16)f2bf(h * bf2f(GL[l * XS + d])); } } }
            } else {
                for (int rg_ = 0; rg_ < ((!FINAL && (SUBREP & 256)) ? 2 : 1); ++rg_) { asm volatile("" ::: "memory");
#pragma unroll
                for (int nt = 0; nt < 8; ++nt) { const int d = 16 * nt + fr, dg = kb * 128 + d; const float cfac = CHC[d], bav = CHC[128 + d], bxv = CHC[256 + d];
                    float aq[4], bq[4], A = 1.f, H = 0.f;
#pragma unroll
                    for (int q = 0; q < 4; q += 2) { const int l = l0 + 4 * fq + q; v2f av2, bt2, la2;
                        lru_gate2((v2f){acc[nt][q], acc[nt][q + 1]}, (v2f){acc[nt + 8][q], acc[nt + 8][q + 1]}, bav, bxv, cfac, (v2f){bf2f(XR[l * XS + d]), bf2f(XR[(l + 1) * XS + d])}, av2, bt2, la2);
                        aq[q] = av2.x; aq[q + 1] = av2.y; bq[q] = bt2.x; bq[q + 1] = bt2.y;
                        H = av2.x * H + bt2.x; H = av2.y * H + bt2.y; A *= av2.x * av2.y;
                        if (!FINAL) { LAB[(size_t)(row0 + l) * DR + dg] = pk2(la2.x, bt2.x); LAB[(size_t)(row0 + l + 1) * DR + dg] = pk2(la2.y, bt2.y); } }
                    const float Ap = xor16_f(A, lane), Hp = xor16_f(H, lane);
                    const bool odd = (fq & 1) != 0;
                    const float AT = A * Ap, HT = odd ? A * Hp + H : Ap * H + Hp;
                    const float A01 = xor32_f(AT, lane), H01 = xor32_f(HT, lane);
                    const float Aex = fq == 0 ? 1.f : fq == 1 ? Ap : fq == 2 ? A01 : Ap * A01, Hex = fq == 0 ? 0.f : fq == 1 ? Hp : fq == 2 ? H01 : Ap * H01 + Hp;
                    if (!FINAL) { if (fq == 3) { const v2f tot = (v2f){A01 * AT, AT * H01 + HT};
                            *(LAS v2f*)(WSUM + (wave * 128 + d) * 2) = tot; } }
                    else { float h = Aex * WSUM[wave * 128 + d] + Hex;
#pragma unroll
                        for (int q = 0; q < 4; ++q) { const int l = l0 + 4 * fq + q; h = aq[q] * h + bq[q];
                            GL[l * XS + d] = (bf16)f2bf(h * bf2f(GL[l * XS + d]));
                            if (c == NCH - 1 && l == Q - 1) out[O_PLH + ((size_t)j * NB + b) * DR + dg] = h; } }
                    __builtin_amdgcn_sched_barrier(0); }
                }
            }
        }
        if (!FINAL) { __syncthreads();
            if (tid < 128) { float A = 1.f, H = 0.f; const int nw = Q / 16;
                for (int ww = 0; ww < nw; ++ww) { const v2f sm = *(const LAS v2f*)(WSUM + (ww * 128 + tid) * 2); H = sm.x * H + sm.y; A *= sm.x; }
                *(GAS v2f*)(LSUM + ((size_t)(b * NCH + c) * DR + kb * 128 + tid) * 2) = (v2f){A, H}; } }
        if (FINAL && act) { LDS_WAIT();
#pragma unroll
            for (int k = 0; k < 4; ++k) { const int ci = lane + 64 * k, rr = l0 + (ci >> 4), c16 = ci & 15;
                *(GAS v4u*)(YL + (size_t)(row0 + rr) * DR + kb * 128 + 8 * c16) = *(const LAS v4u*)(GL + rr * XS + 8 * c16); } }
        if (FINAL && (SUBREP & 16) && samp && !srep_) { srep_ = true; item -= gridDim.x; }
    }
}

__device__ __forceinline__ void lru_sample_item(unsigned char* ws, float* out, LAS unsigned char* lds, int j, int kb, int rgp, int tid, int wave) {
    const bf16* G = (const bf16*)(ws + WS_ZX); const bf16* XRAW = G + (size_t)T * DR; bf16* YL = (bf16*)(ws + WS_YN);
    const bf16* WAX = (const bf16*)(ws + WS_W) + WE_LRU0 + (size_t)j * WE_LEND + WE_LAX + (size_t)kb * 256 * 128;
    const float* LCF = (const float*)(ws + WS_LCF) + (size_t)j * DR;
    const float* cw = arg_in(I_LCW) + (size_t)j * 4 * DR; const float* cb = arg_in(I_LCB) + (size_t)j * DR;
    const float* ba = arg_in(I_LBA) + (size_t)j * DR; const float* bx = arg_in(I_LBX) + (size_t)j * DR;
    LAS bf16* XR = (LAS bf16*)(lds + 32768);
    LAS bf16* GLs = XR + 16 * XS;
    const int lane = tid & 63, fr = lane & 15, fq = lane >> 4, s0 = 16 * rgp, d = 16 * wave + fr, dg = kb * 128 + d;
    float h0v[4];
    { const float* h0p = arg_in(I_SLH) + (size_t)j * NS * DR;
#pragma unroll
      for (int q = 0; q < 4; ++q) h0v[q] = h0p[(size_t)(s0 + 4 * fq + q) * DR + dg]; }
    const float cfac = LCF[dg], bav = ba[dg], bxv = bx[dg];
    bf16x8 wa[4], wx[4];
#pragma unroll
    for (int kk = 0; kk < 4; ++kk) { wa[kk] = *(const GAS bf16x8*)(WAX + (size_t)(16 * wave + fr) * 128 + 32 * kk + 8 * fq); wx[kk] = *(const GAS bf16x8*)(WAX + (size_t)(128 + 16 * wave + fr) * 128 + 32 * kk + 8 * fq); }
    __syncthreads();
    { const int rr = tid >> 5, c4 = tid & 31, cc = kb * 128 + 4 * c4, s = s0 + rr;
      const float* sp = arg_in(I_SLC) + (((size_t)j * NS + s) * 3) * DR + cc; float* op = out + O_SLC + (((size_t)j * NS + s) * 3) * DR + cc;
      const v4f q0 = *(const GAS v4f*)sp, q1 = *(const GAS v4f*)(sp + DR), q2 = *(const GAS v4f*)(sp + 2 * DR);
      const v2u xr = *(const GAS v2u*)(XRAW + (size_t)(TP + s) * DR + cc), gg = *(const GAS v2u*)(G + (size_t)(TP + s) * DR + cc);
      const v4f w0 = *(const GAS v4f*)(cw + cc), w1 = *(const GAS v4f*)(cw + DR + cc), w2 = *(const GAS v4f*)(cw + 2 * DR + cc), w3 = *(const GAS v4f*)(cw + 3 * DR + cc), bb = *(const GAS v4f*)(cb + cc);
      const v4f x3 = (v4f){bflo(xr.x), bfhi(xr.x), bflo(xr.y), bfhi(xr.y)};
      const v4f t = bb + w0 * q0 + w1 * q1 + w2 * q2 + w3 * x3;
      *(GAS v4f*)op = q1; *(GAS v4f*)(op + DR) = q2; *(GAS v4f*)(op + 2 * DR) = x3;
      *(LAS v2u*)(XR + rr * XS + 4 * c4) = (v2u){pk2(t.x, t.y), pk2(t.z, t.w)};
      *(LAS v2u*)(GLs + rr * XS + 4 * c4) = gg; }
    __syncthreads();
    pg8::f32x4 aa = (pg8::f32x4){0.f, 0.f, 0.f, 0.f}, ax = aa;
#pragma unroll
    for (int kk = 0; kk < 4; ++kk) { const bf16x8 af = *(const LAS bf16x8*)(XR + fr * XS + 32 * kk + 8 * fq);
        aa = __builtin_amdgcn_mfma_f32_16x16x32_bf16(af, wa[kk], aa, 0, 0, 0); ax = __builtin_amdgcn_mfma_f32_16x16x32_bf16(af, wx[kk], ax, 0, 0, 0); }
    float* hop = out + O_SLH + (size_t)j * NS * DR;
#pragma unroll
    for (int q = 0; q < 4; ++q) { const int l = 4 * fq + q;
        const float rgt = sigmoid_f(aa[q] + bav), ig = sigmoid_f(ax[q] + bxv), la = -cfac * rgt, av = __expf(la), mult = __builtin_amdgcn_sqrtf(one_minus_exp2x(la, av));
        const float bt = mult * ig * bf2f(XR[l * XS + d]);
        const float h = av * h0v[q] + bt; hop[(size_t)(s0 + l) * DR + dg] = h;
        YL[(size_t)(TP + s0 + l) * DR + dg] = (bf16)f2bf(h * bf2f(GLs[l * XS + d])); }
}

__device__ __forceinline__ void lru_phase_b(unsigned char* ws, float* out, LAS unsigned char* lds, int j, int tid0, int wave) {
    const bf16* G = (const bf16*)(ws + WS_ZX); bf16* YL = (bf16*)(ws + WS_YN);
    const float* LSUM = (const float*)(ws + WS_SCR + SC_LSUM); const unsigned* LAB = (const unsigned*)(ws + WS_SCR + SC_LAB);
    int tid = tid0; asm volatile("" : "+v"(tid));
    const int c4 = tid & 31, rg = tid >> 5;
    LAS float* QS = (LAS float*)lds;
    LAS float* HINL = QS + 16 * 128 * 2;
    v4u abn[8]; v2u gqn[8];
#define LB_ISSUE(item_) { const SsdItem it_ = ssd_item(item_); const int rr_ = rg < it_.Q / 8 ? 8 * rg : 0; \
        const unsigned* labp_ = LAB + (size_t)(it_.row0 + rr_) * DR + it_.g * 128 + 4 * c4; const bf16* gp_ = G + (size_t)(it_.row0 + rr_) * DR + it_.g * 128 + 4 * c4; \
        _Pragma("unroll") for (int i = 0; i < 8; ++i) { abn[i] = *(const GAS v4u*)(labp_ + (size_t)i * DR); gqn[i] = *(const GAS v2u*)(gp_ + (size_t)i * DR); } }
    int item = blockIdx.x;
    if (item < N_CITEMS) LB_ISSUE(item)
    for (; item < N_CITEMS; item += gridDim.x) {
        const SsdItem it = ssd_item(item); const int b = it.b, c = it.c, kb = it.g, Q = it.Q, row0 = it.row0;
        const int nrg = Q / 8, r0 = 8 * rg, dg4 = kb * 128 + 4 * c4;
        v2f cs_[NCH - 1];
        if (tid < 128) { const int dg = kb * 128 + tid;
#pragma unroll
            for (int cp = 0; cp < NCH - 1; ++cp) { const v2f t = *(const GAS v2f*)(LSUM + ((size_t)(b * NCH + (cp < c ? cp : 0)) * DR + dg) * 2); const float mk = cp < c ? 1.f : 0.f;
                cs_[cp].x = 1.f + mk * (t.x - 1.f); cs_[cp].y = mk * t.y; } }
        v4u ab[8]; v2u gq[8];
#pragma unroll
        for (int i = 0; i < 8; ++i) { ab[i] = abn[i]; gq[i] = gqn[i]; }
        if (item + (int)gridDim.x < N_CITEMS) LB_ISSUE(item + (int)gridDim.x)
        __syncthreads();
        if (tid < 128) { float h = 0.f;
#pragma unroll
            for (int cp = 0; cp < NCH - 1; ++cp) h = cs_[cp].x * h + cs_[cp].y;
            HINL[tid] = h; }
        float av[8][4]; v4f A4 = (v4f){1.f, 1.f, 1.f, 1.f}, H4 = (v4f){0.f, 0.f, 0.f, 0.f};
#pragma unroll
        for (int i = 0; i < 8; ++i) { const v4u w = ab[i];
            av[i][0] = __expf(bflo(w.x)); av[i][1] = __expf(bflo(w.y)); av[i][2] = __expf(bflo(w.z)); av[i][3] = __expf(bflo(w.w));
            const v4f a4 = (v4f){av[i][0], av[i][1], av[i][2], av[i][3]}, b4 = (v4f){bfhi(w.x), bfhi(w.y), bfhi(w.z), bfhi(w.w)};
            H4 = a4 * H4 + b4; A4 = A4 * a4; }
        if (rg < nrg) { *(LAS v4f*)(QS + (rg * 128 + 4 * c4) * 2) = (v4f){A4.x, H4.x, A4.y, H4.y}; *(LAS v4f*)(QS + (rg * 128 + 4 * c4) * 2 + 4) = (v4f){A4.z, H4.z, A4.w, H4.w}; }
        __syncthreads();
        if (rg < nrg) {
            v4f h4 = *(const LAS v4f*)(HINL + 4 * c4);
            for (int qq = 0; qq < rg; ++qq) { const v4f s0 = *(const LAS v4f*)(QS + (qq * 128 + 4 * c4) * 2), s1 = *(const LAS v4f*)(QS + (qq * 128 + 4 * c4) * 2 + 4);
                h4 = (v4f){s0.x * h4.x + s0.y, s0.z * h4.y + s0.w, s1.x * h4.z + s1.y, s1.z * h4.w + s1.w}; }
            bf16* yp = YL + (size_t)(row0 + r0) * DR + dg4;
#pragma unroll
            for (int i = 0; i < 8; ++i) { const v4u w = ab[i]; const v4f a4 = (v4f){av[i][0], av[i][1], av[i][2], av[i][3]}, b4 = (v4f){bfhi(w.x), bfhi(w.y), bfhi(w.z), bfhi(w.w)};
                h4 = a4 * h4 + b4;
                const v4f g4 = (v4f){bflo(gq[i].x), bfhi(gq[i].x), bflo(gq[i].y), bfhi(gq[i].y)}, y4 = h4 * g4;
                *(GAS v2u*)(yp + (size_t)i * DR) = (v2u){pk2(y4.x, y4.y), pk2(y4.z, y4.w)}; }
            if (c == NCH - 1 && rg == nrg - 1) *(GAS v4f*)(out + O_PLH + ((size_t)j * NB + b) * DR + dg4) = h4;
        }
    }
#undef LB_ISSUE
    for (; item < N_CITEMS + 64; item += gridDim.x) { const int si = item - N_CITEMS; lru_sample_item(ws, out, lds, j, si & 7, si >> 3, tid, wave); }
}
#define RLX_AGENT __ATOMIC_RELAXED, __HIP_MEMORY_SCOPE_AGENT
#define XB_TMO      128
#define XB_XCNT(j)  (256  + 64 * (j))
#define XB_XSUB(j)  (1280 + 64 * (j))
#define XB_XGEN(j)  (2304 + 64 * (j))
#define XB_TOP      3328
#define XB_TOPGEN   3392
#define XCD_BAR_WORDS 3456
#define XB_SPIN_CAP (1u << 18)

__device__ __forceinline__ unsigned xb_ld(unsigned* p)              { return __hip_atomic_load(p, __ATOMIC_RELAXED, __HIP_MEMORY_SCOPE_AGENT); }
__device__ __forceinline__ unsigned xb_add(unsigned* p, unsigned v) { return __hip_atomic_fetch_add(p, v, __ATOMIC_RELAXED, __HIP_MEMORY_SCOPE_AGENT); }
__device__ __forceinline__ unsigned xb_xcc_id() { return (unsigned)__builtin_amdgcn_s_getreg((3 << 11) | 20) & 0xFu; }
#define XB_SPIN(cond, bar) do { unsigned _sp = 0; while (cond) { __builtin_amdgcn_s_sleep(1); \
    if ((++_sp & 255u) == 0u) { if (xb_ld(&(bar)[XB_TMO])) break; if (_sp > XB_SPIN_CAP) { atomicAdd(&(bar)[XB_TMO], 1u); break; } } } } while (0)

struct XcdBarrier {
    unsigned* bar; unsigned x;
    volatile LAS unsigned* st;
};

__device__ __forceinline__ XcdBarrier xcd_barrier_post(unsigned* bar, volatile LAS unsigned* st) {
    XcdBarrier b; b.bar = bar; b.x = xb_xcc_id(); b.st = st;
    if (threadIdx.x == 0) (void)xb_add(&bar[XB_XCNT(b.x)], 1u);
    return b;
}
__device__ __forceinline__ void xcd_barrier_complete(unsigned* bar, unsigned x, unsigned& nloc, unsigned& nx) {
    const unsigned G = gridDim.x * gridDim.y * gridDim.z;
    unsigned sum, cnt, mine, sp = 0u;
    for (;;) {
        sum = 0u; cnt = 0u; mine = 0u;
#pragma unroll
        for (unsigned j = 0; j < 16; ++j) { const unsigned c = xb_ld(&bar[XB_XCNT(j)]); sum += c; cnt += (c > 0u) ? 1u : 0u; mine = (j == x) ? c : mine; }
        if (sum == G) break;
        __builtin_amdgcn_s_sleep(1);
        if ((++sp & 255u) == 0u) { if (xb_ld(&bar[XB_TMO])) break; if (sp > XB_SPIN_CAP) { atomicAdd(&bar[XB_TMO], 1u); break; } }
    }
    nloc = mine > 0u ? mine : 1u; nx = cnt > 0u ? cnt : 1u;
}

__device__ __forceinline__ void xcd_barrier(const XcdBarrier& b) {
    asm volatile("s_waitcnt vmcnt(0)" ::: "memory");
    __syncthreads();
    if (threadIdx.x == 0) {
        unsigned* bar = b.bar;
        __builtin_amdgcn_s_waitcnt(0);
        unsigned nloc = b.st[0], nx = b.st[1];
        if (nloc == 0u) { xcd_barrier_complete(bar, b.x, nloc, nx); b.st[0] = nloc; b.st[1] = nx; }
        const unsigned old = xb_add(&bar[XB_XSUB(b.x)], 1u);
        const unsigned gen = old / nloc;
        if (old + 1u == (gen + 1u) * nloc) {
            __builtin_amdgcn_fence(__ATOMIC_RELEASE, "agent");
            asm volatile("s_waitcnt vmcnt(0)" ::: "memory");
            const unsigned og = xb_add(&bar[XB_TOP], 1u);
            const unsigned tg = og / nx;
            if (og + 1u == (tg + 1u) * nx) xb_add(&bar[XB_TOPGEN], 1u);
            else XB_SPIN(xb_ld(&bar[XB_TOPGEN]) == tg, bar);
            __builtin_amdgcn_fence(__ATOMIC_ACQUIRE, "agent");
            xb_add(&bar[XB_XGEN(b.x)], 1u);
            asm volatile("s_waitcnt vmcnt(0)" ::: "memory");
        } else {
            XB_SPIN(xb_ld(&bar[XB_XGEN(b.x)]) == gen, bar);
            __builtin_amdgcn_fence(__ATOMIC_ACQUIRE, "agent");
            asm volatile("s_waitcnt vmcnt(0)" ::: "memory");
        }
    }
    __syncthreads();
}

typedef float f32x16 __attribute__((ext_vector_type(16)));
constexpr int SG_SP = 136, SG_WREG = 2 * 32 * SG_SP * 2;
template <int K, int RT, class Epi>
__device__ __forceinline__ void small_gemm(LAS unsigned char* lds, const bf16* A, const bf16* Bt, int rt0, int nrt, int ct0, int nct, const Epi& E) {
    static_assert(RT == 1 && K % 1024 == 0, "small_gemm shape");
    int tid_ = threadIdx.x; asm volatile("" : "+v"(tid_));
    const int tid = tid_, lane = tid & 63, wave = __builtin_amdgcn_readfirstlane(tid >> 6), r = lane & 31, hh = lane >> 5, c16 = lane & 15, rs = lane >> 4;
    constexpr int KW = K / 8, NBAT = KW / 128;
    LAS bf16* As = (LAS bf16*)(lds + wave * SG_WREG); LAS bf16* Bs = As + 32 * SG_SP;
    LAS float* Pw = (LAS float*)(lds + wave * SG_WREG);
    const int ntiles = nrt * nct;
    v4u sa[8], sb[8];
#define SG_ISSUE(tile_, b_) { const bf16* ap_ = A + (size_t)(32 * (rt0 + (tile_) / nct) + rs) * K + wave * KW + 128 * (b_) + 8 * c16; \
        const bf16* bp_ = Bt + (size_t)(32 * (ct0 + (tile_) % nct) + rs) * K + wave * KW + 128 * (b_) + 8 * c16; \
        _Pragma("unroll") for (int i = 0; i < 8; ++i) { sa[i] = *(const GAS v4u*)(ap_ + (size_t)(4 * i) * K); sb[i] = *(const GAS v4u*)(bp_ + (size_t)(4 * i) * K); } }
    int tile = blockIdx.x;
    if (tile < ntiles) SG_ISSUE(tile, 0)
    for (; tile < ntiles; tile += gridDim.x) {
        const int row0 = 32 * (rt0 + tile / nct), col0 = 32 * (ct0 + tile % nct);
        f32x16 acc;
#pragma unroll
        for (int i = 0; i < 16; ++i) acc[i] = 0.f;
        __syncthreads();
#pragma unroll 1
        for (int b = 0; b < NBAT; ++b) {
#pragma unroll
            for (int i = 0; i < 8; ++i) { *(LAS v4u*)(As + (4 * i + rs) * SG_SP + 8 * c16) = sa[i]; *(LAS v4u*)(Bs + (4 * i + rs) * SG_SP + 8 * c16) = sb[i]; }
            bf16x8 af[8], bfr[8];
#pragma unroll
            for (int i = 0; i < 8; ++i) { af[i] = *(const LAS bf16x8*)(As + r * SG_SP + 16 * i + 8 * hh); bfr[i] = *(const LAS bf16x8*)(Bs + r * SG_SP + 16 * i + 8 * hh); }
            if (b + 1 < NBAT) SG_ISSUE(tile, b + 1)
            else if (tile + (int)gridDim.x < ntiles) SG_ISSUE(tile + (int)gridDim.x, 0)
#pragma unroll
            for (int i = 0; i < 8; ++i) acc = __builtin_amdgcn_mfma_f32_32x32x16_bf16(af[i], bfr[i], acc, 0, 0, 0);
        }
#pragma unroll
        for (int i = 0; i < 16; ++i) Pw[((i & 3) + 8 * (i >> 2) + 4 * hh) * 33 + r] = acc[i];
        __syncthreads();
#pragma unroll
        for (int e = 0; e < 2; ++e) { const int idx = tid + 512 * e, rr = idx >> 5, cc = idx & 31; float v = 0.f;
#pragma unroll
            for (int w = 0; w < 8; ++w) v += *(const LAS float*)(lds + w * SG_WREG + (rr * 33 + cc) * 4);
            E.elem(row0 + rr, col0 + cc, v); }
    }
#undef SG_ISSUE
}
constexpr int TM = 16384;
__device__ __forceinline__ void touch_region(const void* p, size_t bytes, int gthread, int nthreads) {
    const GAS v4u* q = (const GAS v4u*)p; const size_t n = bytes / 16;
    for (size_t i = gthread; i < n; i += (size_t)nthreads * 4) { v4u a = q[i], b = (i + nthreads < n) ? q[i + nthreads] : a, c = (i + 2 * (size_t)nthreads < n) ? q[i + 2 * (size_t)nthreads] : a, d = (i + 3 * (size_t)nthreads < n) ? q[i + 3 * (size_t)nthreads] : a;
        asm volatile("" :: "v"(a), "v"(b), "v"(c), "v"(d)); }
}
template <int N, int K, class Epi>
__device__ __forceinline__ void run_gemm(LAS unsigned char* lds, const bf16* A, const bf16* Bt, const Epi& E) {
    pg8::Gemm g{A, Bt, TM, N, K}; pg8::StaticOrder S; S.init(TM, N, (int)gridDim.x, (int)blockIdx.x);
    pg8::gemm_phase<Epi, pg8::StaticOrder, true, true>(lds, g, S, E);
    small_gemm<K, 1>(lds, A, Bt, TM / 32, (T - TM) / 32, 0, N / 32, E);
    if (SUBREP & 512) { asm volatile("" ::: "memory"); small_gemm<K, 1>(lds, A, Bt, TM / 32, (T - TM) / 32, 0, N / 32, E); }
}
__global__ void __launch_bounds__(NTHR, 2) mk_fwd(Args args) {
    extern __shared__ __attribute__((aligned(16))) unsigned char lds_raw[];
    LAS unsigned char* lds = (LAS unsigned char*)lds_raw;
    if (threadIdx.x < 2) ((LAS unsigned*)(lds + LDS_MISC_OFF))[threadIdx.x] = 0u;
    __syncthreads();
    const XcdBarrier bar = xcd_barrier_post((unsigned*)(args.ws + WS_CTL) + CW_BAR, (volatile LAS unsigned*)(lds + LDS_MISC_OFF));
    for (int ph = args.ph_lo, rep = 0; ph < args.ph_hi; ++ph) {
        if (ph > 0 && ((ph - 1) / PL) % 2 == 1 && (ph - 1) % PL == 3) continue;
        if (ph == args.ph_lo + 1 && rep == 0) cg::this_grid().sync();
        else if (ph > args.ph_lo || rep) xcd_barrier(bar);
        int tid = threadIdx.x; asm volatile("" : "+v"(tid));
        unsigned char* ws = args.ws; asm volatile("" : "+s"(ws));
        const int lane = tid & 63, wave = __builtin_amdgcn_readfirstlane(tid >> 6);
        const int G = gridDim.x, gw = blockIdx.x * NWAVES + wave, NGW = G * NWAVES;
        bf16* WB = (bf16*)(ws + WS_W); bf16* XB = (bf16*)(ws + WS_XB); float* RS = (float*)(ws + WS_RS); bf16* Mb = (bf16*)(ws + WS_M);
        bf16* ZX = (bf16*)(ws + WS_ZX); float* DT = (float*)(ws + WS_DT); bf16* YN = (bf16*)(ws + WS_YN);
        if (ph == 0) { p0_prologue(args, lds, gw, NGW, wave, lane); if (((REP_MASK >> 6) & 1) && rep == 0) { rep = 1; --ph; } else rep = 0; continue; }
        const int i = (ph - 1) / PL, k = (ph - 1) % PL, j = i >> 1; const bool ssd = (i & 1) == 0;
        bf16* wl = ssd ? WB + WE_SSD0 + (size_t)j * WE_SEND : WB + WE_LRU0 + (size_t)j * WE_LEND;
        bf16* wf = WB + WE_FFN0 + (size_t)i * WE_FEND;
        if (k == 0) {
            if (ssd) { pg8::EpiSsdIn E{ZX, DT, RS}; run_gemm<ZXW, DM>(lds, XB, wl + WE_SIN, E);
                small_gemm<DM, 1>(lds, XB, wl + WE_SIN, 0, T / 32, ZXW / 32, 1, E); }
            else { pg8::EpiLruIn E{ZX, ZX + (size_t)T * DR, RS, arg_in(I_LBIN) + (size_t)j * 2048}; run_gemm<2048, DM>(lds, XB, wl + WE_LIN, E); }
        } else if (k == 4) {
            if (ssd) { pg8::EpiM E{Mb, nullptr}; run_gemm<DM, DI>(lds, YN, wl + WE_SOUT, E); }
            else { pg8::EpiM E{Mb, arg_in(I_LBOUT) + (size_t)j * DM}; run_gemm<DM, DR>(lds, YN, wl + WE_LOUT, E); }
        } else if (k == 5) { if (TOUCH_W) touch_region(wf, (size_t)WE_FEND * 2, blockIdx.x * NTHR + tid, G * NTHR);
            resid_phase(args, arg_in(I_NMPOST) + (size_t)i * DM, false, gw, NGW, lane);
        } else if (k == 6) { pg8::EpiFfn1 E{ZX, RS}; run_gemm<DFF, DM>(lds, XB, wf + WE_F1, E);
        } else if (k == 7) { pg8::EpiM E{Mb, nullptr}; run_gemm<DM, DFF>(lds, ZX, wf + WE_F2, E);
        } else if (k == 8) { resid_phase(args, arg_in(I_NFPOST) + (size_t)i * DM, i == 3, gw, NGW, lane);
        }
        else if (ssd && k == 1) ssd_phase_a(ws, args.out, lds, j, tid, lane, wave);
        else if (ssd && k == 2) ssd_phase_b(ws, args.out, j, tid);
        else if (ssd && k == 3) ssd_phase_c(ws, args.out, lds, j, tid, lane, wave);
        else if (!ssd && k == 1) lru_phase<false>(ws, args.out, lds, j, tid, lane, wave);
        else if (!ssd && k == 2) lru_phase_b(ws, args.out, lds, j, tid, wave);
        if (REP_MASK) { const int kind = (k == 0 || k == 4 || k == 6 || k == 7) ? 0 : (ssd && k >= 1 && k <= 3) ? k : (!ssd && k >= 1 && k <= 2) ? 3 + k : 9;
            if (((REP_MASK >> kind) & 1) && rep == 0) { rep = 1; --ph; } else rep = 0; }
    }
}

__global__ void k_ssd_conv(const bf16* __restrict__ ZX, const float* __restrict__ st, const float* __restrict__ cw, const float* __restrict__ cb,
                           float* __restrict__ XBC, float* __restrict__ o_p, float* __restrict__ o_s) {
    const int r = blockIdx.x, c = blockIdx.y * 256 + threadIdx.x;
    float x0, x1, x2; const float x3 = bf2f(ZX[(size_t)r * ZXW + DI + c]);
    if (r < TP) { const int t = r % LP;
        x2 = t >= 1 ? bf2f(ZX[(size_t)(r - 1) * ZXW + DI + c]) : 0.f; x1 = t >= 2 ? bf2f(ZX[(size_t)(r - 2) * ZXW + DI + c]) : 0.f; x0 = t >= 3 ? bf2f(ZX[(size_t)(r - 3) * ZXW + DI + c]) : 0.f;
        if (t >= LP - 3) o_p[((size_t)(r / LP) * 3 + (t - (LP - 3))) * CONVD + c] = x3;
    } else { const int s = r - TP; const float* sp = st + (size_t)s * 3 * CONVD + c; x0 = sp[0]; x1 = sp[CONVD]; x2 = sp[2 * CONVD];
        float* op = o_s + (size_t)s * 3 * CONVD + c; op[0] = x1; op[CONVD] = x2; op[2 * CONVD] = x3; }
    const float v = cb[c] + cw[c] * x0 + cw[CONVD + c] * x1 + cw[2 * CONVD + c] * x2 + cw[3 * CONVD + c] * x3;
    XBC[(size_t)r * CONVD + c] = silu_f(v);
}
__global__ void __launch_bounds__(64) k_ssd_scan(const float* __restrict__ DT, const float* __restrict__ XBC, const float* __restrict__ h0,
                                                 const float* __restrict__ dt_bias, const float* __restrict__ a_log, const float* __restrict__ dsk,
                                                 float* __restrict__ Y, float* __restrict__ o_ph, float* __restrict__ o_sh) {
    const int q = blockIdx.x / NH, h = blockIdx.x % NH, p = threadIdx.x, g = h / 4;
    const int row0 = seq_row0(q), L = seq_len(q);
    float hs[NST];
    if (q < NB) {
#pragma unroll
        for (int n = 0; n < NST; ++n) hs[n] = 0.f;
    } else { const float* hp = h0 + (((size_t)(q - NB) * NH + h) * HD + p) * NST;
#pragma unroll
        for (int n = 0; n < NST; n += 4) { const float4 v = *(const float4*)(hp + n); hs[n] = v.x; hs[n + 1] = v.y; hs[n + 2] = v.z; hs[n + 3] = v.w; } }
    const float Aneg = -__expf(a_log[h]), dtb = dt_bias[h], Dh = dsk[h];
    for (int t = 0; t < L; ++t) {
        const size_t row = (size_t)(row0 + t);
        const float dtv = softplus_f(DT[row * 32 + h] + dtb);
        const float dA = __expf(dtv * Aneg);
        const float xv = XBC[row * CONVD + h * HD + p], xdt = xv * dtv;
        const float* Bp = XBC + row * CONVD + DI + g * NST; const float* Cp = Bp + NG * NST;
        float y = 0.f;
#pragma unroll
        for (int n = 0; n < NST; ++n) { hs[n] = fmaf(hs[n], dA, xdt * Bp[n]); y = fmaf(Cp[n], hs[n], y); }
        Y[row * DI + h * HD + p] = y + Dh * xv;
    }
    float* op = (q < NB ? o_ph + (((size_t)q * NH + h) * HD + p) * NST : o_sh + (((size_t)(q - NB) * NH + h) * HD + p) * NST);
#pragma unroll
    for (int n = 0; n < NST; n += 4) *(float4*)(op + n) = make_float4(hs[n], hs[n + 1], hs[n + 2], hs[n + 3]);
}
__global__ void k_ssd_gate_norm(const float* __restrict__ Y, const bf16* __restrict__ ZX, bf16* __restrict__ YN) {
    const int wv = blockIdx.x * 4 + (threadIdx.x >> 6), lane = threadIdx.x & 63, r = wv / NG, g = wv % NG, c = g * 256 + lane * 4;
    const float4 y = *(const float4*)(Y + (size_t)r * DI + c); const v2u zz = *(const v2u*)(ZX + (size_t)r * ZXW + c);
    float4 v = make_float4(y.x * silu_f(bflo(zz.x)), y.y * silu_f(bfhi(zz.x)), y.z * silu_f(bflo(zz.y)), y.w * silu_f(bfhi(zz.y)));
    const float s = wave_sum(v.x * v.x + v.y * v.y + v.z * v.z + v.w * v.w);
    const float rs = rsqrtf(s * (1.f / 256.f) + EPS);
    *(v2u*)(YN + (size_t)r * DI + c) = (v2u){pk2(v.x * rs, v.y * rs), pk2(v.z * rs, v.w * rs)};
}
__global__ void k_lru_conv(const bf16* __restrict__ XRAW, const float* __restrict__ st, const float* __restrict__ cw, const float* __restrict__ cb,
                           float* __restrict__ XR, float* __restrict__ o_p, float* __restrict__ o_s) {
    const int r = blockIdx.x, c = blockIdx.y * 256 + threadIdx.x;
    float x0, x1, x2; const float x3 = bf2f(XRAW[(size_t)r * DR + c]);
    if (r < TP) { const int t = r % LP;
        x2 = t >= 1 ? bf2f(XRAW[(size_t)(r - 1) * DR + c]) : 0.f; x1 = t >= 2 ? bf2f(XRAW[(size_t)(r - 2) * DR + c]) : 0.f; x0 = t >= 3 ? bf2f(XRAW[(size_t)(r - 3) * DR + c]) : 0.f;
        if (t >= LP - 3) o_p[((size_t)(r / LP) * 3 + (t - (LP - 3))) * DR + c] = x3;
    } else { const int s = r - TP; const float* sp = st + (size_t)s * 3 * DR + c; x0 = sp[0]; x1 = sp[DR]; x2 = sp[2 * DR];
        float* op = o_s + (size_t)s * 3 * DR + c; op[0] = x1; op[DR] = x2; op[2 * DR] = x3; }
    XR[(size_t)r * DR + c] = cb[c] + cw[c] * x0 + cw[DR + c] * x1 + cw[2 * DR + c] * x2 + cw[3 * DR + c] * x3;
}
__global__ void k_lru_gates(const float* __restrict__ XR, const float* __restrict__ wa, const float* __restrict__ ba, const float* __restrict__ wx, const float* __restrict__ bx,
                            const float* __restrict__ lam, float* __restrict__ AV, float* __restrict__ BV) {
    const int r = blockIdx.x, d = blockIdx.y * 256 + threadIdx.x, k = d >> 7, dd = d & 127;
    const float* xr = XR + (size_t)r * DR + k * 128; const float* wap = wa + (size_t)k * 128 * 128 + dd; const float* wxp = wx + (size_t)k * 128 * 128 + dd;
    float sa = ba[d], sx = bx[d];
    for (int c = 0; c < 128; ++c) { const float xv = xr[c]; sa = fmaf(xv, wap[c * 128], sa); sx = fmaf(xv, wxp[c * 128], sx); }
    const float rg = sigmoid_f(sa), ig = sigmoid_f(sx);
    const float log_a = -8.0f * rg * softplus_f(-lam[d]);
    const float av = __expf(log_a), mult = sqrtf(-expm1f(2.f * log_a));
    AV[(size_t)r * DR + d] = av; BV[(size_t)r * DR + d] = mult * ig * XR[(size_t)r * DR + d];
}
__global__ void k_lru_scan(const float* __restrict__ AV, const float* __restrict__ BV, const bf16* __restrict__ Gt, const float* __restrict__ h0,
                           bf16* __restrict__ YL, float* __restrict__ o_p, float* __restrict__ o_s) {
    const int q = blockIdx.x, d = blockIdx.y * 256 + threadIdx.x, row0 = seq_row0(q), L = seq_len(q);
    float h = q < NB ? 0.f : h0[(size_t)(q - NB) * DR + d];
    for (int t = 0; t < L; ++t) { const size_t row = (size_t)(row0 + t);
        h = fmaf(AV[row * DR + d], h, BV[row * DR + d]);
        YL[row * DR + d] = (bf16)f2bf(h * bf2f(Gt[row * DR + d])); }
    if (q < NB) o_p[(size_t)q * DR + d] = h; else o_s[(size_t)(q - NB) * DR + d] = h;
}

extern "C" void kernel_launch(void* const* d_in, const int* in_sizes, int n_in, void* d_out, int out_size, void* d_ws, size_t ws_size, hipStream_t stream) {
    static int grid = 0;
    if (grid == 0) {
        if (n_in != N_IN || (size_t)out_size != O_END || ws_size < WS_END) { fprintf(stderr, "kernel_launch: unexpected sizes n_in %d out %d ws %zu (need %zu)\n", n_in, out_size, ws_size, (size_t)WS_END); grid = -1; return; }
        int dev = 0, cus = 0, per_cu = 0;
        if (hipGetDevice(&dev) != hipSuccess || hipDeviceGetAttribute(&cus, hipDeviceAttributeMultiprocessorCount, dev) != hipSuccess) { grid = -1; return; }
        if (hipFuncSetAttribute((const void*)mk_fwd, hipFuncAttributeMaxDynamicSharedMemorySize, LDS_BYTES) != hipSuccess) { fprintf(stderr, "kernel_launch: hipFuncSetAttribute failed\n"); grid = -1; return; }
        if (hipOccupancyMaxActiveBlocksPerMultiprocessor(&per_cu, (const void*)mk_fwd, NTHR, LDS_BYTES) != hipSuccess || per_cu < 1) { fprintf(stderr, "kernel_launch: occupancy query %d\n", per_cu); grid = -1; return; }
        grid = cus;
    }
    if (grid < 0) return;
    const float* const* in = (const float* const*)d_in; float* out = (float*)d_out; unsigned char* ws = (unsigned char*)d_ws;
    (void)hipMemsetAsync(ws + WS_CTL, 0, CTL_ZERO_BYTES, stream);
    Args a{};
    for (int i = 0; i < N_IN; ++i) a.in[i] = in[i];
    a.out = out; a.ws = ws;
    bf16* ZX = (bf16*)(ws + WS_ZX); float* DT = (float*)(ws + WS_DT); bf16* YN = (bf16*)(ws + WS_YN);
    float* SCR = (float*)(ws + WS_SCR);
    constexpr size_t SZ_X = (size_t)T * DM;
    int ph = 0;
    while (ph < NPH) {
        const int i = ph ? (ph - 1) / PL : -1, k = ph ? (ph - 1) % PL : -1, j = i >> 1;
        if (false) {
            if (k == 1) {
            if ((i & 1) == 0) {
                float* XBC = SCR; float* Y = SCR + (size_t)T * CONVD;
                hipLaunchKernelGGL(k_ssd_conv, dim3(T, CONVD / 256), dim3(256), 0, stream, ZX, in[I_SSC] + (size_t)j * NS * 3 * CONVD, in[I_SCW] + (size_t)j * 4 * CONVD, in[I_SCB] + (size_t)j * CONVD,
                                   XBC, out + O_PSC + (size_t)j * NB * 3 * CONVD, out + O_SSC + (size_t)j * NS * 3 * CONVD);
                hipLaunchKernelGGL(k_ssd_scan, dim3(NSEQ * NH), dim3(64), 0, stream, DT, XBC, in[I_SSH] + (size_t)j * NS * NH * HD * NST, in[I_SDTB] + j * NH, in[I_SALOG] + j * NH, in[I_SD] + j * NH,
                                   Y, out + O_PSH + (size_t)j * NB * NH * HD * NST, out + O_SSH + (size_t)j * NS * NH * HD * NST);
                hipLaunchKernelGGL(k_ssd_gate_norm, dim3(T * NG / 4), dim3(256), 0, stream, Y, ZX, YN);
            } else {
                float* XR = SCR; float* AV = SCR + SZ_X; float* BV = SCR + 2 * SZ_X;
                hipLaunchKernelGGL(k_lru_conv, dim3(T, DR / 256), dim3(256), 0, stream, ZX + (size_t)T * DR, in[I_SLC] + (size_t)j * NS * 3 * DR, in[I_LCW] + (size_t)j * 4 * DR, in[I_LCB] + (size_t)j * DR,
                                   XR, out + O_PLC + (size_t)j * NB * 3 * DR, out + O_SLC + (size_t)j * NS * 3 * DR);
                hipLaunchKernelGGL(k_lru_gates, dim3(T, DR / 256), dim3(256), 0, stream, XR, in[I_LWA] + (size_t)j * 8 * 128 * 128, in[I_LBA] + (size_t)j * DR, in[I_LWX] + (size_t)j * 8 * 128 * 128, in[I_LBX] + (size_t)j * DR,
                                   in[I_LLAM] + (size_t)j * DR, AV, BV);
                hipLaunchKernelGGL(k_lru_scan, dim3(NSEQ, DR / 256), dim3(256), 0, stream, AV, BV, ZX, in[I_SLH] + (size_t)j * NS * DR, YN, out + O_PLH + (size_t)j * NB * DR, out + O_SLH + (size_t)j * NS * DR);
            }
            }
            ++ph; continue;
        }
        int hi = ph + 1;
        hi = NPH;
        a.ph_lo = ph; a.ph_hi = hi;
        void* kargs[] = {(void*)&a};
        const hipError_t e = hipLaunchCooperativeKernel((const void*)mk_fwd, dim3(grid), dim3(NTHR), kargs, LDS_BYTES, stream);
        if (e != hipSuccess) fprintf(stderr, "kernel_launch: cooperative launch failed: %s (grid %d)\n", hipGetErrorString(e), grid);
        ph = hi;
    }
}
```

```cpp
#include <hip/hip_runtime.h>
#include <hip/hip_cooperative_groups.h>
#include <cstdio>
#include <cstdint>
namespace cg = cooperative_groups;

constexpr int DM = 1024, NB = 8, SEQ = 2048, NMETA = 16, LP = SEQ + NMETA  , NS = 128;
constexpr int TP = NB * LP  , T = TP + NS  ;
constexpr int DI = 2048, HD = 64, NH = 32, NG = 8, NST = 128, CONVD = 4096, INDIM = 6176, DFF = 4096, DR = 1024;
constexpr int ZXW = 6144;
constexpr int NPAD_SSD = 6400;
constexpr int NSEQ = NB + NS;
constexpr float EPS = 1e-6f;

constexpr size_t O_YP = 0, O_YS = O_YP + (size_t)NB * SEQ * DM, O_PSC = O_YS + (size_t)NS * DM, O_PSH = O_PSC + (size_t)2 * NB * 3 * CONVD,
                 O_PLC = O_PSH + (size_t)2 * NB * NH * HD * NST, O_PLH = O_PLC + (size_t)2 * NB * 3 * DR, O_SSC = O_PLH + (size_t)2 * NB * DR,
                 O_SSH = O_SSC + (size_t)2 * NS * 3 * CONVD, O_SLC = O_SSH + (size_t)2 * NS * NH * HD * NST, O_SLH = O_SLC + (size_t)2 * NS * 3 * DR,
                 O_END = O_SLH + (size_t)2 * NS * DR;

enum { I_XP = 0, I_XS, I_SSC, I_SSH, I_SLC, I_SLH, I_META, I_NMPRE, I_NMPOST, I_NFPRE, I_NFPOST, I_SWIN, I_SCW, I_SCB, I_SDTB, I_SALOG, I_SD, I_SNORM, I_SWOUT,
       I_LWIN, I_LBIN, I_LCW, I_LCB, I_LWA, I_LBA, I_LWX, I_LBX, I_LLAM, I_LWOUT, I_LBOUT, I_W1, I_W2, N_IN };

#ifndef SUBREP
#define SUBREP 0
#endif
typedef unsigned short bf16;

constexpr size_t MiB = 1u << 20;
constexpr size_t WS_CTL = 0, CTL_ZERO_BYTES = 49152;
constexpr int CW_LFLG = 8192;
constexpr size_t WS_LCF = 512 * 1024;
constexpr size_t WE_SIN = 0, WE_SOUT = WE_SIN + (size_t)NPAD_SSD * DM, WE_SEND = WE_SOUT + (size_t)DM * DI;
constexpr size_t WE_LIN = 0, WE_LAX = WE_LIN + (size_t)2048 * DM, WE_LOUT = WE_LAX + (size_t)8 * 256 * 128, WE_LEND = WE_LOUT + (size_t)DM * DR;
constexpr size_t WE_F1 = 0, WE_F2 = WE_F1 + (size_t)DFF * DM, WE_FEND = WE_F2 + (size_t)DM * DFF;
constexpr size_t WE_SSD0 = 0, WE_LRU0 = WE_SSD0 + 2 * WE_SEND, WE_FFN0 = WE_LRU0 + 2 * WE_LEND, WE_TOTAL = WE_FFN0 + 4 * WE_FEND;
constexpr size_t WS_W = 1 * MiB;
constexpr size_t WS_X = 121 * MiB;
constexpr size_t WS_XB = WS_X + 65 * MiB;
constexpr size_t WS_RS = WS_XB + 33 * MiB;
constexpr size_t WS_M = WS_RS + 1 * MiB;
constexpr size_t WS_ZX = WS_M + 65 * MiB;
constexpr size_t WS_DT = WS_ZX + 195 * MiB;
constexpr size_t WS_YN = WS_DT + 3 * MiB;
constexpr size_t WS_SCR = WS_YN + 65 * MiB;
constexpr size_t WS_END = WS_SCR + 400 * MiB;
static_assert(WE_TOTAL * 2 <= 120 * MiB, "weight region");
static_assert(WS_END <= 1024 * MiB, "d_ws map");

#define GAS __attribute__((address_space(1)))
#define LAS __attribute__((address_space(3)))
typedef unsigned v4u __attribute__((ext_vector_type(4)));
typedef unsigned v2u __attribute__((ext_vector_type(2)));
typedef float v4f __attribute__((ext_vector_type(4)));
typedef float v2f __attribute__((ext_vector_type(2)));
#define LDS_WAIT() asm volatile("s_waitcnt lgkmcnt(0)" ::: "memory")
#define VM_WAIT() asm volatile("s_waitcnt vmcnt(0)" ::: "memory")

__device__ __forceinline__ float silu_f(float x) { return x * __builtin_amdgcn_rcpf(1.f + __expf(-x)); }
__device__ __forceinline__ float sigmoid_f(float x) { return __builtin_amdgcn_rcpf(1.f + __expf(-x)); }
__device__ __forceinline__ float neg_expm1_f(float x) { const float p = x * (1.f + x * (0.5f + x * (0.16666667f + x * (0.041666668f + x * (0.0083333338f + x * 0.0013888889f)))));
    return x > -0.35f ? -p : 1.f - __expf(x); }
__device__ __forceinline__ float softplus_f(float x) { return fmaxf(x, 0.f) + log1pf(__expf(-fabsf(x))); }
__device__ __forceinline__ float one_minus_exp2x(float x, float e) { const float t = 2.f * x;
    const float p = t * (1.f + t * (0.5f + t * (0.16666667f + t * (0.041666668f + t * (0.0083333338f + t * 0.0013888889f)))));
    return t > -0.35f ? -p : 1.f - e * e; }
__device__ __forceinline__ void lru_gate2(v2f ga, v2f gx, float bav, float bxv, float cfac, v2f xr, v2f& av, v2f& bt, v2f& la) {
    const v2f ta = ga + bav, tx = gx + bxv;
    v2f ea, ex; ea.x = __expf(-ta.x); ea.y = __expf(-ta.y); ex.x = __expf(-tx.x); ex.y = __expf(-tx.y);
    ea = ea + 1.0f; ex = ex + 1.0f;
    v2f rg, ig; rg.x = __builtin_amdgcn_rcpf(ea.x); rg.y = __builtin_amdgcn_rcpf(ea.y); ig.x = __builtin_amdgcn_rcpf(ex.x); ig.y = __builtin_amdgcn_rcpf(ex.y);
    la = rg * (-cfac);
    av.x = __expf(la.x); av.y = __expf(la.y);
    const v2f t = la * 2.0f;
    const v2f p = t * (1.0f + t * (0.5f + t * (0.16666667f + t * (0.041666668f + t * (0.0083333338f + t * 0.0013888889f)))));
    const v2f q = 1.0f - av * av;
    v2f om; om.x = t.x > -0.35f ? -p.x : q.x; om.y = t.y > -0.35f ? -p.y : q.y;
    v2f mu; mu.x = __builtin_amdgcn_sqrtf(om.x); mu.y = __builtin_amdgcn_sqrtf(om.y);
    bt = mu * ig * xr;
}
__device__ __forceinline__ float gelu_tanh_f(float x) { const float u = 0.7978845608028654f * (x + 0.044715f * x * x * x); return x * __builtin_amdgcn_rcpf(1.f + __expf(-2.f * u)); }
__device__ __forceinline__ float dpp_add(float v, float w) { return v + w; }
#define WS_DPP(v, ctrl, rmask) ((v) + __builtin_bit_cast(float, __builtin_amdgcn_update_dpp(0, __builtin_bit_cast(int, (v)), (ctrl), (rmask), 0xf, true)))
__device__ __forceinline__ float wave_sum(float v) {
    v = WS_DPP(v, 0xB1, 0xf);
    v = WS_DPP(v, 0x4E, 0xf);
    v = WS_DPP(v, 0x141, 0xf);
    v = WS_DPP(v, 0x140, 0xf);
    v = WS_DPP(v, 0x142, 0xa);
    v = WS_DPP(v, 0x143, 0xc);
    return __builtin_bit_cast(float, __builtin_amdgcn_readlane(__builtin_bit_cast(int, v), 63));
}
__device__ __forceinline__ float xor32_f(float x, int lane) { const unsigned u = __builtin_bit_cast(unsigned, x); const auto r = __builtin_amdgcn_permlane32_swap(u, u, false, false);
    return __builtin_bit_cast(float, lane < 32 ? r[1] : r[0]); }
__device__ __forceinline__ float xor16_f(float x, int lane) { const unsigned u = __builtin_bit_cast(unsigned, x); const auto r = __builtin_amdgcn_permlane16_swap(u, u, false, false);
    return __builtin_bit_cast(float, (lane & 16) ? r[0] : r[1]); }
typedef __bf16 bf16x2_hw __attribute__((ext_vector_type(2)));
__device__ __forceinline__ unsigned pk2(float lo, float hi) { const v2f v = {lo, hi}; return __builtin_bit_cast(unsigned, __builtin_convertvector(v, bf16x2_hw)); }
__device__ __forceinline__ unsigned f2bf(float f) { return pk2(f, 0.f) & 0xffffu; }
__device__ __forceinline__ float bf2f(bf16 b) { return __builtin_bit_cast(float, (unsigned)b << 16); }
__device__ __forceinline__ float bflo(unsigned w) { return __builtin_bit_cast(float, w << 16); }
__device__ __forceinline__ float bfhi(unsigned w) { return __builtin_bit_cast(float, w & 0xffff0000u); }
__device__ __forceinline__ int seq_row0(int q) { return q < NB ? q * LP : TP + (q - NB); }
__device__ __forceinline__ int seq_len(int q) { return q < NB ? LP : 1; }

namespace pg8 {
#define PG8_LAS __attribute__((address_space(3)))
typedef unsigned short bf16_t;
typedef short bf16x8 __attribute__((ext_vector_type(8)));
typedef float f32x4 __attribute__((ext_vector_type(4)));
typedef unsigned u32x4 __attribute__((ext_vector_type(4)));
constexpr int BM = 256, BK = 64, HALF = 128, HTB = HALF * BK * 2  , STAGE_BYTES = 8 * HTB, NXCD = 8, WGM = 4;

__host__ __device__ __forceinline__ int lds_byte(int r, int c) { const int st = (r >> 4) * 2 + (c >> 5), rr = r & 15, cc = c & 31, ob = rr * 64 + cc * 2; return st * 1024 + (ob ^ (((ob >> 9) & 1) << 5)); }
__host__ __device__ __forceinline__ void stage_rc(int b, int& R, int& C) { const int st = b / 1024, sb = b % 1024, swz = sb ^ (((sb >> 9) & 1) << 5); R = (st >> 1) * 16 + swz / 64; C = (st & 1) * 32 + (swz % 64) / 2; }
__host__ __device__ __forceinline__ int perm32(int rho) { const int n = rho >> 4, i = rho & 15; return 8 * (i >> 2) + 4 * n + (i & 3); }

struct Unit { int pm, pn; };
struct Gemm { const bf16_t* A; const bf16_t* Bt; int M, N, K; };

struct StaticOrder {
    int nM, nN, nwg, G, c;
    __host__ __device__ void init(int M, int N, int G_, int c_) { nM = M / BM; nN = N / BM; nwg = nM * nN; G = G_; c = c_; }
    __host__ __device__ bool next(int i, Unit& u) const {
        const long L = (long)i * G + c; if (L >= nwg) return false;
        int wgid = (int)L; { const int q = nwg / NXCD, r = nwg % NXCD, xcd = wgid % NXCD, off = wgid / NXCD; wgid = (xcd < r ? xcd * (q + 1) : r * (q + 1) + (xcd - r) * q) + off; }
        const int nig = WGM * nN, gid = wgid / nig, fm = gid * WGM, gsz = (nM - fm) < WGM ? (nM - fm) : WGM;
        u.pm = fm + ((wgid % nig) % gsz); u.pn = (wgid % nig) / gsz; return true;
    }
    __device__ __forceinline__ void a_ready(const Unit&) const {}
    __device__ __forceinline__ void done(const Unit&) const {}
};
__device__ __forceinline__ unsigned cvt_pk_bf16(float lo, float hi) { return ::pk2(lo, hi); }

template <class Epi, class Sched, bool ALIGN_EPI = false, bool SP2 = false, bool TILED_A = false>
__device__ __forceinline__ void gemm_phase(PG8_LAS unsigned char* lds, const Gemm g, const Sched& S, const Epi& E) {
    int tid_ = threadIdx.x; asm volatile("" : "+v"(tid_));
    const int tid = tid_, wid = __builtin_amdgcn_readfirstlane(tid >> 6), lane = tid & 63, wr = wid >> 2, wc = wid & 3, fr = lane & 15, fq = lane >> 4;
    const int K = g.K, nt = K / BK;
    unsigned voffA[2], voffB[2];
#pragma unroll
    for (int i = 0; i < 2; ++i) { int R, C; stage_rc(tid * 16 + i * 8192, R, C); const int Rb = Epi::PERM ? ((R & ~31) + perm32(R & 31)) : R;
        voffA[i] = TILED_A ? (unsigned)((R >> 4) * (K / 32) * 1024 + (C >> 5) * 1024 + ((R & 15) * 4 + ((C & 31) >> 3)) * 16) : (unsigned)(R * K + C) * 2u; voffB[i] = (unsigned)((Rb >> 4) * (K / 32) * 1024 + (C >> 5) * 1024 + ((Rb & 15) * 4 + ((C & 31) >> 3)) * 16); }
    const size_t kstep = (size_t)(BK * 2);
    const size_t kstepA = TILED_A ? (size_t)2048 : kstep;
    const size_t kstepB = 2048;
    const size_t hstep = (size_t)HALF * K * 2;
    const size_t tstep = 2 * hstep;
    const unsigned ldsw = (unsigned)wid * 1024u;
    const int aoff = lds_byte(wr * 64 + fr, fq * 8), boff = lds_byte(wc * 32 + fr, fq * 8);
#define PG8_SA(b, h) (((b) * 2 + (h)) * HTB)
#define PG8_SB(b, h) ((4 + (b) * 2 + (h)) * HTB)
#define PG8_STAGE(bufoff, gbase, voff) do { _Pragma("unroll") for (int _i = 0; _i < 2; ++_i) \
        __builtin_amdgcn_global_load_lds((const unsigned*)((const char*)(gbase) + (voff)[_i]), (PG8_LAS unsigned*)(lds + (bufoff) + ldsw + _i * 8192), 16, 0, 0); } while (0)
#define PG8_LDA(dst, b, h) do { _Pragma("unroll") for (int m = 0; m < 4; ++m) _Pragma("unroll") for (int k = 0; k < 2; ++k) dst[m][k] = *(const PG8_LAS bf16x8*)(lds + PG8_SA(b, h) + aoff + m * 2048 + k * 1024); } while (0)
#define PG8_LDB(dst, b, h) do { _Pragma("unroll") for (int n = 0; n < 2; ++n) _Pragma("unroll") for (int k = 0; k < 2; ++k) dst[n][k] = *(const PG8_LAS bf16x8*)(lds + PG8_SB(b, h) + boff + n * 2048 + k * 1024); } while (0)
#define PG8_MMA(ai, bj, At, Bt) do { __builtin_amdgcn_s_setprio(1); _Pragma("unroll") for (int m = 0; m < 4; ++m) _Pragma("unroll") for (int n = 0; n < 2; ++n) _Pragma("unroll") for (int k = 0; k < 2; ++k) \
        acc[ai][bj][m][n] = __builtin_amdgcn_mfma_f32_16x16x32_bf16(Bt[n][k], At[m][k], acc[ai][bj][m][n], 0, 0, 0); __builtin_amdgcn_s_setprio(0); } while (0)
#define PG8_WAIT_V(n) asm volatile("s_waitcnt vmcnt(" #n ")" ::: "memory")
#define PG8_WAIT_L(n) asm volatile("s_waitcnt lgkmcnt(" #n ")" ::: "memory")
#define PG8_BAR __builtin_amdgcn_s_barrier()
#define PG8_SCHED __builtin_amdgcn_sched_barrier(0)
    Unit cur, nxt; int ui = 0;
    if (!S.next(0, cur)) return;
    f32x4 acc[2][2][4][2];
#pragma unroll
    for (int a = 0; a < 2; ++a)
#pragma unroll
        for (int b = 0; b < 2; ++b)
#pragma unroll
            for (int m = 0; m < 4; ++m)
#pragma unroll
                for (int n = 0; n < 2; ++n) acc[a][b][m][n] = (f32x4){0.f, 0.f, 0.f, 0.f};
    bf16x8 At[4][2], B0[2][2], B1[2][2];
    const char* cA = (const char*)g.A + (size_t)cur.pm * tstep; const char* cB = (const char*)g.Bt + (size_t)cur.pn * tstep;
    S.a_ready(cur);
    if constexpr (SP2) {
        PG8_STAGE(PG8_SB(0, 0), cB, voffB); PG8_STAGE(PG8_SB(0, 1), cB + hstep, voffB); PG8_STAGE(PG8_SA(0, 0), cA, voffA); PG8_STAGE(PG8_SA(0, 1), cA + hstep, voffA);
        if (wr == 1) PG8_BAR;
        PG8_WAIT_V(2); PG8_BAR;
        PG8_STAGE(PG8_SB(1, 0), cB + kstepB, voffB); PG8_STAGE(PG8_SA(1, 0), cA + kstepA, voffA); PG8_STAGE(PG8_SB(1, 1), cB + hstep + kstepB, voffB);
        PG8_WAIT_V(6); PG8_BAR;
    } else {
        PG8_STAGE(PG8_SB(0, 0), cB, voffB); PG8_STAGE(PG8_SA(0, 0), cA, voffA); PG8_STAGE(PG8_SB(0, 1), cB + hstep, voffB); PG8_STAGE(PG8_SA(0, 1), cA + hstep, voffA);
        if (wr == 1) PG8_BAR;
        PG8_WAIT_V(4); PG8_BAR;
        PG8_STAGE(PG8_SB(1, 0), cB + kstepB, voffB); PG8_STAGE(PG8_SA(1, 0), cA + kstepA, voffA); PG8_STAGE(PG8_SB(1, 1), cB + hstep + kstepB, voffB);
        PG8_WAIT_V(6); PG8_BAR;
    }
    for (;;) {
        const bool has_next = S.next(ui + 1, nxt);
        const char* nA = has_next ? (const char*)g.A + (size_t)nxt.pm * tstep : cA; const char* nB = has_next ? (const char*)g.Bt + (size_t)nxt.pn * tstep : cB;
        for (int t = 0; t < nt; t += 2) {
            const bool last = (t == nt - 2);
            const char* a1 = cA + (size_t)(t + 1) * kstepA;
            const char* a2 = last ? nA : cA + (size_t)(t + 2) * kstepA; const char* b2 = last ? nB : cB + (size_t)(t + 2) * kstepB;
            const char* a3 = a2 + kstepA; const char* b3 = b2 + kstepB;
            if (last && has_next) S.a_ready(nxt);
            if constexpr (SP2) {
            PG8_LDB(B0, 0, 0); PG8_LDB(B1, 0, 1); PG8_SCHED; PG8_LDA(At, 0, 0); PG8_STAGE(PG8_SA(1, 1), a1 + hstep, voffA);
            PG8_WAIT_V(8); PG8_WAIT_L(0); PG8_BAR; PG8_MMA(0, 0, At, B0); PG8_MMA(0, 1, At, B1); PG8_BAR; PG8_SCHED;
            PG8_LDA(At, 0, 1); PG8_STAGE(PG8_SB(0, 0), b2, voffB); PG8_STAGE(PG8_SB(0, 1), b2 + hstep, voffB); PG8_STAGE(PG8_SA(0, 0), a2, voffA);
            PG8_WAIT_V(8); PG8_WAIT_L(0); PG8_BAR; PG8_MMA(1, 0, At, B0); PG8_MMA(1, 1, At, B1); PG8_BAR; PG8_SCHED;
            PG8_LDB(B0, 1, 0); PG8_LDB(B1, 1, 1); PG8_SCHED; PG8_LDA(At, 1, 0); PG8_STAGE(PG8_SA(0, 1), a2 + hstep, voffA);
            PG8_WAIT_V(8); PG8_WAIT_L(0); PG8_BAR; PG8_MMA(0, 0, At, B0); PG8_MMA(0, 1, At, B1); PG8_BAR; PG8_SCHED;
            PG8_LDA(At, 1, 1); PG8_STAGE(PG8_SB(1, 0), b3, voffB); PG8_STAGE(PG8_SB(1, 1), b3 + hstep, voffB); PG8_STAGE(PG8_SA(1, 0), a3, voffA);
            PG8_WAIT_V(8); PG8_WAIT_L(0); PG8_BAR; PG8_MMA(1, 0, At, B0); PG8_MMA(1, 1, At, B1); PG8_BAR; PG8_SCHED;
            } else {
            PG8_LDB(B0, 0, 0); PG8_SCHED; PG8_LDA(At, 0, 0); PG8_STAGE(PG8_SA(1, 1), a1 + hstep, voffA);
            PG8_WAIT_L(8); PG8_BAR; PG8_WAIT_L(0); PG8_MMA(0, 0, At, B0); PG8_BAR; PG8_SCHED;
            PG8_LDB(B1, 0, 1); PG8_STAGE(PG8_SB(0, 0), b2, voffB);
            PG8_BAR; PG8_WAIT_L(0); PG8_MMA(0, 1, At, B1); PG8_BAR;
            PG8_LDA(At, 0, 1); PG8_STAGE(PG8_SA(0, 0), a2, voffA);
            PG8_BAR; PG8_WAIT_L(0); PG8_MMA(1, 0, At, B0); PG8_BAR; PG8_SCHED;
            PG8_STAGE(PG8_SB(0, 1), b2 + hstep, voffB);
            PG8_WAIT_V(6); PG8_BAR; PG8_MMA(1, 1, At, B1); PG8_BAR;
            PG8_LDB(B0, 1, 0); PG8_SCHED; PG8_LDA(At, 1, 0); PG8_STAGE(PG8_SA(0, 1), a2 + hstep, voffA);
            PG8_WAIT_L(8); PG8_BAR; PG8_WAIT_L(0); PG8_MMA(0, 0, At, B0); PG8_BAR; PG8_SCHED;
            PG8_LDB(B1, 1, 1); PG8_STAGE(PG8_SB(1, 0), b3, voffB);
            PG8_BAR; PG8_WAIT_L(0); PG8_MMA(0, 1, At, B1); PG8_BAR;
            PG8_LDA(At, 1, 1); PG8_STAGE(PG8_SA(1, 0), a3, voffA);
            PG8_BAR; PG8_WAIT_L(0); PG8_MMA(1, 0, At, B0); PG8_BAR; PG8_SCHED;
            PG8_STAGE(PG8_SB(1, 1), b3 + hstep, voffB);
            PG8_WAIT_V(6); PG8_BAR; PG8_MMA(1, 1, At, B1); PG8_BAR;
            }
        }
        if constexpr (ALIGN_EPI) { if (wr == 0) PG8_BAR; }
        if constexpr (!Epi::AFTER_DRAIN) { E(acc, cur, wr, wc, fr, fq); if (SUBREP & 2048) asm volatile("s_waitcnt vmcnt(0)" ::: "memory"); if (SUBREP & 1024) { asm volatile("" ::: "memory"); E(acc, cur, wr, wc, fr, fq); } S.done(cur); }
        if (!has_next) break;
#pragma unroll
        for (int a = 0; a < 2; ++a)
#pragma unroll
            for (int b = 0; b < 2; ++b)
#pragma unroll
                for (int m = 0; m < 4; ++m)
#pragma unroll
                    for (int n = 0; n < 2; ++n) acc[a][b][m][n] = (f32x4){0.f, 0.f, 0.f, 0.f};
        cur = nxt; cA = nA; cB = nB; ++ui;
        if constexpr (ALIGN_EPI) { if (wr == 1) PG8_BAR; }
    }
    PG8_WAIT_V(0);
    if constexpr (!ALIGN_EPI) { if (wr == 0) PG8_BAR; }
    PG8_BAR;
    if constexpr (Epi::AFTER_DRAIN) { E.fused(acc, cur, wr, wc, fr, fq, lds, wid, lane); S.done(cur); }
#undef PG8_SA
#undef PG8_SB
#undef PG8_STAGE
#undef PG8_LDA
#undef PG8_LDB
#undef PG8_MMA
#undef PG8_WAIT_V
#undef PG8_WAIT_L
#undef PG8_BAR
#undef PG8_SCHED
}
}

namespace pg8 {
#define EPI_STORE16(p, v) (*(u32x4*)(p) = (v))
struct EpiSsdIn {
    static constexpr bool PERM = true, AFTER_DRAIN = false;
    bf16_t* ZX; float* DT; const float* rs;
    __device__ __forceinline__ void elem(int r, int c, float v) const { if (c < ZXW) ZX[(size_t)r * ZXW + c] = (bf16_t)f2bf(v); else DT[(size_t)r * 32 + (c - ZXW)] = v; }
    __device__ __forceinline__ void operator()(const f32x4 (&acc)[2][2][4][2], const Unit& u, int wr, int wc, int fr, int fq) const {
        const int row0 = u.pm * BM + wr * 64 + fr;
        if (u.pn < 24) {
            const int col0 = u.pn * BM + wc * 32 + 8 * fq;
#pragma unroll
            for (int ai = 0; ai < 2; ++ai)
#pragma unroll
                for (int m = 0; m < 4; ++m) { const int r = row0 + ai * HALF + m * 16; bf16_t* rowp = ZX + (size_t)r * ZXW + col0;
#pragma unroll
                    for (int bj = 0; bj < 2; ++bj) { const f32x4 v0 = acc[ai][bj][m][0], v1 = acc[ai][bj][m][1];
                        u32x4 w; w.x = cvt_pk_bf16(v0[0], v0[1]); w.y = cvt_pk_bf16(v0[2], v0[3]); w.z = cvt_pk_bf16(v1[0], v1[1]); w.w = cvt_pk_bf16(v1[2], v1[3]);
                        EPI_STORE16(rowp + bj * HALF, w); } }
        } else if (wc == 0) {
#pragma unroll
            for (int ai = 0; ai < 2; ++ai)
#pragma unroll
                for (int m = 0; m < 4; ++m) { const int r = row0 + ai * HALF + m * 16; float* p = DT + (size_t)r * 32 + 8 * fq;
                    *(f32x4*)p = acc[ai][0][m][0]; *(f32x4*)(p + 4) = acc[ai][0][m][1]; }
        }
    }
};
struct EpiLruIn {
    static constexpr bool PERM = true, AFTER_DRAIN = false;
    bf16_t* G; bf16_t* XRAW; const float* rs; const float* bias;
    __device__ __forceinline__ void elem(int r, int c, float v) const { v = v + bias[c]; if (c < DR) G[(size_t)r * DR + c] = (bf16_t)f2bf(gelu_tanh_f(v)); else XRAW[(size_t)r * DR + (c - DR)] = (bf16_t)f2bf(v); }
    __device__ __forceinline__ void operator()(const f32x4 (&acc)[2][2][4][2], const Unit& u, int wr, int wc, int fr, int fq) const {
        const int row0 = u.pm * BM + wr * 64 + fr, bcol0 = u.pn * BM + wc * 32 + 8 * fq; const bool gate = u.pn < 4;
        bf16_t* base = gate ? G : XRAW; const int col0 = (gate ? bcol0 : bcol0 - DR);
        f32x4 bv[2][2];
#pragma unroll
        for (int bj = 0; bj < 2; ++bj)
#pragma unroll
            for (int n = 0; n < 2; ++n) bv[bj][n] = *(const f32x4*)(bias + bcol0 + bj * HALF + 4 * n);
#pragma unroll
        for (int ai = 0; ai < 2; ++ai)
#pragma unroll
            for (int m = 0; m < 4; ++m) { const int r = row0 + ai * HALF + m * 16; bf16_t* rowp = base + (size_t)r * DR + col0;
#pragma unroll
                for (int bj = 0; bj < 2; ++bj) { f32x4 v0 = acc[ai][bj][m][0] + bv[bj][0], v1 = acc[ai][bj][m][1] + bv[bj][1];
                    if (gate) {
#pragma unroll
                        for (int j = 0; j < 4; ++j) { v0[j] = gelu_tanh_f(v0[j]); v1[j] = gelu_tanh_f(v1[j]); } }
                    u32x4 w; w.x = cvt_pk_bf16(v0[0], v0[1]); w.y = cvt_pk_bf16(v0[2], v0[3]); w.z = cvt_pk_bf16(v1[0], v1[1]); w.w = cvt_pk_bf16(v1[2], v1[3]);
                    EPI_STORE16(rowp + bj * HALF, w); } }
    }
};
struct EpiFfn1 {
    static constexpr bool PERM = true, AFTER_DRAIN = false;
    bf16_t* H1; const float* rs;
    __device__ __forceinline__ void elem(int r, int c, float v) const { v = fmaxf(v, 0.f); H1[(size_t)r * DFF + c] = (bf16_t)f2bf(v * v); }
    __device__ __forceinline__ void operator()(const f32x4 (&acc)[2][2][4][2], const Unit& u, int wr, int wc, int fr, int fq) const {
        const int row0 = u.pm * BM + wr * 64 + fr, col0 = u.pn * BM + wc * 32 + 8 * fq;
#pragma unroll
        for (int ai = 0; ai < 2; ++ai)
#pragma unroll
            for (int m = 0; m < 4; ++m) {
                bf16_t* tp = H1 + ((size_t)(u.pm * 16 + wr * 4 + ai * 8 + m) * (DFF / 32) + u.pn * 8 + wc) * 512 + (fr * 4 + fq) * 8;
#pragma unroll
                for (int bj = 0; bj < 2; ++bj) { f32x4 v0 = acc[ai][bj][m][0], v1 = acc[ai][bj][m][1];
#pragma unroll
                    for (int j = 0; j < 4; ++j) { v0[j] = fmaxf(v0[j], 0.f); v0[j] *= v0[j]; v1[j] = fmaxf(v1[j], 0.f); v1[j] *= v1[j]; }
                    u32x4 w; w.x = cvt_pk_bf16(v0[0], v0[1]); w.y = cvt_pk_bf16(v0[2], v0[3]); w.z = cvt_pk_bf16(v1[0], v1[1]); w.w = cvt_pk_bf16(v1[2], v1[3]);
                    EPI_STORE16(tp + bj * 4 * 512, w); } }
    }
};
struct EpiM {
    static constexpr bool PERM = true, AFTER_DRAIN = false;
    bf16_t* C; const float* bias;
    __device__ __forceinline__ void elem(int r, int c, float v) const { C[(size_t)r * DM + c] = (bf16_t)f2bf(v + (bias ? bias[c] : 0.f)); }
    __device__ __forceinline__ void operator()(const f32x4 (&acc)[2][2][4][2], const Unit& u, int wr, int wc, int fr, int fq) const {
        const int row0 = u.pm * BM + wr * 64 + fr, col0 = u.pn * BM + wc * 32 + 8 * fq;
        f32x4 bv[2][2];
#pragma unroll
        for (int bj = 0; bj < 2; ++bj)
#pragma unroll
            for (int n = 0; n < 2; ++n) bv[bj][n] = bias ? *(const f32x4*)(bias + col0 + bj * HALF + 4 * n) : (f32x4){0.f, 0.f, 0.f, 0.f};
#pragma unroll
        for (int ai = 0; ai < 2; ++ai)
#pragma unroll
            for (int m = 0; m < 4; ++m) { bf16_t* rowp = C + (size_t)(row0 + ai * HALF + m * 16) * DM + col0;
#pragma unroll
                for (int bj = 0; bj < 2; ++bj) { const f32x4 v0 = acc[ai][bj][m][0] + bv[bj][0], v1 = acc[ai][bj][m][1] + bv[bj][1];
                    u32x4 w; w.x = cvt_pk_bf16(v0[0], v0[1]); w.y = cvt_pk_bf16(v0[2], v0[3]); w.z = cvt_pk_bf16(v1[0], v1[1]); w.w = cvt_pk_bf16(v1[2], v1[3]);
                    EPI_STORE16(rowp + bj * HALF, w); } }
    }
};
}

constexpr int NWAVES = 8, NTHR = 512;
constexpr int RING_BYTES = 131072, LDS_BYTES = 153600;
constexpr int LDS_MISC_OFF = 152576;
constexpr int CW_BAR = 4096;
#ifndef TOUCH_W
#define TOUCH_W 0
#endif
#ifndef REP_MASK
#define REP_MASK 0
#endif
constexpr int PL = 9, NPH = 1 + 4 * PL;

struct Args { const float* in[N_IN]; float* out; unsigned char* ws; int ph_lo, ph_hi; };
__device__ __forceinline__ const float* arg_in(int k) {
    const auto ka = __builtin_amdgcn_kernarg_segment_ptr();
    unsigned long long p;
    asm volatile("s_load_dwordx2 %0, %1, %2\n\ts_waitcnt lgkmcnt(0)" : "=s"(p) : "s"(ka), "s"(k * 8) : "memory");
    return (const float*)p;
}

constexpr int TP_PITCH = 68, TP_WAVE_BYTES = 64 * TP_PITCH * 4;
__device__ __forceinline__ void p0_transpose_item(const float* W, int ldw, int N, int nblk, bf16* WT, int ldt, int row_off, const float* scale, LAS float* scr, int item, int lane) {
    const int kb = item / nblk, nb = item % nblk, k0 = 64 * kb, n0 = 64 * nb, c4 = 4 * (lane & 15), rq = lane >> 4;
    v4f v[16];
#pragma unroll
    for (int i = 0; i < 16; ++i) v[i] = (n0 + c4 < N) ? *(const GAS v4f*)(W + (size_t)(k0 + 4 * i + rq) * ldw + n0 + c4) : (v4f){0.f, 0.f, 0.f, 0.f};
#pragma unroll
    for (int i = 0; i < 16; ++i) { const float sc = scale ? scale[k0 + 4 * i + rq] : 1.f; *(LAS v4f*)(scr + (4 * i + rq) * TP_PITCH + ((c4 + 4 * (((4 * i + rq) >> 3) & 7)) & 63)) = v[i] * sc; }
    LDS_WAIT(); asm volatile("" ::: "memory");
    const int c = lane & 7;
#pragma unroll
    for (int jj = 0; jj < 8; ++jj) { const int n = (lane >> 3) + 8 * jj; const LAS float* sp = scr + (8 * c) * TP_PITCH + ((n + 4 * c) & 63);
        v4u o; o.x = pk2(sp[0 * TP_PITCH], sp[1 * TP_PITCH]); o.y = pk2(sp[2 * TP_PITCH], sp[3 * TP_PITCH]); o.z = pk2(sp[4 * TP_PITCH], sp[5 * TP_PITCH]); o.w = pk2(sp[6 * TP_PITCH], sp[7 * TP_PITCH]);
        const int ng = row_off + n0 + n, kk = k0 + 8 * c;
        const size_t eo = ldt > 128 ? ((size_t)(ng >> 4) * (ldt / 32) + (kk >> 5)) * 512 + ((ng & 15) * 4 + ((kk & 31) >> 3)) * 8 : (size_t)ng * ldt + kk;
        if (n0 + n < N) *(GAS v4u*)(WT + eo) = o; }
    LDS_WAIT(); asm volatile("" ::: "memory");
}
constexpr int IT_SIN = (DM / 64) * ((INDIM + 63) / 64), IT_SOUT = (DI / 64) * (DM / 64), IT_LIN = (DM / 64) * (2048 / 64), IT_LAX = 8 * 2 * 4, IT_LOUT = (DR / 64) * (DM / 64),
              IT_F1 = (DM / 64) * (DFF / 64), IT_F2 = (DFF / 64) * (DM / 64), IT_PAIR = IT_SIN + IT_SOUT + IT_LIN + IT_LAX + IT_LOUT + 2 * (IT_F1 + IT_F2);

__device__ __forceinline__ void p0_prologue(const Args& a, LAS unsigned char* lds, int gw, int NGW, int wave, int lane) {
    bf16* WB = (bf16*)(a.ws + WS_W);
    LAS float* scr = (LAS float*)(lds + wave * TP_WAVE_BYTES);
    for (int it = gw; it < 2 * IT_PAIR; it += NGW) {
        const int j = it / IT_PAIR; int r = it % IT_PAIR;
        bf16* ws_ssd = WB + WE_SSD0 + (size_t)j * WE_SEND; bf16* ws_lru = WB + WE_LRU0 + (size_t)j * WE_LEND;
        if (r < IT_SIN) { p0_transpose_item(arg_in(I_SWIN) + (size_t)j * DM * INDIM, INDIM, INDIM, (INDIM + 63) / 64, ws_ssd + WE_SIN, DM, 0, arg_in(I_NMPRE) + (size_t)(2 * j) * DM, scr, r, lane); continue; } r -= IT_SIN;
        if (r < IT_SOUT) { p0_transpose_item(arg_in(I_SWOUT) + (size_t)j * DI * DM, DM, DM, DM / 64, ws_ssd + WE_SOUT, DI, 0, arg_in(I_SNORM) + (size_t)j * DI, scr, r, lane); continue; } r -= IT_SOUT;
        if (r < IT_LIN) { p0_transpose_item(arg_in(I_LWIN) + (size_t)j * DM * 2048, 2048, 2048, 2048 / 64, ws_lru + WE_LIN, DM, 0, arg_in(I_NMPRE) + (size_t)(2 * j + 1) * DM, scr, r, lane); continue; } r -= IT_LIN;
        if (r < IT_LAX) { const int blk = r >> 3, mat = (r >> 2) & 1, sub = r & 3;
            p0_transpose_item(arg_in(mat ? I_LWX : I_LWA) + ((size_t)j * 8 + blk) * 128 * 128, 128, 128, 2, ws_lru + WE_LAX + (size_t)blk * 256 * 128, 128, mat * 128, nullptr, scr, sub, lane); continue; } r -= IT_LAX;
        if (r < IT_LOUT) { p0_transpose_item(arg_in(I_LWOUT) + (size_t)j * DR * DM, DM, DM, DM / 64, ws_lru + WE_LOUT, DR, 0, nullptr, scr, r, lane); continue; } r -= IT_LOUT;
        const int f = r / (IT_F1 + IT_F2), i = 2 * j + f; r -= f * (IT_F1 + IT_F2);
        bf16* ws_ffn = WB + WE_FFN0 + (size_t)i * WE_FEND;
        if (r < IT_F1) { p0_transpose_item(arg_in(I_W1) + (size_t)i * DM * DFF, DFF, DFF, DFF / 64, ws_ffn + WE_F1, DM, 0, arg_in(I_NFPRE) + (size_t)i * DM, scr, r, lane); continue; } r -= IT_F1;
        p0_transpose_item(arg_in(I_W2) + (size_t)i * DFF * DM, DM, DM, DM / 64, ws_ffn + WE_F2, DFF, 0, nullptr, scr, r, lane);
    }
    for (int idx = gw * 64 + lane; idx < 2 * (NPAD_SSD - INDIM) * DM / 8; idx += NGW * 64) { const int j = idx / ((NPAD_SSD - INDIM) * DM / 8), o = idx % ((NPAD_SSD - INDIM) * DM / 8);
        ((GAS v4u*)(WB + WE_SSD0 + (size_t)j * WE_SEND + WE_SIN + (size_t)INDIM * DM))[o] = (v4u){0u, 0u, 0u, 0u}; }
    for (int idx = gw * 64 + lane; idx < 2 * DR; idx += NGW * 64) ((float*)(a.ws + WS_LCF))[idx] = 8.0f * softplus_f(-arg_in(I_LLAM)[idx]);
    float* X = (float*)(a.ws + WS_X); bf16* XB = (bf16*)(a.ws + WS_XB); float* RS = (float*)(a.ws + WS_RS);
#define P0_SRC(r_) ((r_) < TP ? (((r_) % LP) < NMETA ? arg_in(I_META) + (size_t)((r_) % LP) * DM : arg_in(I_XP) + ((size_t)((r_) / LP) * SEQ + (((r_) % LP) - NMETA)) * DM) : arg_in(I_XS) + (size_t)((r_) - TP) * DM)
    v4f vn[4];
    if (gw < T) { const float* src = P0_SRC(gw);
#pragma unroll
        for (int j = 0; j < 4; ++j) vn[j] = ((const GAS v4f*)src)[lane + 64 * j]; }
    for (int r = gw; r < T; r += NGW) {
        v4f v[4]; float s = 0.f;
#pragma unroll
        for (int j = 0; j < 4; ++j) { v[j] = vn[j]; s += (v[j].x * v[j].x + v[j].y * v[j].y) + (v[j].z * v[j].z + v[j].w * v[j].w); }
        if (r + NGW < T) { const float* src = P0_SRC(r + NGW);
#pragma unroll
            for (int j = 0; j < 4; ++j) vn[j] = ((const GAS v4f*)src)[lane + 64 * j]; }
        const float msx = wave_sum(s) * (1.f / DM) + EPS, rsx = rsqrtf(msx);
        if (lane == 0) RS[r] = sqrtf(msx);
#pragma unroll
        for (int j = 0; j < 4; ++j) {
            ((GAS v2u*)(XB + (size_t)r * DM))[lane + 64 * j] = (v2u){pk2(v[j].x * rsx, v[j].y * rsx), pk2(v[j].z * rsx, v[j].w * rsx)}; }
    }
#undef P0_SRC
}
__device__ __forceinline__ void resid_phase(const Args& a, const float* g, bool last, int gw, int NGW, int lane) {
    bf16* XB = (bf16*)(a.ws + WS_XB); float* RS = (float*)(a.ws + WS_RS); const bf16* Mb = (const bf16*)(a.ws + WS_M);
    v4f gg[4];
#pragma unroll
    for (int j = 0; j < 4; ++j) gg[j] = ((const GAS v4f*)g)[lane + 64 * j];
    v2u mwn[4], xwn[4]; float invn = 0.f;
    if (gw < T) { invn = RS[gw];
#pragma unroll
        for (int j = 0; j < 4; ++j) { mwn[j] = ((const GAS v2u*)(Mb + (size_t)gw * DM))[lane + 64 * j]; xwn[j] = ((const GAS v2u*)(XB + (size_t)gw * DM))[lane + 64 * j]; } }
    for (int r = gw; r < T; r += NGW) {
        v4f m[4], x[4]; float s = 0.f; const float inv = invn;
#pragma unroll
        for (int j = 0; j < 4; ++j) { m[j] = (v4f){bflo(mwn[j].x), bfhi(mwn[j].x), bflo(mwn[j].y), bfhi(mwn[j].y)};
            x[j] = (v4f){bflo(xwn[j].x), bfhi(xwn[j].x), bflo(xwn[j].y), bfhi(xwn[j].y)} * inv;
            s += (m[j].x * m[j].x + m[j].y * m[j].y) + (m[j].z * m[j].z + m[j].w * m[j].w); }
        if (r + NGW < T) { invn = RS[r + NGW];
#pragma unroll
            for (int j = 0; j < 4; ++j) { mwn[j] = ((const GAS v2u*)(Mb + (size_t)(r + NGW) * DM))[lane + 64 * j]; xwn[j] = ((const GAS v2u*)(XB + (size_t)(r + NGW) * DM))[lane + 64 * j]; } }
        const float rm = rsqrtf(wave_sum(s) * (1.f / DM) + EPS); float s2 = 0.f;
#pragma unroll
        for (int j = 0; j < 4; ++j) { x[j] = x[j] + m[j] * rm * gg[j]; s2 += (x[j].x * x[j].x + x[j].y * x[j].y) + (x[j].z * x[j].z + x[j].w * x[j].w); }
        s2 = wave_sum(s2);
        if (!last) {
            const float msx = s2 * (1.f / DM) + EPS, rsx = rsqrtf(msx);
            if (lane == 0) RS[r] = sqrtf(msx);
#pragma unroll
            for (int j = 0; j < 4; ++j) ((GAS v2u*)(XB + (size_t)r * DM))[lane + 64 * j] = (v2u){pk2(x[j].x * rsx, x[j].y * rsx), pk2(x[j].z * rsx, x[j].w * rsx)};
        } else {
            float* dst = nullptr;
            if (r < TP) { const int b = r / LP, t = r % LP; if (t >= NMETA) dst = a.out + O_YP + ((size_t)b * SEQ + (t - NMETA)) * DM; }
            else dst = a.out + O_YS + (size_t)(r - TP) * DM;
            if (dst) {
#pragma unroll
                for (int j = 0; j < 4; ++j) ((GAS v4f*)dst)[lane + 64 * j] = x[j]; }
        }
    }
}


#ifndef SUBREP
#define SUBREP 0
#endif
typedef short bf16x8 __attribute__((ext_vector_type(8)));
typedef short bf16x4 __attribute__((ext_vector_type(4)));
constexpr int NCH = 17, N_CITEMS = NB * NCH * NG;
constexpr int YSP = 264;
constexpr int XS = 136;
constexpr size_t SC_CST = 0;
constexpr size_t SC_HPREV = SC_CST + (size_t)NB * NCH * NH * HD * NST * 2;
constexpr size_t SC_DEC = SC_HPREV + (size_t)NB * NCH * NH * HD * NST * 2;
constexpr size_t SC_XC = SC_DEC + 65536;
constexpr size_t SC_BC = SC_XC + (size_t)N_CITEMS * 256 * 128 * 2;
constexpr size_t SC_END = SC_BC + (size_t)N_CITEMS * 2 * 128 * 128 * 2;
static_assert(SC_END <= 400 * MiB, "ssd scratch");

struct SsdItem { int b, c, g, Q, row0; };
__device__ __forceinline__ SsdItem ssd_item(int item) { SsdItem it; it.g = item % NG;
    if (item < NB * 16 * NG) { it.c = 1 + (item / NG) % 16; it.b = item / (NG * 16); } else { it.c = 0; it.b = (item - NB * 16 * NG) / NG; }
    it.Q = it.c == 0 ? NMETA : 128; it.row0 = it.b * LP + (it.c == 0 ? 0 : NMETA + 128 * (it.c - 1)); return it; }

struct DtRaw { float r0, r1; };
__device__ __forceinline__ DtRaw ssd_dt_load(const float* DT, int row0, int Q, int h, int lane) { DtRaw d; d.r0 = 0.f; d.r1 = 0.f;
    if (lane < Q) d.r0 = DT[(size_t)(row0 + lane) * 32 + h];
    if (lane + 64 < Q) d.r1 = DT[(size_t)(row0 + lane + 64) * 32 + h];
    return d; }
__device__ __forceinline__ float ssd_dt_finish(const DtRaw dr, int Q, float dtb, float Aneg, LAS float* dtl, LAS float* csl, int lane) {
    float d0 = 0.f, d1 = 0.f;
    if (lane < Q) d0 = softplus_f(dr.r0 + dtb);
    if (lane + 64 < Q) d1 = softplus_f(dr.r1 + dtb);
    float a0 = d0 * Aneg, a1 = d1 * Aneg;
#pragma unroll
    for (int o = 1; o < 64; o <<= 1) { const float t0 = __shfl_up(a0, o), t1 = __shfl_up(a1, o); if (lane >= o) { a0 += t0; a1 += t1; } }
    const float tot0 = __shfl(a0, 63); a1 += tot0;
    const float tot = __shfl(a1, 63);
    dtl[lane] = d0; dtl[lane + 64] = d1; csl[lane] = a0; csl[lane + 64] = a1;
    return tot;
}
__device__ __forceinline__ float ssd_dt_cs(const float* DT, int row0, int Q, int h, float dtb, float Aneg, LAS float* dtl, LAS float* csl, int lane) {
    return ssd_dt_finish(ssd_dt_load(DT, row0, Q, h, lane), Q, dtb, Aneg, dtl, csl, lane); }


__device__ __forceinline__ float bf_elem(const v4u& w, int k) { const unsigned x = k < 2 ? w.x : k < 4 ? w.y : k < 6 ? w.z : w.w; return (k & 1) ? bfhi(x) : bflo(x); }
#define XT_SWZ(row) (((row) >> 4) & 7)
struct NoMid { __device__ __forceinline__ void operator()() const {} };
template <bool ROWMAJOR, class Mid>
__device__ __forceinline__ void ssd_conv_lane(const bf16* src  , bool hasprev, const float* cw, const float* cb, int cc, LAS bf16* dst, int s0, int swz, float* cso  , int Q, const Mid& mid, const v4u (&raw)[19]) {
    v4f wv[4][2], bv[2];
#pragma unroll
    for (int t = 0; t < 4; ++t) { wv[t][0] = *(const GAS v4f*)(cw + (size_t)t * CONVD + cc); wv[t][1] = *(const GAS v4f*)(cw + (size_t)t * CONVD + cc + 4); }
    bv[0] = *(const GAS v4f*)(cb + cc); bv[1] = *(const GAS v4f*)(cb + cc + 4);
    mid();
    if (cso) {
#pragma unroll
        for (int i = 0; i < 3; ++i) { float* o = cso + (size_t)i * CONVD + cc; const v4u w = raw[16 + i];
            *(GAS v4f*)o = (v4f){bflo(w.x), bfhi(w.x), bflo(w.y), bfhi(w.y)}; *(GAS v4f*)(o + 4) = (v4f){bflo(w.z), bfhi(w.z), bflo(w.w), bfhi(w.w)}; } }
#define RAW2(i) ((v2f){bf_elem(raw[i], k), bf_elem(raw[i], k + 1)})
#define CW2(t) ((v2f){wv[t][k >> 2][k & 3], wv[t][k >> 2][(k & 3) + 1]})
    if (!ROWMAJOR) {
        const int c0 = s0 >> 3;
#pragma unroll
        for (int kp = 0; kp < 4; ++kp) { const int k = 2 * kp;
            const v2f w0 = CW2(0), w1 = CW2(1), w2 = CW2(2), w3 = CW2(3), bb = (v2f){bv[k >> 2][k & 3], bv[k >> 2][(k & 3) + 1]};
            v2f x0 = RAW2(0), x1 = RAW2(1), x2 = RAW2(2);
            unsigned pa[4], pb[4]; v2f pv = (v2f){0.f, 0.f}; LAS bf16* d0 = dst + k * XS; LAS bf16* d1 = d0 + XS;
#pragma unroll
            for (int i = 0; i < 16; ++i) { const v2f x3 = RAW2(3 + i);
                const v2f t = bb + w0 * x0 + w1 * x1 + w2 * x2 + w3 * x3;
                v2f e; e.x = __expf(-t.x); e.y = __expf(-t.y); e = e + 1.0f;
                v2f rr; rr.x = __builtin_amdgcn_rcpf(e.x); rr.y = __builtin_amdgcn_rcpf(e.y);
                const v2f v = t * rr;
                if (i & 1) { pa[(i >> 1) & 3] = pg8::cvt_pk_bf16(pv.x, v.x); pb[(i >> 1) & 3] = pg8::cvt_pk_bf16(pv.y, v.y);
                    if ((i & 7) == 7) { const int co = 8 * ((c0 + (i >> 3)) ^ swz); *(LAS v4u*)(d0 + co) = (v4u){pa[0], pa[1], pa[2], pa[3]}; *(LAS v4u*)(d1 + co) = (v4u){pb[0], pb[1], pb[2], pb[3]}; } } else pv = v;
                x0 = x1; x1 = x2; x2 = x3; }
            if (Q < 32) { const int z0 = 8 * ((c0 + 2) ^ swz), z1 = 8 * ((c0 + 3) ^ swz);
                *(LAS v4u*)(d0 + z0) = (v4u){0u, 0u, 0u, 0u}; *(LAS v4u*)(d0 + z1) = (v4u){0u, 0u, 0u, 0u}; *(LAS v4u*)(d1 + z0) = (v4u){0u, 0u, 0u, 0u}; *(LAS v4u*)(d1 + z1) = (v4u){0u, 0u, 0u, 0u}; }
            __builtin_amdgcn_sched_barrier(0); }
    } else {
        v2f xa[4], xb[4], xc[4];
#pragma unroll
        for (int kp = 0; kp < 4; ++kp) { const int k = 2 * kp; xa[kp] = RAW2(0); xb[kp] = RAW2(1); xc[kp] = RAW2(2); }
#pragma unroll
        for (int i = 0; i < 16; ++i) { unsigned o[4];
#pragma unroll
            for (int kp = 0; kp < 4; ++kp) { const int k = 2 * kp; const v2f x3 = RAW2(3 + i);
                const v2f t = (v2f){bv[k >> 2][k & 3], bv[k >> 2][(k & 3) + 1]} + CW2(0) * xa[kp] + CW2(1) * xb[kp] + CW2(2) * xc[kp] + CW2(3) * x3;
                v2f e; e.x = __expf(-t.x); e.y = __expf(-t.y); e = e + 1.0f;
                v2f rr; rr.x = __builtin_amdgcn_rcpf(e.x); rr.y = __builtin_amdgcn_rcpf(e.y);
                const v2f v = t * rr; o[kp] = pg8::cvt_pk_bf16(v.x, v.y);
                xa[kp] = xb[kp]; xb[kp] = xc[kp]; xc[kp] = x3; }
            *(LAS v4u*)(dst + i * XS) = (v4u){o[0], o[1], o[2], o[3]};
            if ((i & 3) == 3) __builtin_amdgcn_sched_barrier(0); }
    }
#undef CW2
#undef RAW2
}
__device__ __forceinline__ void ssd_conv_lane_bc(const bf16* src, bool hasprev, const float* cw, const float* cb, int cc, bf16* gdst  , bool toT,
                                                 LAS bf16* dstT  , int s0, int swz, float* cso  , int Q, const v4u (&raw)[19]) {
    v4f wv[4][2], bv[2];
#pragma unroll
    for (int t = 0; t < 4; ++t) { wv[t][0] = *(const GAS v4f*)(cw + (size_t)t * CONVD + cc); wv[t][1] = *(const GAS v4f*)(cw + (size_t)t * CONVD + cc + 4); }
    bv[0] = *(const GAS v4f*)(cb + cc); bv[1] = *(const GAS v4f*)(cb + cc + 4);
    if (cso) {
#pragma unroll
        for (int i = 0; i < 3; ++i) { float* o = cso + (size_t)i * CONVD + cc; const v4u w = raw[16 + i];
            *(GAS v4f*)o = (v4f){bflo(w.x), bfhi(w.x), bflo(w.y), bfhi(w.y)}; *(GAS v4f*)(o + 4) = (v4f){bflo(w.z), bfhi(w.z), bflo(w.w), bfhi(w.w)}; } }
#define RAW2(i) ((v2f){bf_elem(raw[i], k), bf_elem(raw[i], k + 1)})
#define CW2(t) ((v2f){wv[t][k >> 2][k & 3], wv[t][k >> 2][(k & 3) + 1]})
    const int c0 = s0 >> 3;
    v2f xa[4], xb[4], xc[4], pv[4];
    unsigned pw[8][2];
#pragma unroll
    for (int kp = 0; kp < 4; ++kp) { const int k = 2 * kp; xa[kp] = RAW2(0); xb[kp] = RAW2(1); xc[kp] = RAW2(2); pv[kp] = (v2f){0.f, 0.f}; }
#pragma unroll
    for (int i = 0; i < 16; ++i) { unsigned o[4];
#pragma unroll
        for (int kp = 0; kp < 4; ++kp) { const int k = 2 * kp; const v2f x3 = RAW2(3 + i);
            const v2f t = (v2f){bv[k >> 2][k & 3], bv[k >> 2][(k & 3) + 1]} + CW2(0) * xa[kp] + CW2(1) * xb[kp] + CW2(2) * xc[kp] + CW2(3) * x3;
            v2f e; e.x = __expf(-t.x); e.y = __expf(-t.y); e = e + 1.0f;
            v2f rr; rr.x = __builtin_amdgcn_rcpf(e.x); rr.y = __builtin_amdgcn_rcpf(e.y);
            const v2f v = t * rr; o[kp] = pg8::cvt_pk_bf16(v.x, v.y);
            if (i & 1) { pw[k][(i >> 1) & 1] = pg8::cvt_pk_bf16(pv[kp].x, v.x); pw[k + 1][(i >> 1) & 1] = pg8::cvt_pk_bf16(pv[kp].y, v.y); } else pv[kp] = v;
            xa[kp] = xb[kp]; xb[kp] = xc[kp]; xc[kp] = x3; }
        *(GAS v4u*)(gdst + (size_t)i * 128) = (v4u){o[0], o[1], o[2], o[3]};
        if ((i & 3) == 3 && toT) { const int co = 8 * ((c0 + (i >> 3)) ^ swz) + 4 * ((i >> 2) & 1);
#pragma unroll
            for (int ch = 0; ch < 8; ++ch) *(LAS v2u*)(dstT + ch * XS + co) = (v2u){pw[ch][0], pw[ch][1]}; }
        if ((i & 3) == 3) __builtin_amdgcn_sched_barrier(0); }
    if (Q < 32 && toT) { const int z0 = 8 * ((c0 + 2) ^ swz), z1 = 8 * ((c0 + 3) ^ swz);
#pragma unroll
        for (int ch = 0; ch < 8; ++ch) { *(LAS v4u*)(dstT + ch * XS + z0) = (v4u){0u, 0u, 0u, 0u}; *(LAS v4u*)(dstT + ch * XS + z1) = (v4u){0u, 0u, 0u, 0u}; } }
#undef CW2
#undef RAW2
}
__device__ __forceinline__ void ssd_conv_issue(const bf16* ZX, int row0, int g, int Q, bool hasprev_chunk, int lane, int wave, v4u (&raw)[19]) {
    const int cg = lane & 31, rh = lane >> 5, wq = wave & 3, s0 = 32 * wq + 16 * rh; const bool isx = wave < 4;
    const int cc = isx ? 256 * g + 8 * cg : (cg < 16 ? DI + 128 * g + 8 * cg : DI + NG * NST + 128 * g + 8 * (cg - 16));
    const int s0c = s0 < Q ? s0 : 0;
    const bf16* src = ZX + (size_t)(row0 + s0c) * ZXW + DI + cc; const bool hasprev = hasprev_chunk || s0c > 0;
#pragma unroll
    for (int i = 0; i < 3; ++i) { const v4u t = *(const GAS v4u*)(src + (ptrdiff_t)(hasprev ? i - 3 : 0) * ZXW); raw[i] = hasprev ? t : (v4u){0u, 0u, 0u, 0u}; }
#pragma unroll
    for (int i = 0; i < 16; ++i) raw[3 + i] = *(const GAS v4u*)(src + (size_t)i * ZXW);
}
template <class Mid>
__device__ __forceinline__ void ssd_conv_tile_a(const bf16* ZX, int row0, int g, int Q, bool hasprev, const float* cw, const float* cb, LAS bf16* XT, LAS bf16* BT, bf16* gBC,
                                                float* cso_base, int lane, int wave, const Mid& mid, const v4u (&raw)[19]) {
    const int cg = lane & 31, rh = lane >> 5, wq = wave & 3, s0 = 32 * wq + 16 * rh; const bool isx = wave < 4;
    const bool active = s0 < Q;
    const int cc = isx ? 256 * g + 8 * cg : (cg < 16 ? DI + 128 * g + 8 * cg : DI + NG * NST + 128 * g + 8 * (cg - 16));
    const bf16* src = ZX + (size_t)(row0 + s0) * ZXW + DI + cc;
    float* cso = (cso_base && s0 + 16 == Q) ? cso_base : nullptr;
    if (isx) { if (active) ssd_conv_lane<false>(src, hasprev || s0 > 0, cw, cb, cc, XT + (8 * cg) * XS, s0, XT_SWZ(8 * cg), cso, Q, mid, raw); }
    else { if (active) ssd_conv_lane_bc(src, hasprev || s0 > 0, cw, cb, cc, gBC + (cg < 16 ? 0 : 128 * 128) + (size_t)s0 * 128 + 8 * (cg & 15), cg < 16, BT + (8 * (cg & 15)) * XS, s0, XT_SWZ(8 * (cg & 15)), cso, Q, raw); }
}

__device__ __forceinline__ void ssd_phase_a(unsigned char* ws, float* out, LAS unsigned char* lds, int j, int tid, int lane, int wave) {
    const bf16* ZX = (const bf16*)(ws + WS_ZX); const float* DT = (const float*)(ws + WS_DT); bf16* YN = (bf16*)(ws + WS_YN);
    bf16* CST = (bf16*)(ws + WS_SCR + SC_CST); float* DEC = (float*)(ws + WS_SCR + SC_DEC); bf16* XC = (bf16*)(ws + WS_SCR + SC_XC); bf16* BC = (bf16*)(ws + WS_SCR + SC_BC);
    const float* cw = arg_in(I_SCW) + (size_t)j * 4 * CONVD; const float* cb = arg_in(I_SCB) + (size_t)j * CONVD;
    const float* dtbias = arg_in(I_SDTB) + j * NH; const float* alog = arg_in(I_SALOG) + j * NH; const float* dsk = arg_in(I_SD) + j * NH;
    LAS bf16* XWT = (LAS bf16*)lds;
    LAS bf16* BT = XWT + 256 * XS;
    LAS float* DTL = (LAS float*)(BT + 128 * XS);
    LAS float* CSL = DTL + 512;
    LAS float* WL = CSL + 512;
    const int tid0 = tid;
    const int n_all = N_CITEMS + NS * NG;
    v4u raw[19]; DtRaw dr; dr.r0 = 0.f; dr.r1 = 0.f;
    int item = blockIdx.x;
    if (item < N_CITEMS) { const SsdItem it0 = ssd_item(item); int tid_ = tid0; asm volatile("" : "+v"(tid_));
        if (wave < 4) dr = ssd_dt_load(DT, it0.row0, it0.Q, 4 * it0.g + (wave & 3), tid_ & 63);
        ssd_conv_issue(ZX, it0.row0, it0.g, it0.Q, it0.c > 0, tid_ & 63, wave, raw); }
    for (; item < N_CITEMS; item += gridDim.x) {
        int tid = tid0; asm volatile("" : "+v"(tid));
        const int lane = tid & 63, fr = lane & 15, fq = lane >> 4;
        __syncthreads();
        {
            const SsdItem it = ssd_item(item); const int Q = it.Q;
            { const bool fuse = Q == 128; const int hq = 4 * it.g + (wave & 3); const float dtb_ = dtbias[hq], an_ = -__expf(alog[hq]);
              auto dtwork = [&](const DtRaw& d_) { const int hh = wave; const float tot = ssd_dt_finish(d_, Q, dtb_, an_, DTL + hh * 128, CSL + hh * 128, lane);
                  LDS_WAIT();
                  WL[hh * 128 + lane] = DTL[hh * 128 + lane] * __expf(tot - CSL[hh * 128 + lane]);
                  WL[hh * 128 + lane + 64] = DTL[hh * 128 + lane + 64] * __expf(tot - CSL[hh * 128 + lane + 64]);
                  if (lane == 0) DEC[(it.b * NCH + it.c) * NH + hq] = __expf(tot); };
              if (wave < 4 && !fuse) dtwork(dr);
              auto mid = [&]() { if (fuse) dtwork(dr); };
              float* cso = (it.c == NCH - 1) ? out + O_PSC + (((size_t)j * NB + it.b) * 3) * CONVD : nullptr;
              ssd_conv_tile_a(ZX, it.row0, it.g, Q, it.c > 0, cw, cb, XWT, BT, BC + (size_t)item * 2 * 128 * 128, cso, lane, wave, mid, raw); }
            __syncthreads();
            { bf16* xg = XC + (size_t)item * 256 * 128 + (size_t)(32 * wave) * 128;
#pragma unroll
              for (int i = 0; i < 8; ++i) { const int rr = 4 * i + (lane >> 4), c16 = lane & 15;
                  *(GAS v4u*)(xg + rr * 128 + 8 * c16) = *(const LAS v4u*)(XWT + (32 * wave + rr) * XS + 8 * c16); } }
            {
            pg8::f32x4 acc[2][8];
#pragma unroll
            for (int mi = 0; mi < 2; ++mi)
#pragma unroll
                for (int ni = 0; ni < 8; ++ni) acc[mi][ni] = (pg8::f32x4){0.f, 0.f, 0.f, 0.f};
            const int nkb = Q < 32 ? 1 : Q / 32;
            for (int kb = 0; kb < nkb; ++kb) {
                bf16x8 a[2], bq[8];
#pragma unroll
                for (int mi = 0; mi < 2; ++mi) a[mi] = *(const LAS bf16x8*)(XWT + (32 * wave + 16 * mi + fr) * XS + 8 * ((4 * kb + fq) ^ XT_SWZ(32 * wave + 16 * mi)));
                { const LAS float* wlp = WL + (wave >> 1) * 128 + 32 * kb + 8 * fq;
                  const v4f wa = *(const LAS v4f*)wlp, wb = *(const LAS v4f*)(wlp + 4);
#pragma unroll
                  for (int mi = 0; mi < 2; ++mi) { const v4u xa = __builtin_bit_cast(v4u, a[mi]);
                      a[mi] = __builtin_bit_cast(bf16x8, (v4u){pg8::cvt_pk_bf16(bflo(xa.x) * wa.x, bfhi(xa.x) * wa.y), pg8::cvt_pk_bf16(bflo(xa.y) * wa.z, bfhi(xa.y) * wa.w),
                                                               pg8::cvt_pk_bf16(bflo(xa.z) * wb.x, bfhi(xa.z) * wb.y), pg8::cvt_pk_bf16(bflo(xa.w) * wb.z, bfhi(xa.w) * wb.w)}); } }
#pragma unroll
                for (int ni = 0; ni < 8; ++ni) bq[ni] = *(const LAS bf16x8*)(BT + (16 * ni + fr) * XS + 8 * ((4 * kb + fq) ^ XT_SWZ(16 * ni)));
#pragma unroll
                for (int mi = 0; mi < 2; ++mi)
#pragma unroll
                    for (int ni = 0; ni < 8; ++ni) acc[mi][ni] = __builtin_amdgcn_mfma_f32_16x16x32_bf16(bq[ni], a[mi], acc[mi][ni], 0, 0, 0);
            }
            { LAS bf16* stg = XWT + (32 * wave) * XS;
#pragma unroll
              for (int mi = 0; mi < 2; ++mi)
#pragma unroll
                for (int ni = 0; ni < 8; ++ni) *(LAS v2u*)(stg + (16 * mi + fr) * XS + 16 * ni + 4 * fq) = (v2u){pg8::cvt_pk_bf16(acc[mi][ni][0], acc[mi][ni][1]), pg8::cvt_pk_bf16(acc[mi][ni][2], acc[mi][ni][3])};
              __builtin_amdgcn_sched_barrier(0);
              { const int nxt_ = item + (int)gridDim.x < N_CITEMS ? item + (int)gridDim.x : item; const SsdItem itn = ssd_item(nxt_);
                if (wave < 4) dr = ssd_dt_load(DT, itn.row0, itn.Q, 4 * itn.g + (wave & 3), lane);
                ssd_conv_issue(ZX, itn.row0, itn.g, itn.Q, itn.c > 0, lane, wave, raw); }
              __builtin_amdgcn_sched_barrier(0);
              const int hp0 = 32 * wave, h = 4 * it.g + (hp0 >> 6), p0 = hp0 & 63;
              bf16* dstb = CST + ((((size_t)(it.b * NCH + it.c) * NH + h) * HD + p0) * NST);
#pragma unroll
              for (int i = 0; i < 8; ++i) { const int rr = 4 * i + (lane >> 4), c16 = lane & 15;
                  *(GAS v4u*)(dstb + rr * NST + 8 * c16) = *(const LAS v4u*)(stg + rr * XS + 8 * c16); } }
            }
        }
    }
    for (; item < n_all; item += gridDim.x) {
        int tid = tid0; asm volatile("" : "+v"(tid));
        const int lane = tid & 63;
        __syncthreads();
        {
            const int si = (item - N_CITEMS) / NG, g = (item - N_CITEMS) % NG, row = TP + si;
            LAS float* xs = (LAS float*)lds; LAS float* Bsm = xs + 256; LAS float* Csm = Bsm + 128; LAS float* dtv = Csm + 128; LAS float* dAv = dtv + 4; LAS float* yv = dAv + 4;
            { const int cc = tid < 256 ? 256 * g + tid : (tid < 384 ? DI + 128 * g + (tid - 256) : DI + NG * NST + 128 * g + (tid - 384));
              const float* sp = arg_in(I_SSC) + (((size_t)j * NS + si) * 3) * CONVD + cc;
              const float s0 = sp[0], s1 = sp[CONVD], s2 = sp[2 * CONVD], x3 = bf2f(ZX[(size_t)row * ZXW + DI + cc]);
              const float v = silu_f(cb[cc] + cw[cc] * s0 + cw[CONVD + cc] * s1 + cw[2 * CONVD + cc] * s2 + cw[3 * CONVD + cc] * x3);
              xs[tid] = v;
              float* op = out + O_SSC + (((size_t)j * NS + si) * 3) * CONVD + cc; op[0] = s1; op[CONVD] = s2; op[2 * CONVD] = x3; }
            if (tid < 4) { const int h = 4 * g + tid; const float d = softplus_f(DT[(size_t)row * 32 + h] + dtbias[h]); dtv[tid] = d; dAv[tid] = __expf(-d * __expf(alog[h])); }
            __syncthreads();
            v2u zz_ = (v2u){0u, 0u}; if (wave == 0) zz_ = *(const GAS v2u*)(ZX + (size_t)row * ZXW + 256 * g + 4 * lane);
            { const int r = wave >> 1, h = 4 * g + r; const float d = dtv[r], dA = dAv[r], Dh = dsk[h];
              const v2f Bv = *(const LAS v2f*)(Bsm + 2 * lane), Cv = *(const LAS v2f*)(Csm + 2 * lane);
              const float* h0 = arg_in(I_SSH) + ((((size_t)j * NS + si) * NH + h) * HD + 32 * (wave & 1)) * NST; float* ho = out + O_SSH + ((((size_t)j * NS + si) * NH + h) * HD + 32 * (wave & 1)) * NST;
              LAS float* PR = (LAS float*)(lds + 8192) + wave * (32 * 65);
              v2f hv[32];
#pragma unroll
              for (int pp = 0; pp < 32; ++pp) hv[pp] = *(const GAS v2f*)(h0 + (size_t)pp * NST + 2 * lane);
#pragma unroll
              for (int pp = 0; pp < 32; ++pp) { const float xdt = xs[64 * r + 32 * (wave & 1) + pp] * d;
                  hv[pp].x = fmaf(hv[pp].x, dA, xdt * Bv.x); hv[pp].y = fmaf(hv[pp].y, dA, xdt * Bv.y);
                  __builtin_nontemporal_store(hv[pp], (GAS v2f*)(ho + (size_t)pp * NST + 2 * lane));
                  PR[pp * 65 + lane] = Cv.x * hv[pp].x + Cv.y * hv[pp].y; }
              LDS_WAIT();
              if (lane < 32) { float y = 0.f;
#pragma unroll 16
                  for (int k = 0; k < 64; ++k) y += PR[lane * 65 + k];
                  const int p = 32 * (wave & 1) + lane; yv[64 * r + p] = y + Dh * xs[64 * r + p]; } }
            __syncthreads();
            if (wave == 0) { const int c0 = 256 * g + 4 * lane; const v2u zz = zz_;
                const v4f y = *(const LAS v4f*)(yv + 4 * lane);
                const float v0 = y.x * silu_f(bflo(zz.x)), v1 = y.y * silu_f(bfhi(zz.x)), v2 = y.z * silu_f(bflo(zz.y)), v3 = y.w * silu_f(bfhi(zz.y));
                const float rs = rsqrtf(wave_sum(v0 * v0 + v1 * v1 + v2 * v2 + v3 * v3) * (1.f / 256.f) + EPS);
                *(GAS v2u*)(YN + (size_t)row * DI + c0) = (v2u){pk2(v0 * rs, v1 * rs), pk2(v2 * rs, v3 * rs)}; }
        }
    }
}

__device__ __forceinline__ void ssd_phase_b(unsigned char* ws, float* out, int j, int tid) {
    const bf16* CST = (const bf16*)(ws + WS_SCR + SC_CST); const float* DEC = (const float*)(ws + WS_SCR + SC_DEC); bf16* HPREV = (bf16*)(ws + WS_SCR + SC_HPREV);
    constexpr int PER_B = NH * HD * NST / 8;
    for (int idx = blockIdx.x * NTHR + tid; idx < NB * PER_B; idx += gridDim.x * NTHR) {
        const int b = idx / PER_B, e = (idx % PER_B) * 8, h = e / (HD * NST);
        v4f H0 = (v4f){0.f, 0.f, 0.f, 0.f}, H1 = H0;
#pragma unroll 4
        for (int c = 0; c < NCH; ++c) {
            const size_t off = (size_t)(b * NCH + c) * (NH * HD * NST) + e;
            if (c > 0) *(GAS v4u*)(HPREV + off) = (v4u){pk2(H0.x, H0.y), pk2(H0.z, H0.w), pk2(H1.x, H1.y), pk2(H1.z, H1.w)};
            const float dec = DEC[(b * NCH + c) * NH + h];
            const v4u sw = *(const GAS v4u*)(CST + off); const v4f s0 = (v4f){bflo(sw.x), bfhi(sw.x), bflo(sw.y), bfhi(sw.y)}, s1 = (v4f){bflo(sw.z), bfhi(sw.z), bflo(sw.w), bfhi(sw.w)};
            H0 = H0 * dec + s0; H1 = H1 * dec + s1;
        }
        float* op = out + O_PSH + ((size_t)j * NB + b) * (NH * HD * NST) + e;
        *(GAS v4f*)op = H0; *(GAS v4f*)(op + 4) = H1;
    }
}

__device__ __forceinline__ void ssd_phase_c(unsigned char* ws, float* out, LAS unsigned char* lds, int j, int tid0, int, int wave) {
    const bf16* ZX = (const bf16*)(ws + WS_ZX); const float* DT = (const float*)(ws + WS_DT); bf16* YN = (bf16*)(ws + WS_YN);
    const bf16* HPREV = (const bf16*)(ws + WS_SCR + SC_HPREV); const bf16* XC = (const bf16*)(ws + WS_SCR + SC_XC); const bf16* BC = (const bf16*)(ws + WS_SCR + SC_BC);
    const float* dtbias = arg_in(I_SDTB) + j * NH; const float* alog = arg_in(I_SALOG) + j * NH; const float* dsk = arg_in(I_SD) + j * NH;
    LAS bf16* XT = (LAS bf16*)lds;
    LAS bf16* Bs = XT + 256 * XS;
    LAS bf16* Cs = Bs + 128 * XS;
    LAS float* DTL = (LAS float*)(Cs + 128 * XS);
    LAS float* CSL = DTL + 512;
    v4u tx[8], tb[4], tc[4]; DtRaw dr; dr.r0 = 0.f; dr.r1 = 0.f;
#define SC_ISSUE(item_) { const SsdItem it_ = ssd_item(item_); int tid_ = tid0; asm volatile("" : "+v"(tid_)); const int lr_ = tid_ >> 4, lc_ = tid_ & 15; \
        const bf16* xg_ = XC + (size_t)(item_) * 256 * 128; const bf16* bg_ = BC + (size_t)(item_) * 2 * 128 * 128; \
        if (wave < 4) dr = ssd_dt_load(DT, it_.row0, it_.Q, 4 * it_.g + (wave & 3), tid_ & 63); \
        _Pragma("unroll") for (int i = 0; i < 8; ++i) tx[i] = *(const GAS v4u*)(xg_ + (size_t)(32 * i + lr_) * 128 + 8 * lc_); \
        _Pragma("unroll") for (int i = 0; i < 4; ++i) { const int r_ = 32 * i + lr_; const bool ok_ = r_ < it_.Q; const size_t ro_ = (size_t)(ok_ ? r_ : 0) * 128 + 8 * lc_;        \
            const v4u b_ = *(const GAS v4u*)(bg_ + ro_), c_ = *(const GAS v4u*)(bg_ + 128 * 128 + ro_); \
            tb[i] = ok_ ? b_ : (v4u){0u, 0u, 0u, 0u}; tc[i] = ok_ ? c_ : (v4u){0u, 0u, 0u, 0u}; } }
    if ((int)blockIdx.x < N_CITEMS) SC_ISSUE((int)blockIdx.x)
    for (int item = blockIdx.x; item < N_CITEMS; item += gridDim.x) {
        const SsdItem it = ssd_item(item); const int Q = it.Q;
        int tid = tid0; asm volatile("" : "+v"(tid));
        const int lane = tid & 63, fr = lane & 15, fq = lane >> 4;
        __syncthreads();
        { const int hq = 4 * it.g + (wave & 3); const int lr = tid >> 4, lc = tid & 15;
          if (wave < 4) (void)ssd_dt_finish(dr, Q, dtbias[hq], -__expf(alog[hq]), DTL + wave * 128, CSL + wave * 128, lane);
#pragma unroll
          for (int i = 0; i < 8; ++i) *(LAS v4u*)(XT + (32 * i + lr) * XS + 8 * lc) = tx[i];
#pragma unroll
          for (int i = 0; i < 4; ++i) { *(LAS v4u*)(Bs + (32 * i + lr) * XS + 8 * lc) = tb[i]; *(LAS v4u*)(Cs + (32 * i + lr) * XS + 8 * lc) = tc[i]; } }
        __syncthreads();
        const int l0 = 16 * wave, nlt = Q / 16;
        pg8::f32x4 ST[8];
        if (l0 < Q) {
            bf16x8 cf[4];
#pragma unroll
            for (int kb = 0; kb < 4; ++kb) cf[kb] = *(const LAS bf16x8*)(Cs + (l0 + fr) * XS + 32 * kb + 8 * fq);
#pragma unroll
            for (int t = 0; t < 8; ++t) { ST[t] = (pg8::f32x4){0.f, 0.f, 0.f, 0.f};
                if (t <= wave) {
#pragma unroll
                    for (int kb = 0; kb < 4; ++kb) { const bf16x8 bfrag = *(const LAS bf16x8*)(Bs + (16 * t + fr) * XS + 32 * kb + 8 * fq);
                        ST[t] = __builtin_amdgcn_mfma_f32_16x16x32_bf16(bfrag, cf[kb], ST[t], 0, 0, 0); } } }
        }
        __syncthreads();
        LAS bf16* CBL = Bs;
        if (l0 < Q) {
#pragma unroll
            for (int t = 0; t < 8; ++t) if (t <= wave) *(LAS v2u*)(CBL + (l0 + fr) * XS + 16 * t + 4 * fq) = (v2u){pk2(ST[t][0], ST[t][1]), pk2(ST[t][2], ST[t][3])};
        }
        const int r = wave >> 1, ph = wave & 1, h = 4 * it.g + r, hp0 = 64 * r + 32 * ph;
        const bool hasprev = it.c > 0;
        bf16x8 hf[2][4];
        if (hasprev) { const bf16* hpb = HPREV + ((((size_t)(it.b * NCH + it.c) * NH + h) * HD) + 32 * ph + fr) * NST + 8 * fq;
#pragma unroll
            for (int pt = 0; pt < 2; ++pt)
#pragma unroll
                for (int kb = 0; kb < 4; ++kb) hf[pt][kb] = *(const GAS bf16x8*)(hpb + (size_t)(16 * pt) * NST + 32 * kb); }
        __syncthreads();
        const LAS float* csr = CSL + r * 128; const LAS float* dtr = DTL + r * 128; const float Dh = dsk[h];
        float csl[8];
#pragma unroll
        for (int u = 0; u < 8; ++u) csl[u] = csr[(16 * u + fr) & 127];
        pg8::f32x4 ay[2][8];
#pragma unroll
        for (int u = 0; u < 8; ++u) { ay[0][u] = (pg8::f32x4){0.f, 0.f, 0.f, 0.f}; ay[1][u] = ay[0][u]; }
        const int zl = lane >> 2, zck = lane & 3;
        const bf16* zb = ZX + (size_t)(it.row0 + zl) * ZXW + 256 * it.g + hp0 + 8 * zck;
        LAS unsigned char* stg = (LAS unsigned char*)(XT + hp0 * XS);
        const int stg_lin = zl * 64 + 16 * (zck ^ ((zl >> 2) & 3));
        const int stg_acc = fr * 64 + 8 * (fq & 1);
        const int stg_x = (fr >> 2) & 3, stg_c = fq >> 1;
#pragma unroll
        for (int kb = 0; kb < 4; ++kb) if (32 * kb < Q) {
            bf16x8 xf[2];
#pragma unroll
            for (int pt = 0; pt < 2; ++pt) xf[pt] = *(const LAS bf16x8*)(XT + (hp0 + 16 * pt + fr) * XS + 8 * ((4 * kb + fq) ^ XT_SWZ(hp0 + 16 * pt)));
            const v4f c0 = *(const LAS v4f*)(csr + 32 * kb + 8 * fq), c1 = *(const LAS v4f*)(csr + 32 * kb + 8 * fq + 4);
            const v4f d0 = *(const LAS v4f*)(dtr + 32 * kb + 8 * fq), d1 = *(const LAS v4f*)(dtr + 32 * kb + 8 * fq + 4);
            const float csv[8] = {c0.x, c0.y, c0.z, c0.w, c1.x, c1.y, c1.z, c1.w}, dtv[8] = {d0.x, d0.y, d0.z, d0.w, d1.x, d1.y, d1.z, d1.w};
#pragma unroll
            for (int u = 2 * kb; u < 8; ++u) if (u < nlt) {
                const v4u raw = *(const LAS v4u*)(CBL + (16 * u + fr) * XS + 32 * kb + 8 * fq);
                const float cbv[8] = {bflo(raw.x), bfhi(raw.x), bflo(raw.y), bfhi(raw.y), bflo(raw.z), bfhi(raw.z), bflo(raw.w), bfhi(raw.w)};
                const int lrow = 16 * u + fr; float e[8];
#pragma unroll
                for (int jj = 0; jj < 8; ++jj) { const int sidx = 32 * kb + 8 * fq + jj; e[jj] = (sidx <= lrow && sidx < Q) ? cbv[jj] * __expf(csl[u] - csv[jj]) * dtv[jj] : 0.f;
                    if (sidx == lrow) e[jj] += Dh; }
                const bf16x8 sf = __builtin_bit_cast(bf16x8, (v4u){pk2(e[0], e[1]), pk2(e[2], e[3]), pk2(e[4], e[5]), pk2(e[6], e[7])});
#pragma unroll
                for (int pt = 0; pt < 2; ++pt) ay[pt][u] = __builtin_amdgcn_mfma_f32_16x16x32_bf16(xf[pt], sf, ay[pt][u], 0, 0, 0);
            }
            __builtin_amdgcn_sched_barrier(0);
        }
        if (hasprev) {
#pragma unroll
            for (int u = 0; u < 8; ++u) { const float ecs = __expf(csl[u]); pg8::f32x4 ao0 = (pg8::f32x4){0.f, 0.f, 0.f, 0.f}, ao1 = ao0;
#pragma unroll
                for (int kb = 0; kb < 4; ++kb) { const bf16x8 cfr = *(const LAS bf16x8*)(Cs + (16 * u + fr) * XS + 32 * kb + 8 * fq);
                    ao0 = __builtin_amdgcn_mfma_f32_16x16x32_bf16(hf[0][kb], cfr, ao0, 0, 0, 0); ao1 = __builtin_amdgcn_mfma_f32_16x16x32_bf16(hf[1][kb], cfr, ao1, 0, 0, 0); }
                ay[0][u] = ay[0][u] + ao0 * ecs; ay[1][u] = ay[1][u] + ao1 * ecs; } }
        __builtin_amdgcn_sched_barrier(0);
        v2u zz[2][8];
        { v4u zr[8];
#pragma unroll
          for (int i = 0; i < 8; ++i) zr[i] = *(const GAS v4u*)(zb + (size_t)(16 * (i < nlt ? i : 0)) * ZXW);
#pragma unroll
          for (int i = 0; i < 8; ++i) *(LAS v4u*)(stg + 1024 * i + stg_lin) = zr[i]; }
#pragma unroll
        for (int u = 0; u < 8; ++u)
#pragma unroll
            for (int pt = 0; pt < 2; ++pt) zz[pt][u] = *(const LAS v2u*)(stg + 1024 * u + stg_acc + 16 * ((2 * pt + stg_c) ^ stg_x));
        float ssq[8];
#pragma unroll
        for (int u = 0; u < 8; ++u) { ssq[u] = 0.f; if (u < nlt) {
#pragma unroll
            for (int pt = 0; pt < 2; ++pt) { const v2u zw = zz[pt][u]; const float zf[4] = {bflo(zw.x), bfhi(zw.x), bflo(zw.y), bfhi(zw.y)};
#pragma unroll
                for (int q = 0; q < 4; ++q) { const float y = ay[pt][u][q] * silu_f(zf[q]); ay[pt][u][q] = y; ssq[u] += y * y; } }
            ssq[u] += xor16_f(ssq[u], lane); ssq[u] += xor32_f(ssq[u], lane); } }
        LAS float* SSQ = CSL + 512;
        if (fq == 0) {
#pragma unroll
            for (int u = 0; u < 8; ++u) if (u < nlt) SSQ[wave * 128 + 16 * u + fr] = ssq[u]; }
        __builtin_amdgcn_sched_barrier(0);
        { const int nxt_ = item + (int)gridDim.x < N_CITEMS ? item + (int)gridDim.x : item;
          SC_ISSUE(nxt_) }
        __builtin_amdgcn_sched_barrier(0);
        __syncthreads();
        {
#pragma unroll
            for (int u = 0; u < 8; ++u) if (u < nlt) { float tsum = SSQ[(2 * fq) * 128 + 16 * u + fr] + SSQ[(2 * fq + 1) * 128 + 16 * u + fr];
                tsum += xor16_f(tsum, lane); tsum += xor32_f(tsum, lane);
                const float rs = rsqrtf(tsum * (1.f / 256.f) + EPS);
#pragma unroll
                for (int pt = 0; pt < 2; ++pt) *(LAS v2u*)(stg + 1024 * u + stg_acc + 16 * ((2 * pt + stg_c) ^ stg_x)) = (v2u){pk2(ay[pt][u][0] * rs, ay[pt][u][1] * rs), pk2(ay[pt][u][2] * rs, ay[pt][u][3] * rs)}; }
            bf16* yb = YN + (size_t)(it.row0 + zl) * DI + 256 * it.g + hp0 + 8 * zck;
#pragma unroll
            for (int i = 0; i < 8; ++i) if (i < nlt) *(GAS v4u*)(yb + (size_t)(16 * i) * DI) = *(const LAS v4u*)(stg + 1024 * i + stg_lin); }
    }
#undef SC_ISSUE
}


constexpr size_t SC_LSUM = 0;
constexpr size_t SC_LSUB = SC_LSUM + (size_t)NB * NCH * DR * 2 * 4;
constexpr size_t SC_LAB = SC_LSUB + (size_t)NB * NCH * 8 * DR * 2 * 4;
template <bool FINAL>
__device__ __forceinline__ void lru_phase(unsigned char* ws, float* out, LAS unsigned char* lds, int j, int tid0, int, int wave) {
    const bf16* G = (const bf16*)(ws + WS_ZX); const bf16* XRAW = G + (size_t)T * DR; bf16* YL = (bf16*)(ws + WS_YN);
    const bf16* WAX = (const bf16*)(ws + WS_W) + WE_LRU0 + (size_t)j * WE_LEND + WE_LAX;
    float* LSUM = (float*)(ws + WS_SCR + SC_LSUM); float* LSUB = (float*)(ws + WS_SCR + SC_LSUB); unsigned* LAB = (unsigned*)(ws + WS_SCR + SC_LAB); const float* LCF = (const float*)(ws + WS_LCF) + (size_t)j * DR;
    const float* cw = arg_in(I_LCW) + (size_t)j * 4 * DR; const float* cb = arg_in(I_LCB) + (size_t)j * DR;
    const float* ba = arg_in(I_LBA) + (size_t)j * DR; const float* bx = arg_in(I_LBX) + (size_t)j * DR;
    LAS bf16* WL = (LAS bf16*)lds;
    LAS bf16* XR = WL + 256 * XS;
    LAS bf16* GL = XR + 128 * XS;
    LAS float* WSUM = (LAS float*)(GL + 128 * XS);
    LAS float* CHC = WSUM + 8 * 128 * 2;
    const int nitems = FINAL ? N_CITEMS + 8 : N_CITEMS;
    int kb_staged = -1;
    bool srep_ = false;
    for (int item = blockIdx.x; item < nitems; item += gridDim.x) {
        int tid = tid0; asm volatile("" : "+v"(tid));
        const int lane = tid & 63, fr = lane & 15, fq = lane >> 4;
        const bool samp = item >= N_CITEMS;
        int b = 0, c = -1, kb, Q = 128, row0 = TP;
        if (!samp) { const SsdItem it = ssd_item(item); kb = it.g; c = it.c; b = it.b; Q = it.Q; row0 = it.row0; }
        else kb = item - N_CITEMS;
        if (FINAL && !samp) {
            const int c4 = tid & 31, rg = tid >> 5, nrg = Q / 8, r0 = 8 * rg, dg4 = kb * 128 + 4 * c4;
            LAS float* QS = (LAS float*)lds;
            LAS float* HINL = QS + 16 * 128 * 2;
            __syncthreads();
            v4u ab[8]; v2u gq[8];
            v2f cs_[NCH - 1];
            if (tid < 128) { const int dg = kb * 128 + tid;
#pragma unroll
                for (int cp = 0; cp < NCH - 1; ++cp) { const v2f t = *(const GAS v2f*)(LSUM + ((size_t)(b * NCH + (cp < c ? cp : 0)) * DR + dg) * 2); const float mk = cp < c ? 1.f : 0.f;
                    cs_[cp].x = 1.f + mk * (t.x - 1.f); cs_[cp].y = mk * t.y; } }
            { const int rr = rg < nrg ? r0 : 0;
              const unsigned* labp = LAB + (size_t)(row0 + rr) * DR + dg4; const bf16* gp = G + (size_t)(row0 + rr) * DR + dg4;
#pragma unroll
              for (int i = 0; i < 8; ++i) { ab[i] = *(const GAS v4u*)(labp + (size_t)i * DR); gq[i] = *(const GAS v2u*)(gp + (size_t)i * DR); } }
            if (tid < 128) { float h = 0.f;
#pragma unroll
                for (int cp = 0; cp < NCH - 1; ++cp) h = cs_[cp].x * h + cs_[cp].y;
                HINL[tid] = h; }
            float av[8][4]; v4f A4 = (v4f){1.f, 1.f, 1.f, 1.f}, H4 = (v4f){0.f, 0.f, 0.f, 0.f};
#pragma unroll
            for (int i = 0; i < 8; ++i) { const v4u w = ab[i];
                av[i][0] = __expf(bflo(w.x)); av[i][1] = __expf(bflo(w.y)); av[i][2] = __expf(bflo(w.z)); av[i][3] = __expf(bflo(w.w));
                const v4f a4 = (v4f){av[i][0], av[i][1], av[i][2], av[i][3]}, b4 = (v4f){bfhi(w.x), bfhi(w.y), bfhi(w.z), bfhi(w.w)};
                H4 = a4 * H4 + b4; A4 = A4 * a4; }
            if (rg < nrg) { *(LAS v4f*)(QS + (rg * 128 + 4 * c4) * 2) = (v4f){A4.x, H4.x, A4.y, H4.y}; *(LAS v4f*)(QS + (rg * 128 + 4 * c4) * 2 + 4) = (v4f){A4.z, H4.z, A4.w, H4.w}; }
            __syncthreads();
            if (rg < nrg) {
                v4f h4 = *(const LAS v4f*)(HINL + 4 * c4);
                for (int qq = 0; qq < rg; ++qq) { const v4f s0 = *(const LAS v4f*)(QS + (qq * 128 + 4 * c4) * 2), s1 = *(const LAS v4f*)(QS + (qq * 128 + 4 * c4) * 2 + 4);
                    h4 = (v4f){s0.x * h4.x + s0.y, s0.z * h4.y + s0.w, s1.x * h4.z + s1.y, s1.z * h4.w + s1.w}; }
                bf16* yp = YL + (size_t)(row0 + r0) * DR + dg4;
#pragma unroll
                for (int i = 0; i < 8; ++i) { const v4u w = ab[i]; const v4f a4 = (v4f){av[i][0], av[i][1], av[i][2], av[i][3]}, b4 = (v4f){bfhi(w.x), bfhi(w.y), bfhi(w.z), bfhi(w.w)};
                    h4 = a4 * h4 + b4;
                    const v4f g4 = (v4f){bflo(gq[i].x), bfhi(gq[i].x), bflo(gq[i].y), bfhi(gq[i].y)}, y4 = h4 * g4;
                    *(GAS v2u*)(yp + (size_t)i * DR) = (v2u){pk2(y4.x, y4.y), pk2(y4.z, y4.w)}; }
                if (c == NCH - 1 && rg == nrg - 1) *(GAS v4f*)(out + O_PLH + ((size_t)j * NB + b) * DR + dg4) = h4;
            }
            continue;
        }
        __syncthreads();
        if (kb != kb_staged) { const GAS v4u* src = (const GAS v4u*)(WAX + (size_t)kb * 256 * 128); v4u wv[8];
#pragma unroll
          for (int i = 0; i < 8; ++i) wv[i] = src[tid + NTHR * i];
#pragma unroll
          for (int i = 0; i < 8; ++i) { const int e = tid + NTHR * i; *(LAS v4u*)(WL + (e >> 4) * XS + 8 * (e & 15)) = wv[i]; }
          if (tid < 128) { CHC[tid] = LCF[kb * 128 + tid]; CHC[128 + tid] = ba[kb * 128 + tid]; CHC[256 + tid] = bx[kb * 128 + tid]; }
          kb_staged = kb; }
        v2f cs_[NCH - 1], ws_[7];
        const bool do_hin = FINAL && !samp && tid < 128;
        if (do_hin) {
#pragma unroll
            for (int cp = 0; cp < NCH - 1; ++cp) cs_[cp] = cp < c ? *(const GAS v2f*)(LSUM + ((size_t)(b * NCH + cp) * DR + kb * 128 + tid) * 2) : (v2f){1.f, 0.f};
#pragma unroll
            for (int ww = 0; ww < 7; ++ww) ws_[ww] = *(const GAS v2f*)(LSUB + (((size_t)(b * NCH + c) * 8 + ww) * DR + kb * 128 + tid) * 2); }
        v4u gv[4];
        if (FINAL) {
#pragma unroll
            for (int i = 0; i < 4; ++i) { const int e = tid + NTHR * i; if (e < Q * 16) gv[i] = *(const GAS v4u*)(G + (size_t)(row0 + (e >> 4)) * DR + kb * 128 + 8 * (e & 15)); } }
        for (int rp_ = 0; rp_ < ((!FINAL && (SUBREP & 64)) ? 2 : 1); ++rp_) { asm volatile("" ::: "memory");
        if (!samp) {
            const int c8 = tid & 15, rg = tid >> 4, s0 = 4 * rg, cc = kb * 128 + 8 * c8;
            if (s0 < Q) {
                const bf16* src = XRAW + (size_t)(row0 + s0) * DR + cc; const int tfirst = row0 - b * LP + s0;
                v4u raw[7];
#pragma unroll
                for (int i = 0; i < 3; ++i) { const bool ok = tfirst >= 3 - i; const v4u t = *(const GAS v4u*)(src + (ptrdiff_t)(ok ? i - 3 : 0) * DR); raw[i] = ok ? t : (v4u){0u, 0u, 0u, 0u}; }
#pragma unroll
                for (int i = 0; i < 4; ++i) raw[3 + i] = *(const GAS v4u*)(src + (size_t)i * DR);
                v4f wv[4][2], bv[2];
#pragma unroll
                for (int t = 0; t < 4; ++t) { wv[t][0] = *(const GAS v4f*)(cw + (size_t)t * DR + cc); wv[t][1] = *(const GAS v4f*)(cw + (size_t)t * DR + cc + 4); }
                bv[0] = *(const GAS v4f*)(cb + cc); bv[1] = *(const GAS v4f*)(cb + cc + 4);
                if (!FINAL && c == NCH - 1 && s0 + 4 == Q) { float* cso = out + O_PLC + (((size_t)j * NB + b) * 3) * DR + cc;
#pragma unroll
                    for (int i = 0; i < 3; ++i) { const v4u w = raw[4 + i]; float* o = cso + (size_t)i * DR;
                        *(GAS v4f*)o = (v4f){bflo(w.x), bfhi(w.x), bflo(w.y), bfhi(w.y)}; *(GAS v4f*)(o + 4) = (v4f){bflo(w.z), bfhi(w.z), bflo(w.w), bfhi(w.w)}; } }
                unsigned ow[4][4];
#pragma unroll
                for (int kp = 0; kp < 4; ++kp) { const int k = 2 * kp;
                    const v2f w0 = (v2f){wv[0][k >> 2][k & 3], wv[0][k >> 2][(k & 3) + 1]}, w1 = (v2f){wv[1][k >> 2][k & 3], wv[1][k >> 2][(k & 3) + 1]},
                              w2 = (v2f){wv[2][k >> 2][k & 3], wv[2][k >> 2][(k & 3) + 1]}, w3 = (v2f){wv[3][k >> 2][k & 3], wv[3][k >> 2][(k & 3) + 1]}, bb = (v2f){bv[k >> 2][k & 3], bv[k >> 2][(k & 3) + 1]};
#define RAW2(i) ((v2f){bf_elem(raw[i], k), bf_elem(raw[i], k + 1)})
                    v2f x0 = RAW2(0), x1 = RAW2(1), x2 = RAW2(2);
#pragma unroll
                    for (int i = 0; i < 4; ++i) { const v2f x3 = RAW2(3 + i); const v2f t = bb + w0 * x0 + w1 * x1 + w2 * x2 + w3 * x3; ow[i][kp] = pk2(t.x, t.y); x0 = x1; x1 = x2; x2 = x3; }
#undef RAW2
                }
#pragma unroll
                for (int i = 0; i < 4; ++i) *(LAS v4u*)(XR + (s0 + i) * XS + 8 * c8) = (v4u){ow[i][0], ow[i][1], ow[i][2], ow[i][3]};
            }
        } else {
            const int ch = tid & 127, sub = tid >> 7, cc = kb * 128 + ch, nr = Q / 4, s0 = sub * nr;
            const float w0 = cw[cc], w1 = cw[DR + cc], w2 = cw[2 * DR + cc], w3 = cw[3 * DR + cc], bias = cb[cc];
            {
                const float* spb = arg_in(I_SLC) + ((size_t)j * NS * 3) * DR + cc; float* opb = out + O_SLC + ((size_t)j * NS * 3) * DR + cc;
#pragma unroll 8
                for (int s = s0; s < s0 + nr; ++s) { const float* sp = spb + (size_t)s * 3 * DR;
                    const float q0 = sp[0], q1 = sp[DR], q2 = sp[2 * DR], x3 = bf2f(XRAW[(size_t)(TP + s) * DR + cc]);
                    XR[s * XS + ch] = (bf16)f2bf(bias + w0 * q0 + w1 * q1 + w2 * q2 + w3 * x3);
                    float* op = opb + (size_t)s * 3 * DR; op[0] = q1; op[DR] = q2; op[2 * DR] = x3; }
            }
        }
        }
        if (FINAL) {
#pragma unroll
            for (int i = 0; i < 4; ++i) { const int e = tid + NTHR * i; if (e < Q * 16) *(LAS v4u*)(GL + (e >> 4) * XS + 8 * (e & 15)) = gv[i]; } }
        if (do_hin) { float h = 0.f;
#pragma unroll
            for (int cp = 0; cp < NCH - 1; ++cp) h = cs_[cp].x * h + cs_[cp].y;
            WSUM[tid] = h;
#pragma unroll
            for (int ww = 0; ww < 7; ++ww) { h = ws_[ww].x * h + ws_[ww].y; WSUM[(ww + 1) * 128 + tid] = h; } }
        __syncthreads();
        const bool act = 16 * wave < Q; const int l0 = 16 * wave;
        if (act) {
            pg8::f32x4 acc[16];
            for (int rm_ = 0; rm_ < ((SUBREP & 128) ? 2 : 1); ++rm_) { asm volatile("" ::: "memory");
#pragma unroll
            for (int nt = 0; nt < 16; ++nt) acc[nt] = (pg8::f32x4){0.f, 0.f, 0.f, 0.f};
#pragma unroll
            for (int kk = 0; kk < 4; ++kk) { const bf16x8 af = *(const LAS bf16x8*)(XR + (l0 + fr) * XS + 32 * kk + 8 * fq);
#pragma unroll
                for (int nt = 0; nt < 16; ++nt) { const bf16x8 wf = *(const LAS bf16x8*)(WL + (16 * nt + fr) * XS + 32 * kk + 8 * fq);
                    acc[nt] = __builtin_amdgcn_mfma_f32_16x16x32_bf16(af, wf, acc[nt], 0, 0, 0); }
                __builtin_amdgcn_sched_barrier(0); }
            }
            if (samp) {
                if (FINAL) { const float* h0p = arg_in(I_SLH) + (size_t)j * NS * DR; float* hop = out + O_SLH + (size_t)j * NS * DR;
#pragma unroll 1
                    for (int nt = 0; nt < 8; ++nt) { const int d = 16 * nt + fr, dg = kb * 128 + d; const float cfac = CHC[d], bav = CHC[128 + d], bxv = CHC[256 + d];
                        const pg8::f32x4 ga = nt == 0 ? acc[0] : nt == 1 ? acc[1] : nt == 2 ? acc[2] : nt == 3 ? acc[3] : nt == 4 ? acc[4] : nt == 5 ? acc[5] : nt == 6 ? acc[6] : acc[7];
                        const pg8::f32x4 gx = nt == 0 ? acc[8] : nt == 1 ? acc[9] : nt == 2 ? acc[10] : nt == 3 ? acc[11] : nt == 4 ? acc[12] : nt == 5 ? acc[13] : nt == 6 ? acc[14] : acc[15];
#pragma unroll
                        for (int q = 0; q < 4; ++q) { const int l = l0 + 4 * fq + q;
                            const float rg = sigmoid_f(ga[q] + bav), ig = sigmoid_f(gx[q] + bxv), la = -cfac * rg, av = __expf(la), mult = __builtin_amdgcn_sqrtf(one_minus_exp2x(la, av));
                            const float bt = mult * ig * bf2f(XR[l * XS + d]);
                            const float h = av * h0p[(size_t)l * DR + dg] + bt; hop[(size_t)l * DR + dg] = h;
                            GL[l * XS + d] = (bf16)f2bf(h * bf2f(GL[l * XS + d])); } } }
            } else {
                for (int rg_ = 0; rg_ < ((!FINAL && (SUBREP & 256)) ? 2 : 1); ++rg_) { asm volatile("" ::: "memory");
#pragma unroll
                for (int nt = 0; nt < 8; ++nt) { const int d = 16 * nt + fr, dg = kb * 128 + d; const float cfac = CHC[d], bav = CHC[128 + d], bxv = CHC[256 + d];
                    float aq[4], bq[4], A = 1.f, H = 0.f;
#pragma unroll
                    for (int q = 0; q < 4; q += 2) { const int l = l0 + 4 * fq + q; v2f av2, bt2, la2;
                        lru_gate2((v2f){acc[nt][q], acc[nt][q + 1]}, (v2f){acc[nt + 8][q], acc[nt + 8][q + 1]}, bav, bxv, cfac, (v2f){bf2f(XR[l * XS + d]), bf2f(XR[(l + 1) * XS + d])}, av2, bt2, la2);
                        aq[q] = av2.x; aq[q + 1] = av2.y; bq[q] = bt2.x; bq[q + 1] = bt2.y;
                        H = av2.x * H + bt2.x; H = av2.y * H + bt2.y; A *= av2.x * av2.y;
                        if (!FINAL) { LAB[(size_t)(row0 + l) * DR + dg] = pk2(la2.x, bt2.x); LAB[(size_t)(row0 + l + 1) * DR + dg] = pk2(la2.y, bt2.y); } }
                    const float Ap = xor16_f(A, lane), Hp = xor16_f(H, lane);
                    const bool odd = (fq & 1) != 0;
                    const float AT = A * Ap, HT = odd ? A * Hp + H : Ap * H + Hp;
                    const float A01 = xor32_f(AT, lane), H01 = xor32_f(HT, lane);
                    const float Aex = fq == 0 ? 1.f : fq == 1 ? Ap : fq == 2 ? A01 : Ap * A01, Hex = fq == 0 ? 0.f : fq == 1 ? Hp : fq == 2 ? H01 : Ap * H01 + Hp;
                    if (!FINAL) { if (fq == 3) { const v2f tot = (v2f){A01 * AT, AT * H01 + HT};
                            *(LAS v2f*)(WSUM + (wave * 128 + d) * 2) = tot; } }
                    else { float h = Aex * WSUM[wave * 128 + d] + Hex;
#pragma unroll
                        for (int q = 0; q < 4; ++q) { const int l = l0 + 4 * fq + q; h = aq[q] * h + bq[q];
                            GL[l * XS + d] = (bf16)f2bf(h * bf2f(GL[l * XS + d]));
                            if (c == NCH - 1 && l == Q - 1) out[O_PLH + ((size_t)j * NB + b) * DR + dg] = h; } }
                    __builtin_amdgcn_sched_barrier(0); }
                }
            }
        }
        if (!FINAL) { __syncthreads();
            if (tid < 128) { float A = 1.f, H = 0.f; const int nw = Q / 16;
                for (int ww = 0; ww < nw; ++ww) { const v2f sm = *(const LAS v2f*)(WSUM + (ww * 128 + tid) * 2); H = sm.x * H + sm.y; A *= sm.x; }
                *(GAS v2f*)(LSUM + ((size_t)(b * NCH + c) * DR + kb * 128 + tid) * 2) = (v2f){A, H}; } }
        if (FINAL && act) { LDS_WAIT();
#pragma unroll
            for (int k = 0; k < 4; ++k) { const int ci = lane + 64 * k, rr = l0 + (ci >> 4), c16 = ci & 15;
                *(GAS v4u*)(YL + (size_t)(row0 + rr) * DR + kb * 128 + 8 * c16) = *(const LAS v4u*)(GL + rr * XS + 8 * c16); } }
        if (FINAL && (SUBREP & 16) && samp && !srep_) { srep_ = true; item -= gridDim.x; }
    }
}

__device__ __forceinline__ void lru_sample_item(unsigned char* ws, float* out, LAS unsigned char* lds, int j, int kb, int rgp, int tid, int wave) {
    const bf16* G = (const bf16*)(ws + WS_ZX); const bf16* XRAW = G + (size_t)T * DR; bf16* YL = (bf16*)(ws + WS_YN);
    const bf16* WAX = (const bf16*)(ws + WS_W) + WE_LRU0 + (size_t)j * WE_LEND + WE_LAX + (size_t)kb * 256 * 128;
    const float* LCF = (const float*)(ws + WS_LCF) + (size_t)j * DR;
    const float* cw = arg_in(I_LCW) + (size_t)j * 4 * DR; const float* cb = arg_in(I_LCB) + (size_t)j * DR;
    const float* ba = arg_in(I_LBA) + (size_t)j * DR; const float* bx = arg_in(I_LBX) + (size_t)j * DR;
    LAS bf16* XR = (LAS bf16*)(lds + 32768);
    LAS bf16* GLs = XR + 16 * XS;
    const int lane = tid & 63, fr = lane & 15, fq = lane >> 4, s0 = 16 * rgp, d = 16 * wave + fr, dg = kb * 128 + d;
    float h0v[4];
    { const float* h0p = arg_in(I_SLH) + (size_t)j * NS * DR;
#pragma unroll
      for (int q = 0; q < 4; ++q) h0v[q] = h0p[(size_t)(s0 + 4 * fq + q) * DR + dg]; }
    const float cfac = LCF[dg], bav = ba[dg], bxv = bx[dg];
    bf16x8 wa[4], wx[4];
#pragma unroll
    for (int kk = 0; kk < 4; ++kk) { wa[kk] = *(const GAS bf16x8*)(WAX + (size_t)(16 * wave + fr) * 128 + 32 * kk + 8 * fq); wx[kk] = *(const GAS bf16x8*)(WAX + (size_t)(128 + 16 * wave + fr) * 128 + 32 * kk + 8 * fq); }
    __syncthreads();
    { const int rr = tid >> 5, c4 = tid & 31, cc = kb * 128 + 4 * c4, s = s0 + rr;
      const float* sp = arg_in(I_SLC) + (((size_t)j * NS + s) * 3) * DR + cc; float* op = out + O_SLC + (((size_t)j * NS + s) * 3) * DR + cc;
      const v4f q0 = *(const GAS v4f*)sp, q1 = *(const GAS v4f*)(sp + DR), q2 = *(const GAS v4f*)(sp + 2 * DR);
      const v2u xr = *(const GAS v2u*)(XRAW + (size_t)(TP + s) * DR + cc), gg = *(const GAS v2u*)(G + (size_t)(TP + s) * DR + cc);
      const v4f w0 = *(const GAS v4f*)(cw + cc), w1 = *(const GAS v4f*)(cw + DR + cc), w2 = *(const GAS v4f*)(cw + 2 * DR + cc), w3 = *(const GAS v4f*)(cw + 3 * DR + cc), bb = *(const GAS v4f*)(cb + cc);
      const v4f x3 = (v4f){bflo(xr.x), bfhi(xr.x), bflo(xr.y), bfhi(xr.y)};
      const v4f t = bb + w0 * q0 + w1 * q1 + w2 * q2 + w3 * x3;
      *(GAS v4f*)op = q1; *(GAS v4f*)(op + DR) = q2; *(GAS v4f*)(op + 2 * DR) = x3;
      *(LAS v2u*)(XR + rr * XS + 4 * c4) = (v2u){pk2(t.x, t.y), pk2(t.z, t.w)};
      *(LAS v2u*)(GLs + rr * XS + 4 * c4) = gg; }
    __syncthreads();
    pg8::f32x4 aa = (pg8::f32x4){0.f, 0.f, 0.f, 0.f}, ax = aa;
#pragma unroll
    for (int kk = 0; kk < 4; ++kk) { const bf16x8 af = *(const LAS bf16x8*)(XR + fr * XS + 32 * kk + 8 * fq);
        aa = __builtin_amdgcn_mfma_f32_16x16x32_bf16(af, wa[kk], aa, 0, 0, 0); ax = __builtin_amdgcn_mfma_f32_16x16x32_bf16(af, wx[kk], ax, 0, 0, 0); }
    float* hop = out + O_SLH + (size_t)j * NS * DR;
#pragma unroll
    for (int q = 0; q < 4; ++q) { const int l = 4 * fq + q;
        const float rgt = sigmoid_f(aa[q] + bav), ig = sigmoid_f(ax[q] + bxv), la = -cfac * rgt, av = __expf(la), mult = __builtin_amdgcn_sqrtf(one_minus_exp2x(la, av));
        const float bt = mult * ig * bf2f(XR[l * XS + d]);
        const float h = av * h0v[q] + bt; hop[(size_t)(s0 + l) * DR + dg] = h;
        YL[(size_t)(TP + s0 + l) * DR + dg] = (bf16)f2bf(h * bf2f(GLs[l * XS + d])); }
}

__device__ __forceinline__ void lru_phase_b(unsigned char* ws, float* out, LAS unsigned char* lds, int j, int tid0, int wave) {
    const bf16* G = (const bf16*)(ws + WS_ZX); bf16* YL = (bf16*)(ws + WS_YN);
    const float* LSUM = (const float*)(ws + WS_SCR + SC_LSUM); const unsigned* LAB = (const unsigned*)(ws + WS_SCR + SC_LAB);
    int tid = tid0; asm volatile("" : "+v"(tid));
    const int c4 = tid & 31, rg = tid >> 5;
    LAS float* QS = (LAS float*)lds;
    LAS float* HINL = QS + 16 * 128 * 2;
    v4u abn[8]; v2u gqn[8];
#define LB_ISSUE(item_) { const SsdItem it_ = ssd_item(item_); const int rr_ = rg < it_.Q / 8 ? 8 * rg : 0; \
        const unsigned* labp_ = LAB + (size_t)(it_.row0 + rr_) * DR + it_.g * 128 + 4 * c4; const bf16* gp_ = G + (size_t)(it_.row0 + rr_) * DR + it_.g * 128 + 4 * c4; \
        _Pragma("unroll") for (int i = 0; i < 8; ++i) { abn[i] = *(const GAS v4u*)(labp_ + (size_t)i * DR); gqn[i] = *(const GAS v2u*)(gp_ + (size_t)i * DR); } }
    int item = blockIdx.x;
    if (item < N_CITEMS) LB_ISSUE(item)
    for (; item < N_CITEMS; item += gridDim.x) {
        const SsdItem it = ssd_item(item); const int b = it.b, c = it.c, kb = it.g, Q = it.Q, row0 = it.row0;
        const int nrg = Q / 8, r0 = 8 * rg, dg4 = kb * 128 + 4 * c4;
        v2f cs_[NCH - 1];
        if (tid < 128) { const int dg = kb * 128 + tid;
#pragma unroll
            for (int cp = 0; cp < NCH - 1; ++cp) { const v2f t = *(const GAS v2f*)(LSUM + ((size_t)(b * NCH + (cp < c ? cp : 0)) * DR + dg) * 2); const float mk = cp < c ? 1.f : 0.f;
                cs_[cp].x = 1.f + mk * (t.x - 1.f); cs_[cp].y = mk * t.y; } }
        v4u ab[8]; v2u gq[8];
#pragma unroll
        for (int i = 0; i < 8; ++i) { ab[i] = abn[i]; gq[i] = gqn[i]; }
        if (item + (int)gridDim.x < N_CITEMS) LB_ISSUE(item + (int)gridDim.x)
        __syncthreads();
        if (tid < 128) { float h = 0.f;
#pragma unroll
            for (int cp = 0; cp < NCH - 1; ++cp) h = cs_[cp].x * h + cs_[cp].y;
            HINL[tid] = h; }
        float av[8][4]; v4f A4 = (v4f){1.f, 1.f, 1.f, 1.f}, H4 = (v4f){0.f, 0.f, 0.f, 0.f};
#pragma unroll
        for (int i = 0; i < 8; ++i) { const v4u w = ab[i];
            av[i][0] = __expf(bflo(w.x)); av[i][1] = __expf(bflo(w.y)); av[i][2] = __expf(bflo(w.z)); av[i][3] = __expf(bflo(w.w));
            const v4f a4 = (v4f){av[i][0], av[i][1], av[i][2], av[i][3]}, b4 = (v4f){bfhi(w.x), bfhi(w.y), bfhi(w.z), bfhi(w.w)};
            H4 = a4 * H4 + b4; A4 = A4 * a4; }
        if (rg < nrg) { *(LAS v4f*)(QS + (rg * 128 + 4 * c4) * 2) = (v4f){A4.x, H4.x, A4.y, H4.y}; *(LAS v4f*)(QS + (rg * 128 + 4 * c4) * 2 + 4) = (v4f){A4.z, H4.z, A4.w, H4.w}; }
        __syncthreads();
        if (rg < nrg) {
            v4f h4 = *(const LAS v4f*)(HINL + 4 * c4);
            for (int qq = 0; qq < rg; ++qq) { const v4f s0 = *(const LAS v4f*)(QS + (qq * 128 + 4 * c4) * 2), s1 = *(const LAS v4f*)(QS + (qq * 128 + 4 * c4) * 2 + 4);
                h4 = (v4f){s0.x * h4.x + s0.y, s0.z * h4.y + s0.w, s1.x * h4.z + s1.y, s1.z * h4.w + s1.w}; }
            bf16* yp = YL + (size_t)(row0 + r0) * DR + dg4;
#pragma unroll
            for (int i = 0; i < 8; ++i) { const v4u w = ab[i]; const v4f a4 = (v4f){av[i][0], av[i][1], av[i][2], av[i][3]}, b4 = (v4f){bfhi(w.x), bfhi(w.y), bfhi(w.z), bfhi(w.w)};
                h4 = a4 * h4 + b4;
                const v4f g4 = (v4f){bflo(gq[i].x), bfhi(gq[i].x), bflo(gq[i].y), bfhi(gq[i].y)}, y4 = h4 * g4;
                *(GAS v2u*)(yp + (size_t)i * DR) = (v2u){pk2(y4.x, y4.y), pk2(y4.z, y4.w)}; }
            if (c == NCH - 1 && rg == nrg - 1) *(GAS v4f*)(out + O_PLH + ((size_t)j * NB + b) * DR + dg4) = h4;
        }
    }
#undef LB_ISSUE
    for (; item < N_CITEMS + 64; item += gridDim.x) { const int si = item - N_CITEMS; lru_sample_item(ws, out, lds, j, si & 7, si >> 3, tid, wave); }
}

constexpr size_t SC_LAGG = 0;
__device__ __forceinline__ void lru_phase_ab(unsigned char* ws, float* out, LAS unsigned char* lds, int j, int tid0, int wave) {
    const bf16* G = (const bf16*)(ws + WS_ZX); const bf16* XRAW = G + (size_t)T * DR; bf16* YL = (bf16*)(ws + WS_YN);
    const bf16* WAX = (const bf16*)(ws + WS_W) + WE_LRU0 + (size_t)j * WE_LEND + WE_LAX;
    unsigned long long* AGG = (unsigned long long*)(ws + WS_SCR + SC_LAGG);
    const float* LCF = (const float*)(ws + WS_LCF) + (size_t)j * DR;
    const float* cw = arg_in(I_LCW) + (size_t)j * 4 * DR; const float* cb = arg_in(I_LCB) + (size_t)j * DR;
    const float* ba = arg_in(I_LBA) + (size_t)j * DR; const float* bx = arg_in(I_LBX) + (size_t)j * DR;
    LAS bf16* WL = (LAS bf16*)lds;
    LAS bf16* XR = WL + 256 * XS;
    LAS bf16* GL = XR + 128 * XS;
    LAS float* WSUM = (LAS float*)(GL + 128 * XS);
    LAS float* CHC = WSUM + 8 * 128 * 2;
    const int Gd = (int)gridDim.x;
    int li = blockIdx.x, fi = blockIdx.x, kb_staged = -1;
#define LRU_FETCH(ok_, b_, c_, kb_) { ok_ = true; if (li < NB * NG) { b_ = li / NG; c_ = 0; kb_ = li % NG; li += Gd; } else if (fi < NB * 16 * NG) { b_ = fi / (NG * 16); c_ = 1 + (fi / NG) % 16; kb_ = fi % NG; fi += Gd; } else ok_ = false; }
    v4u gv[4];
auto lru_front = [&](int b, int c, int kb) { int tid = tid0; asm volatile("" : "+v"(tid)); const int Q = (c) == 0 ? NMETA : 128, row0 = (b) * LP + ((c) == 0 ? 0 : NMETA + 128 * ((c) - 1));
    if (kb != kb_staged) { const GAS v4u* src = (const GAS v4u*)(WAX + (size_t)kb * 256 * 128); v4u wv[8];
#pragma unroll
        for (int i = 0; i < 8; ++i) wv[i] = src[tid + NTHR * i];
#pragma unroll
        for (int i = 0; i < 8; ++i) { const int e = tid + NTHR * i; *(LAS v4u*)(WL + (e >> 4) * XS + 8 * (e & 15)) = wv[i]; }
        if (tid < 128) { CHC[tid] = LCF[kb * 128 + tid]; CHC[128 + tid] = ba[kb * 128 + tid]; CHC[256 + tid] = bx[kb * 128 + tid]; }
        kb_staged = kb; }
        #pragma unroll
        for (int i = 0; i < 4; ++i) { const int e = tid + NTHR * i; if (e < Q * 16) gv[i] = *(const GAS v4u*)(G + (size_t)(row0 + (e >> 4)) * DR + (kb) * 128 + 8 * (e & 15)); }
    {
            const int c8 = tid & 15, rg = tid >> 4, s0 = 4 * rg, cc = kb * 128 + 8 * c8;
            if (s0 < Q) {
                const bf16* src = XRAW + (size_t)(row0 + s0) * DR + cc; const int tfirst = row0 - b * LP + s0;
                v4u raw[7];
#pragma unroll
                for (int i = 0; i < 3; ++i) { const bool ok = tfirst >= 3 - i; const v4u t = *(const GAS v4u*)(src + (ptrdiff_t)(ok ? i - 3 : 0) * DR); raw[i] = ok ? t : (v4u){0u, 0u, 0u, 0u}; }
#pragma unroll
                for (int i = 0; i < 4; ++i) raw[3 + i] = *(const GAS v4u*)(src + (size_t)i * DR);
                v4f wv[4][2], bv[2];
#pragma unroll
                for (int t = 0; t < 4; ++t) { wv[t][0] = *(const GAS v4f*)(cw + (size_t)t * DR + cc); wv[t][1] = *(const GAS v4f*)(cw + (size_t)t * DR + cc + 4); }
                bv[0] = *(const GAS v4f*)(cb + cc); bv[1] = *(const GAS v4f*)(cb + cc + 4);
                if (c == NCH - 1 && s0 + 4 == Q) { float* cso = out + O_PLC + (((size_t)j * NB + b) * 3) * DR + cc;
#pragma unroll
                    for (int i = 0; i < 3; ++i) { const v4u w = raw[4 + i]; float* o = cso + (size_t)i * DR;
                        *(GAS v4f*)o = (v4f){bflo(w.x), bfhi(w.x), bflo(w.y), bfhi(w.y)}; *(GAS v4f*)(o + 4) = (v4f){bflo(w.z), bfhi(w.z), bflo(w.w), bfhi(w.w)}; } }
                unsigned ow[4][4];
#pragma unroll
                for (int kp = 0; kp < 4; ++kp) { const int k = 2 * kp;
                    const v2f w0 = (v2f){wv[0][k >> 2][k & 3], wv[0][k >> 2][(k & 3) + 1]}, w1 = (v2f){wv[1][k >> 2][k & 3], wv[1][k >> 2][(k & 3) + 1]},
                              w2 = (v2f){wv[2][k >> 2][k & 3], wv[2][k >> 2][(k & 3) + 1]}, w3 = (v2f){wv[3][k >> 2][k & 3], wv[3][k >> 2][(k & 3) + 1]}, bb = (v2f){bv[k >> 2][k & 3], bv[k >> 2][(k & 3) + 1]};
#define RAW2(i) ((v2f){bf_elem(raw[i], k), bf_elem(raw[i], k + 1)})
                    v2f x0 = RAW2(0), x1 = RAW2(1), x2 = RAW2(2);
#pragma unroll
                    for (int i = 0; i < 4; ++i) { const v2f x3 = RAW2(3 + i); const v2f t = bb + w0 * x0 + w1 * x1 + w2 * x2 + w3 * x3; ow[i][kp] = pk2(t.x, t.y); x0 = x1; x1 = x2; x2 = x3; }
#undef RAW2
                }
#pragma unroll
                for (int i = 0; i < 4; ++i) *(LAS v4u*)(XR + (s0 + i) * XS + 8 * c8) = (v4u){ow[i][0], ow[i][1], ow[i][2], ow[i][3]};
            }
    }
    };
    bool ok; int b = 0, c = 0, kb = 0;
    LRU_FETCH(ok, b, c, kb)
    if (ok) { __syncthreads(); lru_front(b, c, kb); }
    while (ok) {
        int tid = tid0; asm volatile("" : "+v"(tid));
        const int lane = tid & 63, fr = lane & 15, fq = lane >> 4;
        const int Q = c == 0 ? NMETA : 128, row0 = b * LP + (c == 0 ? 0 : NMETA + 128 * (c - 1));
        unsigned* FLG = (unsigned*)(ws + WS_CTL) + CW_LFLG + (j * NB + b) * NCH * 8;
        __syncthreads();
#pragma unroll
        for (int i = 0; i < 4; ++i) { const int e = tid + NTHR * i; if (e < Q * 16) *(LAS v4u*)(GL + (e >> 4) * XS + 8 * (e & 15)) = gv[i]; }
        const bool act = 16 * wave < Q; const int l0 = 16 * wave;
        float aq[8][4], bq[8][4], Aex[8], Hex[8];
        if (act) {
            pg8::f32x4 acc[16];
#pragma unroll
            for (int nt = 0; nt < 16; ++nt) acc[nt] = (pg8::f32x4){0.f, 0.f, 0.f, 0.f};
#pragma unroll
            for (int kk = 0; kk < 4; ++kk) { const bf16x8 af = *(const LAS bf16x8*)(XR + (l0 + fr) * XS + 32 * kk + 8 * fq);
#pragma unroll
                for (int nt = 0; nt < 16; ++nt) { const bf16x8 wf = *(const LAS bf16x8*)(WL + (16 * nt + fr) * XS + 32 * kk + 8 * fq);
                    acc[nt] = __builtin_amdgcn_mfma_f32_16x16x32_bf16(af, wf, acc[nt], 0, 0, 0); }
                __builtin_amdgcn_sched_barrier(0); }
#pragma unroll
            for (int nt = 0; nt < 8; ++nt) { const int d = 16 * nt + fr; const float cfac = CHC[d], bav = CHC[128 + d], bxv = CHC[256 + d];
                float A = 1.f, H = 0.f;
#pragma unroll
                for (int q = 0; q < 4; q += 2) { const int l = l0 + 4 * fq + q; v2f av2, bt2, la2;
                    lru_gate2((v2f){acc[nt][q], acc[nt][q + 1]}, (v2f){acc[nt + 8][q], acc[nt + 8][q + 1]}, bav, bxv, cfac, (v2f){bf2f(XR[l * XS + d]), bf2f(XR[(l + 1) * XS + d])}, av2, bt2, la2);
                    aq[nt][q] = av2.x; aq[nt][q + 1] = av2.y; bq[nt][q] = bt2.x; bq[nt][q + 1] = bt2.y;
                    H = av2.x * H + bt2.x; H = av2.y * H + bt2.y; A *= av2.x * av2.y; }
                const float Ap = xor16_f(A, lane), Hp = xor16_f(H, lane);
                const bool odd = (fq & 1) != 0;
                const float AT = A * Ap, HT = odd ? A * Hp + H : Ap * H + Hp;
                const float A01 = xor32_f(AT, lane), H01 = xor32_f(HT, lane);
                Aex[nt] = fq == 0 ? 1.f : fq == 1 ? Ap : fq == 2 ? A01 : Ap * A01; Hex[nt] = fq == 0 ? 0.f : fq == 1 ? Hp : fq == 2 ? H01 : Ap * H01 + Hp;
                if (fq == 3) *(LAS v2f*)(WSUM + (wave * 128 + d) * 2) = (v2f){A01 * AT, AT * H01 + HT};
                __builtin_amdgcn_sched_barrier(0); }
        }
        __syncthreads();
        bool okn; int bn = 0, cn = 0, kbn = 0;
        LRU_FETCH(okn, bn, cn, kbn)
        v2f tot[8]; const int dg = kb * 128 + tid;
        if (tid < 128) { const int nw = Q / 16;
#pragma unroll
            for (int ww = 0; ww < 8; ++ww) tot[ww] = ww < nw ? *(const LAS v2f*)(WSUM + (ww * 128 + tid) * 2) : (v2f){1.f, 0.f};
            float A = 1.f, H = 0.f;
#pragma unroll
            for (int ww = 0; ww < 8; ++ww) { H = tot[ww].x * H + tot[ww].y; A *= tot[ww].x; }
            __hip_atomic_store(AGG + (size_t)(b * NCH + c) * DR + dg, ((unsigned long long)__float_as_uint(H) << 32) | __float_as_uint(A), __ATOMIC_RELAXED, __HIP_MEMORY_SCOPE_AGENT);
            asm volatile("s_waitcnt vmcnt(0)" ::: "memory");
            if (lane == 0) __hip_atomic_fetch_add(FLG + c * 8 + kb, 1u, __ATOMIC_RELAXED, __HIP_MEMORY_SCOPE_AGENT);
        }
        if (okn) lru_front(bn, cn, kbn);
        if (tid < 128) {
            for (unsigned sp = 0; sp < (1u << 18); ++sp) { const unsigned f = lane < c ? __hip_atomic_load(FLG + lane * 8 + kb, __ATOMIC_RELAXED, __HIP_MEMORY_SCOPE_AGENT) : 2u;
                if (__builtin_amdgcn_ballot_w64(f < 2u) == 0ull) break; __builtin_amdgcn_s_sleep(2); }
            unsigned long long ag[NCH - 1];
#pragma unroll
            for (int cp = 0; cp < NCH - 1; ++cp) ag[cp] = __hip_atomic_load(AGG + (size_t)(b * NCH + (cp < c ? cp : 0)) * DR + dg, __ATOMIC_RELAXED, __HIP_MEMORY_SCOPE_AGENT);
            float h = 0.f;
#pragma unroll
            for (int cp = 0; cp < NCH - 1; ++cp) { const float mk = cp < c ? 1.f : 0.f, ax = __uint_as_float((unsigned)ag[cp]), hx = __uint_as_float((unsigned)(ag[cp] >> 32)); h = (1.f + mk * (ax - 1.f)) * h + mk * hx; }
#pragma unroll
            for (int ww = 0; ww < 8; ++ww) { WSUM[(ww * 128 + tid) * 2] = h; h = tot[ww].x * h + tot[ww].y; }
            if (c == NCH - 1) out[O_PLH + ((size_t)j * NB + b) * DR + dg] = h;
    }
        __syncthreads();
        if (act) {
#pragma unroll
            for (int nt = 0; nt < 8; ++nt) { const int d = 16 * nt + fr; float h = Aex[nt] * WSUM[(wave * 128 + d) * 2] + Hex[nt];
#pragma unroll
                for (int q = 0; q < 4; ++q) { const int l = l0 + 4 * fq + q; h = aq[nt][q] * h + bq[nt][q];
                    GL[l * XS + d] = (bf16)f2bf(h * bf2f(GL[l * XS + d])); } }
            LDS_WAIT();
#pragma unroll
            for (int k = 0; k < 4; ++k) { const int ci = lane + 64 * k, rr = l0 + (ci >> 4), c16 = ci & 15;
                *(GAS v4u*)(YL + (size_t)(row0 + rr) * DR + kb * 128 + 8 * c16) = *(const LAS v4u*)(GL + rr * XS + 8 * c16); }
        }
        ok = okn; b = bn; c = cn; kb = kbn;
    }
#undef LRU_FETCH
    for (int si = ((int)blockIdx.x + Gd - 64 % Gd) % Gd; si < 64; si += Gd) { int tid = tid0; asm volatile("" : "+v"(tid)); lru_sample_item(ws, out, lds, j, si & 7, si >> 3, tid, wave); }
}
#define RLX_AGENT __ATOMIC_RELAXED, __HIP_MEMORY_SCOPE_AGENT
#define XB_TMO      128
#define XB_XCNT(j)  (256  + 64 * (j))
#define XB_XSUB(j)  (1280 + 64 * (j))
#define XB_XGEN(j)  (2304 + 64 * (j))
#define XB_TOP      3328
#define XB_TOPGEN   3392
#define XCD_BAR_WORDS 3456
#define XB_SPIN_CAP (1u << 18)

__device__ __forceinline__ unsigned xb_ld(unsigned* p)              { return __hip_atomic_load(p, __ATOMIC_RELAXED, __HIP_MEMORY_SCOPE_AGENT); }
__device__ __forceinline__ unsigned xb_add(unsigned* p, unsigned v) { return __hip_atomic_fetch_add(p, v, __ATOMIC_RELAXED, __HIP_MEMORY_SCOPE_AGENT); }
__device__ __forceinline__ unsigned xb_xcc_id() { return (unsigned)__builtin_amdgcn_s_getreg((3 << 11) | 20) & 0xFu; }
#define XB_SPIN(cond, bar) do { unsigned _sp = 0; while (cond) { __builtin_amdgcn_s_sleep(1); \
    if ((++_sp & 255u) == 0u) { if (xb_ld(&(bar)[XB_TMO])) break; if (_sp > XB_SPIN_CAP) { atomicAdd(&(bar)[XB_TMO], 1u); break; } } } } while (0)

struct XcdBarrier {
    unsigned* bar; unsigned x;
    volatile LAS unsigned* st;
};

__device__ __forceinline__ XcdBarrier xcd_barrier_post(unsigned* bar, volatile LAS unsigned* st) {
    XcdBarrier b; b.bar = bar; b.x = xb_xcc_id(); b.st = st;
    if (threadIdx.x == 0) (void)xb_add(&bar[XB_XCNT(b.x)], 1u);
    return b;
}
__device__ __forceinline__ void xcd_barrier_complete(unsigned* bar, unsigned x, unsigned& nloc, unsigned& nx) {
    const unsigned G = gridDim.x * gridDim.y * gridDim.z;
    unsigned sum, cnt, mine, sp = 0u;
    for (;;) {
        sum = 0u; cnt = 0u; mine = 0u;
#pragma unroll
        for (unsigned j = 0; j < 16; ++j) { const unsigned c = xb_ld(&bar[XB_XCNT(j)]); sum += c; cnt += (c > 0u) ? 1u : 0u; mine = (j == x) ? c : mine; }
        if (sum == G) break;
        __builtin_amdgcn_s_sleep(1);
        if ((++sp & 255u) == 0u) { if (xb_ld(&bar[XB_TMO])) break; if (sp > XB_SPIN_CAP) { atomicAdd(&bar[XB_TMO], 1u); break; } }
    }
    nloc = mine > 0u ? mine : 1u; nx = cnt > 0u ? cnt : 1u;
}

__device__ __forceinline__ void xcd_barrier(const XcdBarrier& b) {
    asm volatile("s_waitcnt vmcnt(0)" ::: "memory");
    __syncthreads();
    if (threadIdx.x == 0) {
        unsigned* bar = b.bar;
        __builtin_amdgcn_s_waitcnt(0);
        unsigned nloc = b.st[0], nx = b.st[1];
        if (nloc == 0u) { xcd_barrier_complete(bar, b.x, nloc, nx); b.st[0] = nloc; b.st[1] = nx; }
        const unsigned old = xb_add(&bar[XB_XSUB(b.x)], 1u);
        const unsigned gen = old / nloc;
        if (old + 1u == (gen + 1u) * nloc) {
            __builtin_amdgcn_fence(__ATOMIC_RELEASE, "agent");
            asm volatile("s_waitcnt vmcnt(0)" ::: "memory");
            const unsigned og = xb_add(&bar[XB_TOP], 1u);
            const unsigned tg = og / nx;
            if (og + 1u == (tg + 1u) * nx) xb_add(&bar[XB_TOPGEN], 1u);
            else XB_SPIN(xb_ld(&bar[XB_TOPGEN]) == tg, bar);
            __builtin_amdgcn_fence(__ATOMIC_ACQUIRE, "agent");
            xb_add(&bar[XB_XGEN(b.x)], 1u);
            asm volatile("s_waitcnt vmcnt(0)" ::: "memory");
        } else {
            XB_SPIN(xb_ld(&bar[XB_XGEN(b.x)]) == gen, bar);
            __builtin_amdgcn_fence(__ATOMIC_ACQUIRE, "agent");
            asm volatile("s_waitcnt vmcnt(0)" ::: "memory");
        }
    }
    __syncthreads();
}

typedef float f32x16 __attribute__((ext_vector_type(16)));
constexpr int SG_SP = 136, SG_WREG = 2 * 32 * SG_SP * 2;
template <int K, int RT, class Epi>
__device__ __forceinline__ void small_gemm(LAS unsigned char* lds, const bf16* A, const bf16* Bt, int rt0, int nrt, int ct0, int nct, const Epi& E) {
    static_assert(RT == 1 && K % 1024 == 0, "small_gemm shape");
    int tid_ = threadIdx.x; asm volatile("" : "+v"(tid_));
    const int tid = tid_, lane = tid & 63, wave = __builtin_amdgcn_readfirstlane(tid >> 6), r = lane & 31, hh = lane >> 5, c16 = lane & 15, rs = lane >> 4;
    constexpr int KW = K / 8, NBAT = KW / 128;
    LAS bf16* As = (LAS bf16*)(lds + wave * SG_WREG); LAS bf16* Bs = As + 32 * SG_SP;
    LAS float* Pw = (LAS float*)(lds + wave * SG_WREG);
    const int ntiles = nrt * nct;
    v4u sa[8], sb[8];
#define SG_ISSUE(tile_, b_) { const bf16* ap_ = A + (size_t)(32 * (rt0 + (tile_) / nct) + rs) * K + wave * KW + 128 * (b_) + 8 * c16; \
          \
        const bf16* bp_ = Bt + ((size_t)(2 * (ct0 + (tile_) % nct)) * (K / 32) + (wave * KW + 128 * (b_)) / 32 + (c16 >> 2)) * 512 + (rs * 4 + (c16 & 3)) * 8; \
        _Pragma("unroll") for (int i = 0; i < 8; ++i) { sa[i] = *(const GAS v4u*)(ap_ + (size_t)(4 * i) * K); sb[i] = *(const GAS v4u*)(bp_ + (size_t)(i >> 2) * (K / 32) * 512 + (4 * (i & 3)) * 4 * 8); } }
    int tile = blockIdx.x;
    if (tile < ntiles) SG_ISSUE(tile, 0)
    for (; tile < ntiles; tile += gridDim.x) {
        const int row0 = 32 * (rt0 + tile / nct), col0 = 32 * (ct0 + tile % nct);
        f32x16 acc;
#pragma unroll
        for (int i = 0; i < 16; ++i) acc[i] = 0.f;
        __syncthreads();
#pragma unroll 1
        for (int b = 0; b < NBAT; ++b) {
#pragma unroll
            for (int i = 0; i < 8; ++i) { *(LAS v4u*)(As + (4 * i + rs) * SG_SP + 8 * c16) = sa[i]; *(LAS v4u*)(Bs + (4 * i + rs) * SG_SP + 8 * c16) = sb[i]; }
            bf16x8 af[8], bfr[8];
#pragma unroll
            for (int i = 0; i < 8; ++i) { af[i] = *(const LAS bf16x8*)(As + r * SG_SP + 16 * i + 8 * hh); bfr[i] = *(const LAS bf16x8*)(Bs + r * SG_SP + 16 * i + 8 * hh); }
            if (b + 1 < NBAT) SG_ISSUE(tile, b + 1)
            else if (tile + (int)gridDim.x < ntiles) SG_ISSUE(tile + (int)gridDim.x, 0)
#pragma unroll
            for (int i = 0; i < 8; ++i) acc = __builtin_amdgcn_mfma_f32_32x32x16_bf16(af[i], bfr[i], acc, 0, 0, 0);
        }
#pragma unroll
        for (int i = 0; i < 16; ++i) Pw[((i & 3) + 8 * (i >> 2) + 4 * hh) * 33 + r] = acc[i];
        __syncthreads();
#pragma unroll
        for (int e = 0; e < 2; ++e) { const int idx = tid + 512 * e, rr = idx >> 5, cc = idx & 31; float v = 0.f;
#pragma unroll
            for (int w = 0; w < 8; ++w) v += *(const LAS float*)(lds + w * SG_WREG + (rr * 33 + cc) * 4);
            E.elem(row0 + rr, col0 + cc, v); }
    }
#undef SG_ISSUE
}
constexpr int TM = 16384;
__device__ __forceinline__ void touch_region(const void* p, size_t bytes, int gthread, int nthreads) {
    const GAS v4u* q = (const GAS v4u*)p; const size_t n = bytes / 16;
    for (size_t i = gthread; i < n; i += (size_t)nthreads * 4) { v4u a = q[i], b = (i + nthreads < n) ? q[i + nthreads] : a, c = (i + 2 * (size_t)nthreads < n) ? q[i + 2 * (size_t)nthreads] : a, d = (i + 3 * (size_t)nthreads < n) ? q[i + 3 * (size_t)nthreads] : a;
        asm volatile("" :: "v"(a), "v"(b), "v"(c), "v"(d)); }
}
template <int N, int K, class Epi, bool TILED_A = false>
__device__ __forceinline__ void run_gemm(LAS unsigned char* lds, const bf16* A, const bf16* Bt, const Epi& E) {
    pg8::Gemm g{A, Bt, TM, N, K}; pg8::StaticOrder S; S.init(TM, N, (int)gridDim.x, (int)blockIdx.x);
    pg8::gemm_phase<Epi, pg8::StaticOrder, true, true, TILED_A>(lds, g, S, E);
    small_gemm<K, 1>(lds, A, Bt, TM / 32, (T - TM) / 32, 0, N / 32, E);
    if (SUBREP & 512) { asm volatile("" ::: "memory"); small_gemm<K, 1>(lds, A, Bt, TM / 32, (T - TM) / 32, 0, N / 32, E); }
}
__global__ void __launch_bounds__(NTHR, 2) mk_fwd(Args args) {
    extern __shared__ __attribute__((aligned(16))) unsigned char lds_raw[];
    LAS unsigned char* lds = (LAS unsigned char*)lds_raw;
    if (threadIdx.x < 2) ((LAS unsigned*)(lds + LDS_MISC_OFF))[threadIdx.x] = 0u;
    __syncthreads();
    const XcdBarrier bar = xcd_barrier_post((unsigned*)(args.ws + WS_CTL) + CW_BAR, (volatile LAS unsigned*)(lds + LDS_MISC_OFF));
    for (int ph = args.ph_lo, rep = 0; ph < args.ph_hi; ++ph) {
        if (ph > 0 && ((ph - 1) / PL) % 2 == 1 && ((ph - 1) % PL == 3 || (ph - 1) % PL == 2)) continue;
        if (ph == args.ph_lo + 1 && rep == 0) cg::this_grid().sync();
        else if (ph > args.ph_lo || rep) xcd_barrier(bar);
        int tid = threadIdx.x; asm volatile("" : "+v"(tid));
        unsigned char* ws = args.ws; asm volatile("" : "+s"(ws));
        const int lane = tid & 63, wave = __builtin_amdgcn_readfirstlane(tid >> 6);
        const int G = gridDim.x, gw = blockIdx.x * NWAVES + wave, NGW = G * NWAVES;
        bf16* WB = (bf16*)(ws + WS_W); bf16* XB = (bf16*)(ws + WS_XB); float* RS = (float*)(ws + WS_RS); bf16* Mb = (bf16*)(ws + WS_M);
        bf16* ZX = (bf16*)(ws + WS_ZX); float* DT = (float*)(ws + WS_DT); bf16* YN = (bf16*)(ws + WS_YN);
        if (ph == 0) { p0_prologue(args, lds, gw, NGW, wave, lane); if (((REP_MASK >> 6) & 1) && rep == 0) { rep = 1; --ph; } else rep = 0; continue; }
        const int i = (ph - 1) / PL, k = (ph - 1) % PL, j = i >> 1; const bool ssd = (i & 1) == 0;
        bf16* wl = ssd ? WB + WE_SSD0 + (size_t)j * WE_SEND : WB + WE_LRU0 + (size_t)j * WE_LEND;
        bf16* wf = WB + WE_FFN0 + (size_t)i * WE_FEND;
        if (k == 0) {
            if (ssd) { pg8::EpiSsdIn E{ZX, DT, RS}; run_gemm<ZXW, DM>(lds, XB, wl + WE_SIN, E);
                small_gemm<DM, 1>(lds, XB, wl + WE_SIN, 0, T / 32, ZXW / 32, 1, E); }
            else { pg8::EpiLruIn E{ZX, ZX + (size_t)T * DR, RS, arg_in(I_LBIN) + (size_t)j * 2048}; run_gemm<2048, DM>(lds, XB, wl + WE_LIN, E); }
        } else if (k == 4) {
            if (ssd) { pg8::EpiM E{Mb, nullptr}; run_gemm<DM, DI>(lds, YN, wl + WE_SOUT, E); }
            else { pg8::EpiM E{Mb, arg_in(I_LBOUT) + (size_t)j * DM}; run_gemm<DM, DR>(lds, YN, wl + WE_LOUT, E); }
        } else if (k == 5) { if (TOUCH_W) touch_region(wf, (size_t)WE_FEND * 2, blockIdx.x * NTHR + tid, G * NTHR);
            resid_phase(args, arg_in(I_NMPOST) + (size_t)i * DM, false, gw, NGW, lane);
        } else if (k == 6) { pg8::EpiFfn1 E{ZX, RS}; run_gemm<DFF, DM>(lds, XB, wf + WE_F1, E);
        } else if (k == 7) { pg8::EpiM E{Mb, nullptr}; run_gemm<DM, DFF, pg8::EpiM, true>(lds, ZX, wf + WE_F2, E);
        } else if (k == 8) { resid_phase(args, arg_in(I_NFPOST) + (size_t)i * DM, i == 3, gw, NGW, lane);
        }
        else if (ssd && k == 1) ssd_phase_a(ws, args.out, lds, j, tid, lane, wave);
        else if (ssd && k == 2) ssd_phase_b(ws, args.out, j, tid);
        else if (ssd && k == 3) ssd_phase_c(ws, args.out, lds, j, tid, lane, wave);
        else if (!ssd && k == 1) lru_phase_ab(ws, args.out, lds, j, tid, wave);
#ifdef REP_K
        if (((REP_K >> k) & 1) && (REP_SSD < 0 || (REP_SSD == 1) == ssd)) { if (rep == 0) { rep = 1; --ph; } else rep = 0; }
#endif
        if (REP_MASK) { const int kind = (k == 0 || k == 4 || k == 6 || k == 7) ? 0 : (ssd && k >= 1 && k <= 3) ? k : (!ssd && k >= 1 && k <= 2) ? 3 + k : 9;
            if (((REP_MASK >> kind) & 1) && rep == 0) { rep = 1; --ph; } else rep = 0; }
    }
}

__global__ void k_ssd_conv(const bf16* __restrict__ ZX, const float* __restrict__ st, const float* __restrict__ cw, const float* __restrict__ cb,
                           float* __restrict__ XBC, float* __restrict__ o_p, float* __restrict__ o_s) {
    const int r = blockIdx.x, c = blockIdx.y * 256 + threadIdx.x;
    float x0, x1, x2; const float x3 = bf2f(ZX[(size_t)r * ZXW + DI + c]);
    if (r < TP) { const int t = r % LP;
        x2 = t >= 1 ? bf2f(ZX[(size_t)(r - 1) * ZXW + DI + c]) : 0.f; x1 = t >= 2 ? bf2f(ZX[(size_t)(r - 2) * ZXW + DI + c]) : 0.f; x0 = t >= 3 ? bf2f(ZX[(size_t)(r - 3) * ZXW + DI + c]) : 0.f;
        if (t >= LP - 3) o_p[((size_t)(r / LP) * 3 + (t - (LP - 3))) * CONVD + c] = x3;
    } else { const int s = r - TP; const float* sp = st + (size_t)s * 3 * CONVD + c; x0 = sp[0]; x1 = sp[CONVD]; x2 = sp[2 * CONVD];
        float* op = o_s + (size_t)s * 3 * CONVD + c; op[0] = x1; op[CONVD] = x2; op[2 * CONVD] = x3; }
    const float v = cb[c] + cw[c] * x0 + cw[CONVD + c] * x1 + cw[2 * CONVD + c] * x2 + cw[3 * CONVD + c] * x3;
    XBC[(size_t)r * CONVD + c] = silu_f(v);
}
__global__ void __launch_bounds__(64) k_ssd_scan(const float* __restrict__ DT, const float* __restrict__ XBC, const float* __restrict__ h0,
                                                 const float* __restrict__ dt_bias, const float* __restrict__ a_log, const float* __restrict__ dsk,
                                                 float* __restrict__ Y, float* __restrict__ o_ph, float* __restrict__ o_sh) {
    const int q = blockIdx.x / NH, h = blockIdx.x % NH, p = threadIdx.x, g = h / 4;
    const int row0 = seq_row0(q), L = seq_len(q);
    float hs[NST];
    if (q < NB) {
#pragma unroll
        for (int n = 0; n < NST; ++n) hs[n] = 0.f;
    } else { const float* hp = h0 + (((size_t)(q - NB) * NH + h) * HD + p) * NST;
#pragma unroll
        for (int n = 0; n < NST; n += 4) { const float4 v = *(const float4*)(hp + n); hs[n] = v.x; hs[n + 1] = v.y; hs[n + 2] = v.z; hs[n + 3] = v.w; } }
    const float Aneg = -__expf(a_log[h]), dtb = dt_bias[h], Dh = dsk[h];
    for (int t = 0; t < L; ++t) {
        const size_t row = (size_t)(row0 + t);
        const float dtv = softplus_f(DT[row * 32 + h] + dtb);
        const float dA = __expf(dtv * Aneg);
        const float xv = XBC[row * CONVD + h * HD + p], xdt = xv * dtv;
        const float* Bp = XBC + row * CONVD + DI + g * NST; const float* Cp = Bp + NG * NST;
        float y = 0.f;
#pragma unroll
        for (int n = 0; n < NST; ++n) { hs[n] = fmaf(hs[n], dA, xdt * Bp[n]); y = fmaf(Cp[n], hs[n], y); }
        Y[row * DI + h * HD + p] = y + Dh * xv;
    }
    float* op = (q < NB ? o_ph + (((size_t)q * NH + h) * HD + p) * NST : o_sh + (((size_t)(q - NB) * NH + h) * HD + p) * NST);
#pragma unroll
    for (int n = 0; n < NST; n += 4) *(float4*)(op + n) = make_float4(hs[n], hs[n + 1], hs[n + 2], hs[n + 3]);
}
__global__ void k_ssd_gate_norm(const float* __restrict__ Y, const bf16* __restrict__ ZX, bf16* __restrict__ YN) {
    const int wv = blockIdx.x * 4 + (threadIdx.x >> 6), lane = threadIdx.x & 63, r = wv / NG, g = wv % NG, c = g * 256 + lane * 4;
    const float4 y = *(const float4*)(Y + (size_t)r * DI + c); const v2u zz = *(const v2u*)(ZX + (size_t)r * ZXW + c);
    float4 v = make_float4(y.x * silu_f(bflo(zz.x)), y.y * silu_f(bfhi(zz.x)), y.z * silu_f(bflo(zz.y)), y.w * silu_f(bfhi(zz.y)));
    const float s = wave_sum(v.x * v.x + v.y * v.y + v.z * v.z + v.w * v.w);
    const float rs = rsqrtf(s * (1.f / 256.f) + EPS);
    *(v2u*)(YN + (size_t)r * DI + c) = (v2u){pk2(v.x * rs, v.y * rs), pk2(v.z * rs, v.w * rs)};
}
__global__ void k_lru_conv(const bf16* __restrict__ XRAW, const float* __restrict__ st, const float* __restrict__ cw, const float* __restrict__ cb,
                           float* __restrict__ XR, float* __restrict__ o_p, float* __restrict__ o_s) {
    const int r = blockIdx.x, c = blockIdx.y * 256 + threadIdx.x;
    float x0, x1, x2; const float x3 = bf2f(XRAW[(size_t)r * DR + c]);
    if (r < TP) { const int t = r % LP;
        x2 = t >= 1 ? bf2f(XRAW[(size_t)(r - 1) * DR + c]) : 0.f; x1 = t >= 2 ? bf2f(XRAW[(size_t)(r - 2) * DR + c]) : 0.f; x0 = t >= 3 ? bf2f(XRAW[(size_t)(r - 3) * DR + c]) : 0.f;
        if (t >= LP - 3) o_p[((size_t)(r / LP) * 3 + (t - (LP - 3))) * DR + c] = x3;
    } else { const int s = r - TP; const float* sp = st + (size_t)s * 3 * DR + c; x0 = sp[0]; x1 = sp[DR]; x2 = sp[2 * DR];
        float* op = o_s + (size_t)s * 3 * DR + c; op[0] = x1; op[DR] = x2; op[2 * DR] = x3; }
    XR[(size_t)r * DR + c] = cb[c] + cw[c] * x0 + cw[DR + c] * x1 + cw[2 * DR + c] * x2 + cw[3 * DR + c] * x3;
}
__global__ void k_lru_gates(const float* __restrict__ XR, const float* __restrict__ wa, const float* __restrict__ ba, const float* __restrict__ wx, const float* __restrict__ bx,
                            const float* __restrict__ lam, float* __restrict__ AV, float* __restrict__ BV) {
    const int r = blockIdx.x, d = blockIdx.y * 256 + threadIdx.x, k = d >> 7, dd = d & 127;
    const float* xr = XR + (size_t)r * DR + k * 128; const float* wap = wa + (size_t)k * 128 * 128 + dd; const float* wxp = wx + (size_t)k * 128 * 128 + dd;
    float sa = ba[d], sx = bx[d];
    for (int c = 0; c < 128; ++c) { const float xv = xr[c]; sa = fmaf(xv, wap[c * 128], sa); sx = fmaf(xv, wxp[c * 128], sx); }
    const float rg = sigmoid_f(sa), ig = sigmoid_f(sx);
    const float log_a = -8.0f * rg * softplus_f(-lam[d]);
    const float av = __expf(log_a), mult = sqrtf(-expm1f(2.f * log_a));
    AV[(size_t)r * DR + d] = av; BV[(size_t)r * DR + d] = mult * ig * XR[(size_t)r * DR + d];
}
__global__ void k_lru_scan(const float* __restrict__ AV, const float* __restrict__ BV, const bf16* __restrict__ Gt, const float* __restrict__ h0,
                           bf16* __restrict__ YL, float* __restrict__ o_p, float* __restrict__ o_s) {
    const int q = blockIdx.x, d = blockIdx.y * 256 + threadIdx.x, row0 = seq_row0(q), L = seq_len(q);
    float h = q < NB ? 0.f : h0[(size_t)(q - NB) * DR + d];
    for (int t = 0; t < L; ++t) { const size_t row = (size_t)(row0 + t);
        h = fmaf(AV[row * DR + d], h, BV[row * DR + d]);
        YL[row * DR + d] = (bf16)f2bf(h * bf2f(Gt[row * DR + d])); }
    if (q < NB) o_p[(size_t)q * DR + d] = h; else o_s[(size_t)(q - NB) * DR + d] = h;
}

extern "C" void kernel_launch(void* const* d_in, const int* in_sizes, int n_in, void* d_out, int out_size, void* d_ws, size_t ws_size, hipStream_t stream) {
    static int grid = 0;
    if (grid == 0) {
        if (n_in != N_IN || (size_t)out_size != O_END || ws_size < WS_END) { fprintf(stderr, "kernel_launch: unexpected sizes n_in %d out %d ws %zu (need %zu)\n", n_in, out_size, ws_size, (size_t)WS_END); grid = -1; return; }
        int dev = 0, cus = 0, per_cu = 0;
        if (hipGetDevice(&dev) != hipSuccess || hipDeviceGetAttribute(&cus, hipDeviceAttributeMultiprocessorCount, dev) != hipSuccess) { grid = -1; return; }
        if (hipFuncSetAttribute((const void*)mk_fwd, hipFuncAttributeMaxDynamicSharedMemorySize, LDS_BYTES) != hipSuccess) { fprintf(stderr, "kernel_launch: hipFuncSetAttribute failed\n"); grid = -1; return; }
        if (hipOccupancyMaxActiveBlocksPerMultiprocessor(&per_cu, (const void*)mk_fwd, NTHR, LDS_BYTES) != hipSuccess || per_cu < 1) { fprintf(stderr, "kernel_launch: occupancy query %d\n", per_cu); grid = -1; return; }
        grid = cus;
    }
    if (grid < 0) return;
    const float* const* in = (const float* const*)d_in; float* out = (float*)d_out; unsigned char* ws = (unsigned char*)d_ws;
    (void)hipMemsetAsync(ws + WS_CTL, 0, CTL_ZERO_BYTES, stream);
    Args a{};
    for (int i = 0; i < N_IN; ++i) a.in[i] = in[i];
    a.out = out; a.ws = ws;
    bf16* ZX = (bf16*)(ws + WS_ZX); float* DT = (float*)(ws + WS_DT); bf16* YN = (bf16*)(ws + WS_YN);
    float* SCR = (float*)(ws + WS_SCR);
    constexpr size_t SZ_X = (size_t)T * DM;
    int ph = 0;
    while (ph < NPH) {
        const int i = ph ? (ph - 1) / PL : -1, k = ph ? (ph - 1) % PL : -1, j = i >> 1;
        if (false) {
            if (k == 1) {
            if ((i & 1) == 0) {
                float* XBC = SCR; float* Y = SCR + (size_t)T * CONVD;
                hipLaunchKernelGGL(k_ssd_conv, dim3(T, CONVD / 256), dim3(256), 0, stream, ZX, in[I_SSC] + (size_t)j * NS * 3 * CONVD, in[I_SCW] + (size_t)j * 4 * CONVD, in[I_SCB] + (size_t)j * CONVD,
                                   XBC, out + O_PSC + (size_t)j * NB * 3 * CONVD, out + O_SSC + (size_t)j * NS * 3 * CONVD);
                hipLaunchKernelGGL(k_ssd_scan, dim3(NSEQ * NH), dim3(64), 0, stream, DT, XBC, in[I_SSH] + (size_t)j * NS * NH * HD * NST, in[I_SDTB] + j * NH, in[I_SALOG] + j * NH, in[I_SD] + j * NH,
                                   Y, out + O_PSH + (size_t)j * NB * NH * HD * NST, out + O_SSH + (size_t)j * NS * NH * HD * NST);
                hipLaunchKernelGGL(k_ssd_gate_norm, dim3(T * NG / 4), dim3(256), 0, stream, Y, ZX, YN);
            } else {
                float* XR = SCR; float* AV = SCR + SZ_X; float* BV = SCR + 2 * SZ_X;
                hipLaunchKernelGGL(k_lru_conv, dim3(T, DR / 256), dim3(256), 0, stream, ZX + (size_t)T * DR, in[I_SLC] + (size_t)j * NS * 3 * DR, in[I_LCW] + (size_t)j * 4 * DR, in[I_LCB] + (size_t)j * DR,
                                   XR, out + O_PLC + (size_t)j * NB * 3 * DR, out + O_SLC + (size_t)j * NS * 3 * DR);
                hipLaunchKernelGGL(k_lru_gates, dim3(T, DR / 256), dim3(256), 0, stream, XR, in[I_LWA] + (size_t)j * 8 * 128 * 128, in[I_LBA] + (size_t)j * DR, in[I_LWX] + (size_t)j * 8 * 128 * 128, in[I_LBX] + (size_t)j * DR,
                                   in[I_LLAM] + (size_t)j * DR, AV, BV);
                hipLaunchKernelGGL(k_lru_scan, dim3(NSEQ, DR / 256), dim3(256), 0, stream, AV, BV, ZX, in[I_SLH] + (size_t)j * NS * DR, YN, out + O_PLH + (size_t)j * NB * DR, out + O_SLH + (size_t)j * NS * DR);
            }
            }
            ++ph; continue;
        }
        int hi = ph + 1;
        hi = NPH;
        a.ph_lo = ph; a.ph_hi = hi;
        void* kargs[] = {(void*)&a};
        const hipError_t e = hipLaunchCooperativeKernel((const void*)mk_fwd, dim3(grid), dim3(NTHR), kargs, LDS_BYTES, stream);
        if (e != hipSuccess) fprintf(stderr, "kernel_launch: cooperative launch failed: %s (grid %d)\n", hipGetErrorString(e), grid);
        ph = hi;
    }
}
```
